# Optimizing an MI355X kernel written in HIP

```python
import jax, jax.numpy as jnp
from jax import lax
import numpy as np

D_MODEL = 2048
BATCH = 8
SEQ = 2048
DEPTH = 1

D_MIX = D_MODEL
LRU_WIDTH = D_MIX // 2
LRU_BLOCKS = 8
LRU_BLOCK_W = LRU_WIDTH // LRU_BLOCKS
CONV_W = 4
LRU_C = 8.0
ATTN_WIDTH = D_MIX - LRU_WIDTH
HEAD_DIM = 128
N_HEADS = ATTN_WIDTH // HEAD_DIM
ROT_DIM = HEAD_DIM // 4
ROPE_THETA = 500000.0
DILATED_PATTERNS = ((128, 1), (512, 4), (2048, 16))
ATTN_BLOCK = 128
N_EXPERTS = 64
N_GROUPS = 8
TOPK_GROUPS = 4
TOP_K = 8
D_EXPERT = D_MODEL // 4
ROUTED_SCALE = 2.5
EXPERT_BLOCK = 128
DN_ALPHA = (2 * DEPTH) ** 0.25
DN_BETA = (8 * DEPTH) ** -0.25
LN_EPS = 1e-5
COL_SPLITS = [LRU_WIDTH, 2 * LRU_WIDTH, 2 * LRU_WIDTH + ATTN_WIDTH, 2 * LRU_WIDTH + 2 * ATTN_WIDTH]

kernel_name = 'hymba_rglru_dilated_moe_deepnorm'

F32 = jnp.float32


def _layer_norm(x, g, b):
    xf = x.astype(F32)
    mu = jnp.mean(xf, -1, keepdims=True)
    xc = xf - mu
    var = jnp.mean(xc * xc, -1, keepdims=True)
    return (xc * lax.rsqrt(var + LN_EPS) * g.astype(F32) + b.astype(F32)).astype(x.dtype)


def _partial_rope(t):
    S = t.shape[1]
    half = ROT_DIM // 2
    pos = jnp.arange(S, dtype=F32)
    inv = ROPE_THETA ** (-jnp.arange(0, ROT_DIM, 2, dtype=F32) / ROT_DIM)
    ang = pos[:, None] * inv[None, :]
    cos = jnp.cos(ang)[None, :, None, :]
    sin = jnp.sin(ang)[None, :, None, :]
    t1, t2, tp = t[..., :half], t[..., half:ROT_DIM], t[..., ROT_DIM:]
    return jnp.concatenate([t1 * cos - t2 * sin, t2 * cos + t1 * sin, tp], -1)


def _rglru_branch(xb, gb, conv_w, conv_b, w_a, b_a, w_x, b_x, lam):
    B, S, C = xb.shape
    xc = lax.conv_general_dilated(xb, conv_w.reshape(CONV_W, 1, C), (1,), [(CONV_W - 1, 0)],
                                  dimension_numbers=('NWC', 'WIO', 'NWC'), feature_group_count=C)
    xc = (xc + conv_b).astype(F32)
    xr = xc.reshape(B, S, LRU_BLOCKS, LRU_BLOCK_W)
    r = jax.nn.sigmoid(jnp.einsum('bsnc,ncd->bsnd', xr, w_a.astype(F32)) + b_a.astype(F32)).reshape(B, S, C)
    i = jax.nn.sigmoid(jnp.einsum('bsnc,ncd->bsnd', xr, w_x.astype(F32)) + b_x.astype(F32)).reshape(B, S, C)
    log_a = -LRU_C * r * jax.nn.softplus(-lam.astype(F32))
    a = jnp.exp(log_a)
    u = jnp.sqrt(-jnp.expm1(2.0 * log_a)) * (i * xc)

    def comb(lhs, rhs):
        a1, b1 = lhs
        a2, b2 = rhs
        return a1 * a2, a2 * b1 + b2

    _, h = lax.associative_scan(comb, (a, u), axis=1)
    return h * jax.nn.gelu(gb.astype(F32), approximate=True)


def _dilated_window_attention(q, k, v, window, dilation):
    B, S, H, Dh = q.shape
    L = S // dilation
    W = window // dilation
    Q = min(ATTN_BLOCK, L)
    nb = -(-L // Q)
    Lp = nb * Q
    n = B * dilation

    def split(t):
        return t.reshape(B, L, dilation, H, Dh).transpose(0, 2, 1, 3, 4).reshape(n, L, H, Dh)

    qs = jnp.pad(split(q), ((0, 0), (0, Lp - L), (0, 0), (0, 0)))
    ks = jnp.pad(split(k), ((0, 0), (W, Lp - L), (0, 0), (0, 0)))
    vs = jnp.pad(split(v), ((0, 0), (W, Lp - L), (0, 0), (0, 0)))
    kidx = jnp.arange(nb)[:, None] * Q + jnp.arange(Q + W)[None, :]
    kb = ks[:, kidx]
    vb = vs[:, kidx]
    qb = qs.reshape(n, nb, Q, H, Dh)
    s = jnp.einsum('nbqhd,nbkhd->nbhqk', qb, kb) * (Dh ** -0.5)
    qpos = jnp.arange(Lp).reshape(nb, Q)
    kpos = kidx - W
    diff = qpos[:, :, None] - kpos[:, None, :]
    valid = (diff >= 0) & (diff <= W) & (kpos[:, None, :] >= 0)
    s = jnp.where(valid[None, :, None], s, -jnp.inf)
    m = jnp.max(s, -1)
    p = jnp.exp(s - m[..., None])
    den = jnp.sum(p, -1)
    o = jnp.einsum('nbhqk,nbkhd->nbqhd', p, vb) / jnp.swapaxes(den, -1, -2)[..., None]

    def merge(t):
        t = t[:, :L]
        rest = t.shape[2:]
        return t.reshape((B, dilation, L) + rest).swapaxes(1, 2).reshape((B, S) + rest)

    o = merge(o.reshape(n, Lp, H, Dh))
    m = merge(jnp.swapaxes(m, -1, -2).reshape(n, Lp, H))
    den = merge(jnp.swapaxes(den, -1, -2).reshape(n, Lp, H))
    return o, m, den


def _mixture_of_dilations(q, k, v):
    res = [_dilated_window_attention(q, k, v, w, d) for (w, d) in DILATED_PATTERNS]
    m_all = jnp.stack([r[1] for r in res])
    mx = jnp.max(m_all, 0)
    wts = jnp.stack([r[2] for r in res]) * jnp.exp(m_all - mx)
    o_all = jnp.stack([r[0] for r in res])
    return jnp.einsum('pbsh,pbshd->bshd', wts, o_all) / jnp.sum(wts, 0)[..., None]


def _route(xf, w_router, router_bias):
    N = xf.shape[0]
    scores = jax.nn.sigmoid(xf.astype(F32) @ w_router.astype(F32))
    sel = scores + router_bias.astype(F32)
    grp = sel.reshape(N, N_GROUPS, N_EXPERTS // N_GROUPS)
    gscore = jnp.sum(lax.top_k(grp, 2)[0], -1)
    _, gidx = lax.top_k(gscore, TOPK_GROUPS)
    gmask = jnp.sum(jax.nn.one_hot(gidx, N_GROUPS, dtype=F32), 1) > 0
    emask = jnp.repeat(gmask, N_EXPERTS // N_GROUPS, axis=1)
    _, idx = lax.top_k(jnp.where(emask, sel, -jnp.inf), TOP_K)
    g = jnp.take_along_axis(scores, idx, 1)
    g = g / jnp.sum(g, -1, keepdims=True) * ROUTED_SCALE
    return idx, g


def _routed_experts(xf, idx, gates, w_gate, w_up, w_down):
    N, D = xf.shape
    A = N * TOP_K
    e_flat = idx.reshape(A)
    tok_flat = jnp.repeat(jnp.arange(N, dtype=jnp.int32), TOP_K)
    g_flat = gates.reshape(A)
    order = jnp.argsort(e_flat)
    e_sorted = e_flat[order]
    counts = jnp.zeros((N_EXPERTS,), jnp.int32).at[e_flat].add(1)
    padded = (counts + EXPERT_BLOCK - 1) // EXPERT_BLOCK * EXPERT_BLOCK
    end_pad = jnp.cumsum(padded)
    start_pad = end_pad - padded
    start = jnp.cumsum(counts) - counts
    dest = start_pad[e_sorted] + jnp.arange(A, dtype=jnp.int32) - start[e_sorted]
    P = A + N_EXPERTS * EXPERT_BLOCK
    nblk = P // EXPERT_BLOCK
    slot_tok = jnp.full((P,), N, jnp.int32).at[dest].set(tok_flat[order])
    slot_gate = jnp.zeros((P,), F32).at[dest].set(g_flat[order])
    blk_start = jnp.arange(nblk, dtype=jnp.int32) * EXPERT_BLOCK
    blk_expert = jnp.minimum(jnp.searchsorted(end_pad, blk_start, side='right'), N_EXPERTS - 1)
    xpad = jnp.concatenate([xf, jnp.zeros((1, D), xf.dtype)], 0)

    def body(acc, blk):
        tok, g, e = blk
        xb = xpad[tok]
        h = jax.nn.silu(xb @ w_gate[e]) * (xb @ w_up[e])
        y = (h @ w_down[e]) * g[:, None].astype(h.dtype)
        return acc.at[tok].add(y.astype(acc.dtype)), None

    acc0 = jnp.zeros((N + 1, D), xf.dtype)
    acc, _ = lax.scan(body, acc0, (slot_tok.reshape(nblk, EXPERT_BLOCK),
                                   slot_gate.reshape(nblk, EXPERT_BLOCK), blk_expert))
    return acc[:N]


def _moe(x, w_router, router_bias, w_gate, w_up, w_down, ws_gate, ws_up, ws_down):
    B, S, D = x.shape
    xf = x.reshape(B * S, D)
    idx, g = _route(xf, w_router, router_bias)
    routed = _routed_experts(xf, idx, g, w_gate, w_up, w_down)
    shared = (jax.nn.silu(xf @ ws_gate) * (xf @ ws_up)) @ ws_down
    return (routed + shared).reshape(B, S, D)


def setup_inputs(seed: int = 0) -> dict:
    key = jax.random.key(seed)
    ks = jax.random.split(key, 26)
    L = DEPTH

    def nrm(k, shape, scale):
        return jax.random.normal(k, shape, F32) * scale

    x = nrm(ks[0], (BATCH, SEQ, D_MODEL), 1.0)
    w_in = jnp.concatenate([
        nrm(ks[1], (L, D_MODEL, 2 * LRU_WIDTH + 2 * ATTN_WIDTH), D_MODEL ** -0.5),
        nrm(ks[2], (L, D_MODEL, ATTN_WIDTH), DN_BETA * D_MODEL ** -0.5)], -1)
    conv_w = nrm(ks[3], (L, CONV_W, LRU_WIDTH), CONV_W ** -0.5)
    conv_b = nrm(ks[4], (L, LRU_WIDTH), 0.02)
    w_rg_a = nrm(ks[5], (L, LRU_BLOCKS, LRU_BLOCK_W, LRU_BLOCK_W), LRU_BLOCK_W ** -0.5)
    b_rg_a = nrm(ks[6], (L, LRU_BLOCKS, LRU_BLOCK_W), 0.02)
    w_rg_x = nrm(ks[7], (L, LRU_BLOCKS, LRU_BLOCK_W, LRU_BLOCK_W), LRU_BLOCK_W ** -0.5)
    b_rg_x = nrm(ks[8], (L, LRU_BLOCKS, LRU_BLOCK_W), 0.02)
    u = jax.random.uniform(ks[9], (L, LRU_WIDTH), dtype=F32, minval=0.9, maxval=0.999)
    sa = u ** (1.0 / LRU_C)
    lru_lambda = jnp.log(sa) - jnp.log1p(-sa)
    w_out = nrm(ks[10], (L, D_MIX, D_MODEL), DN_BETA * D_MIX ** -0.5)
    ln1_g = 1.0 + nrm(ks[11], (L, D_MODEL), 0.02)
    ln1_b = nrm(ks[12], (L, D_MODEL), 0.02)
    w_router = nrm(ks[13], (L, D_MODEL, N_EXPERTS), D_MODEL ** -0.5)
    router_bias = nrm(ks[14], (L, N_EXPERTS), 0.01)
    w_gate = nrm(ks[15], (L, N_EXPERTS, D_MODEL, D_EXPERT), D_MODEL ** -0.5)
    w_up = nrm(ks[16], (L, N_EXPERTS, D_MODEL, D_EXPERT), DN_BETA * D_MODEL ** -0.5)
    w_down = nrm(ks[17], (L, N_EXPERTS, D_EXPERT, D_MODEL), DN_BETA * D_EXPERT ** -0.5)
    ws_gate = nrm(ks[18], (L, D_MODEL, D_EXPERT), D_MODEL ** -0.5)
    ws_up = nrm(ks[19], (L, D_MODEL, D_EXPERT), DN_BETA * D_MODEL ** -0.5)
    ws_down = nrm(ks[20], (L, D_EXPERT, D_MODEL), DN_BETA * D_EXPERT ** -0.5)
    ln2_g = 1.0 + nrm(ks[21], (L, D_MODEL), 0.02)
    ln2_b = nrm(ks[22], (L, D_MODEL), 0.02)
    return {'x': x, 'w_in': w_in, 'conv_w': conv_w, 'conv_b': conv_b,
            'w_rg_a': w_rg_a, 'b_rg_a': b_rg_a, 'w_rg_x': w_rg_x, 'b_rg_x': b_rg_x,
            'lru_lambda': lru_lambda, 'w_out': w_out, 'ln1_g': ln1_g, 'ln1_b': ln1_b,
            'w_router': w_router, 'router_bias': router_bias, 'w_gate': w_gate,
            'w_up': w_up, 'w_down': w_down, 'ws_gate': ws_gate, 'ws_up': ws_up,
            'ws_down': ws_down, 'ln2_g': ln2_g, 'ln2_b': ln2_b}


def reference(x, w_in, conv_w, conv_b, w_rg_a, b_rg_a, w_rg_x, b_rg_x, lru_lambda, w_out,
              ln1_g, ln1_b, w_router, router_bias, w_gate, w_up, w_down, ws_gate, ws_up,
              ws_down, ln2_g, ln2_b):
    B, S, _ = x.shape
    for l in range(DEPTH):
        proj = jnp.einsum('bsd,de->bse', x, w_in[l])
        xl, gl, q, k, v = jnp.split(proj, COL_SPLITS, axis=-1)
        lru = _rglru_branch(xl, gl, conv_w[l], conv_b[l], w_rg_a[l], b_rg_a[l],
                            w_rg_x[l], b_rg_x[l], lru_lambda[l])
        qh = _partial_rope(q.astype(F32).reshape(B, S, N_HEADS, HEAD_DIM))
        kh = _partial_rope(k.astype(F32).reshape(B, S, N_HEADS, HEAD_DIM))
        vh = v.astype(F32).reshape(B, S, N_HEADS, HEAD_DIM)
        att = _mixture_of_dilations(qh, kh, vh).reshape(B, S, ATTN_WIDTH)
        mix = jnp.concatenate([lru, att], -1).astype(x.dtype) @ w_out[l]
        x = _layer_norm(DN_ALPHA * x + mix, ln1_g[l], ln1_b[l])
        ffn = _moe(x, w_router[l], router_bias[l], w_gate[l], w_up[l], w_down[l],
                   ws_gate[l], ws_up[l], ws_down[l])
        x = _layer_norm(DN_ALPHA * x + ffn, ln2_g[l], ln2_b[l])
    return x
```

```cpp
#include <hip/hip_runtime.h>
#ifndef MULTI_LAUNCH
#define ONE_LAUNCH 1
#endif
#include <cstdio>
#include <cstdint>

#define LAS __attribute__((address_space(3)))
typedef unsigned short bf16_t;
typedef short bf16x8 __attribute__((ext_vector_type(8)));
typedef short s16x4 __attribute__((ext_vector_type(4)));
typedef float f32x2 __attribute__((ext_vector_type(2)));
typedef float f32x4 __attribute__((ext_vector_type(4)));
typedef float f32x16 __attribute__((ext_vector_type(16)));
typedef unsigned u32x2 __attribute__((ext_vector_type(2)));
typedef unsigned u32x4 __attribute__((ext_vector_type(4)));

constexpr int NB = 8, SEQ = 2048, DM = 2048, NTOK = NB * SEQ;
constexpr int NPROJ = 5120, NGRP = 40;
constexpr int NEXP = 64, NE1 = 65, DEXP = 512, TOPK = 8, NPAIR = 9;
constexpr int CAP = NTOK;
constexpr float DN_ALPHA = 1.189207115002721f;
constexpr float LN_EPS = 1e-5f;
constexpr int NWAVES = 8, NTHR = 512;
constexpr int LDS_BYTES = 147456;

constexpr size_t MiB = 1u << 20;
constexpr size_t WS_CTL = 0;
constexpr size_t WS_TAB = 1 * MiB;
constexpr size_t WS_WRG = 2 * MiB;
constexpr size_t WS_WR = 3 * MiB;
constexpr size_t WS_SLOT = 4 * MiB;
constexpr size_t SLOT_ARR = (size_t)NE1 * CAP * 4;
constexpr size_t WS_RPART = 17 * MiB;
constexpr size_t WS_ASTAT = 21 * MiB;
constexpr size_t WS_WD = 24 * MiB;
constexpr size_t WS_X1 = 154 * MiB;
constexpr size_t WS_H = 218 * MiB;
constexpr size_t WS_BIG = 380 * MiB;
constexpr size_t WS_WGU = WS_BIG;
constexpr size_t WS_WIN = WS_BIG + 260 * MiB;
constexpr size_t WS_WOUT = WS_BIG + 280 * MiB;
constexpr size_t WS_XB = WS_BIG + 288 * MiB;
constexpr size_t WS_PROJ = WS_BIG + 352 * MiB;
constexpr size_t WS_MIX = WS_BIG + 512 * MiB;
constexpr size_t WS_END = WS_BIG + 576 * MiB;

constexpr int CW_CNT = 64;
constexpr int CW_BAR = 4096;

__device__ __forceinline__ unsigned cvt_pk_bf16(float lo, float hi) { unsigned r; asm volatile("v_cvt_pk_bf16_f32 %0, %1, %2" : "=v"(r) : "v"(lo), "v"(hi)); return r; }
__device__ __forceinline__ float bf2f(unsigned short b) { return __uint_as_float(((unsigned)b) << 16); }
__device__ __forceinline__ float bflo(unsigned w) { return __uint_as_float(w << 16); }
__device__ __forceinline__ float bfhi(unsigned w) { return __uint_as_float(w & 0xffff0000u); }
__device__ __forceinline__ float wave_sum(float v) {
#pragma unroll
    for (int o = 1; o < 64; o <<= 1) v += __shfl_xor(v, o);
    return v;
}
#define LDS_WAIT() asm volatile("s_waitcnt lgkmcnt(0)" ::: "memory")
#define VM_WAIT() asm volatile("s_waitcnt vmcnt(0)" ::: "memory")

namespace pg8 {
constexpr int BM = 256, BK = 64, HALF = 128, HTB = HALF * BK * 2, STAGE_BYTES = 8 * HTB, NXCD = 8, WGM = 8;
__host__ __device__ __forceinline__ int lds_byte(int r, int c) { const int st = (r >> 4) * 2 + (c >> 5), rr = r & 15, cc = c & 31, ob = rr * 64 + cc * 2; return st * 1024 + (ob ^ (((ob >> 9) & 1) << 5)); }
__host__ __device__ __forceinline__ void stage_rc(int b, int& R, int& C) { const int st = b / 1024, sb = b % 1024, swz = sb ^ (((sb >> 9) & 1) << 5); R = (st >> 1) * 16 + swz / 64; C = (st & 1) * 32 + (swz % 64) / 2; }
__host__ __device__ __forceinline__ int perm32(int rho) { const int n = rho >> 4, i = rho & 15; return 8 * (i >> 2) + 4 * n + (i & 3); }

struct Unit { int pm, pn, e, cnt, row0; };

struct DenseOrder {
    int nM, nN, nwg, G, c; size_t bstride;
    __device__ void init(int M, int N, int K, int G_, int c_) { nM = M / BM; nN = N / BM; nwg = nM * nN; G = G_; c = c_; bstride = (size_t)BM * K * 2; }
    __device__ __forceinline__ bool next(int i, Unit& u) const {
        const long L = (long)i * G + c; if (L >= nwg) return false;
        int wgid = (int)L; { const int q = nwg / NXCD, r = nwg % NXCD, xcd = wgid % NXCD, off = wgid / NXCD; wgid = (xcd < r ? xcd * (q + 1) : r * (q + 1) + (xcd - r) * q) + off; }
        const int nig = WGM * nN, gid = wgid / nig, fm = gid * WGM, gsz = (nM - fm) < WGM ? (nM - fm) : WGM;
        u.pm = fm + ((wgid % nig) % gsz); u.pn = (wgid % nig) / gsz; u.e = 0; u.cnt = 0; u.row0 = 0; return true;
    }
    __device__ __forceinline__ int arow(const Unit& u, int r) const { return u.pm * BM + r; }
    __device__ __forceinline__ size_t boff(const Unit& u) const { return (size_t)u.pn * bstride; }
};
template <int NPN, bool GATHER> struct GroupOrder {
    const LAS int* pre; const int* cnt; const int* slot_tok; int G, vcu; size_t estride, pstride;
    __device__ __forceinline__ bool next(int i, Unit& u) const {
        const int L = i * G + vcu; const int total = pre[NE1] * NPN; if (L >= total) return false;
        const int T = L / NPN; u.pn = L - T * NPN;
        int lo = 0, hi = NE1;
        while (hi - lo > 1) { const int mid = (lo + hi) >> 1; if (pre[mid] <= T) lo = mid; else hi = mid; }
        u.e = lo; u.pm = T - pre[lo]; u.row0 = pre[lo] * BM; u.cnt = cnt[lo]; return true;
    }
    __device__ __forceinline__ int arow(const Unit& u, int r) const {
        const int s = u.pm * BM + r;
        if (GATHER) { return s < u.cnt ? slot_tok[(size_t)u.e * CAP + s] : 0; }
        else return u.row0 + s;
    }
    __device__ __forceinline__ size_t boff(const Unit& u) const { return (size_t)u.e * estride + (size_t)u.pn * pstride; }
};

template <class Epi, class Sched>
__device__ __forceinline__ void gemm_phase(LAS unsigned char* lds, const bf16_t* Abase, const bf16_t* Bbase, const int K, const Sched& S, const Epi& E) {
    const int tid = threadIdx.x, wid = __builtin_amdgcn_readfirstlane(tid >> 6), lane = tid & 63, wr = wid >> 2, wc = wid & 3, fr = lane & 15, fq = lane >> 4;
    const int nt = K / BK;
    int Rr[2], Cc[2]; unsigned voffB[2];
#pragma unroll
    for (int i = 0; i < 2; ++i) { int R, C; stage_rc(tid * 16 + i * 8192, R, C); Rr[i] = R; Cc[i] = C; const int Rb = Epi::PERM ? ((R & ~31) + perm32(R & 31)) : R; voffB[i] = (unsigned)(Rb * K + C) * 2u; }
    const size_t kstep = (size_t)(BK * 2);
    const size_t hstep = (size_t)HALF * K * 2;
    const unsigned ldsw = (unsigned)wid * 1024u;
    const int aoff = lds_byte(wr * 64 + fr, fq * 8), boff = lds_byte(wc * 32 + fr, fq * 8);
#define PG8_SA(b, h) (((b) * 2 + (h)) * HTB)
#define PG8_SB(b, h) ((4 + (b) * 2 + (h)) * HTB)
#define PG8_STAGE(bufoff, gbase, voff) do { _Pragma("unroll") for (int _i = 0; _i < 2; ++_i) \
        __builtin_amdgcn_global_load_lds((const unsigned*)((const char*)(gbase) + (voff)[_i]), (LAS unsigned*)(lds + (bufoff) + ldsw + _i * 8192), 16, 0, 0); } while (0)
#define PG8_LDA(dst, b, h) do { _Pragma("unroll") for (int m = 0; m < 4; ++m) _Pragma("unroll") for (int k = 0; k < 2; ++k) dst[m][k] = *(const LAS bf16x8*)(lds + PG8_SA(b, h) + aoff + m * 2048 + k * 1024); } while (0)
#define PG8_LDB(dst, b, h) do { _Pragma("unroll") for (int n = 0; n < 2; ++n) _Pragma("unroll") for (int k = 0; k < 2; ++k) dst[n][k] = *(const LAS bf16x8*)(lds + PG8_SB(b, h) + boff + n * 2048 + k * 1024); } while (0)
#define PG8_MMA(ai, bj, At, Bt) do { __builtin_amdgcn_s_setprio(1); _Pragma("unroll") for (int m = 0; m < 4; ++m) _Pragma("unroll") for (int n = 0; n < 2; ++n) _Pragma("unroll") for (int k = 0; k < 2; ++k) \
        acc[ai][bj][m][n] = __builtin_amdgcn_mfma_f32_16x16x32_bf16(Bt[n][k], At[m][k], acc[ai][bj][m][n], 0, 0, 0); __builtin_amdgcn_s_setprio(0); } while (0)
#define PG8_WAIT_V(n) asm volatile("s_waitcnt vmcnt(" #n ")" ::: "memory")
#define PG8_WAIT_L(n) asm volatile("s_waitcnt lgkmcnt(" #n ")" ::: "memory")
#define PG8_BAR __builtin_amdgcn_s_barrier()
#define PG8_SCHED __builtin_amdgcn_sched_barrier(0)
#define PG8_AOFFS(u, v0, v1) do { _Pragma("unroll") for (int _i = 0; _i < 2; ++_i) { \
        v0[_i] = (unsigned)(((size_t)S.arow(u, Rr[_i]) * K + Cc[_i]) * 2u); v1[_i] = (unsigned)(((size_t)S.arow(u, HALF + Rr[_i]) * K + Cc[_i]) * 2u); } } while (0)
    Unit cur, nxt; int ui = 0;
    if (!S.next(0, cur)) return;
    f32x4 acc[2][2][4][2];
#pragma unroll
    for (int a = 0; a < 2; ++a)
#pragma unroll
        for (int b = 0; b < 2; ++b)
#pragma unroll
            for (int m = 0; m < 4; ++m)
#pragma unroll
                for (int n = 0; n < 2; ++n) acc[a][b][m][n] = (f32x4){0.f, 0.f, 0.f, 0.f};
    bf16x8 At[4][2], B0[2][2], B1[2][2];
    unsigned vA0[2], vA1[2], nA0[2], nA1[2];
    PG8_AOFFS(cur, vA0, vA1);
    bool has_next = S.next(1, nxt);
    if (has_next) { PG8_AOFFS(nxt, nA0, nA1); } else { nA0[0] = vA0[0]; nA0[1] = vA0[1]; nA1[0] = vA1[0]; nA1[1] = vA1[1]; }
    asm volatile("" : "+v"(vA0[0]), "+v"(vA0[1]), "+v"(vA1[0]), "+v"(vA1[1]), "+v"(nA0[0]), "+v"(nA0[1]), "+v"(nA1[0]), "+v"(nA1[1]));
    const char* cA = (const char*)Abase; const char* cB = (const char*)Bbase + S.boff(cur);
    PG8_STAGE(PG8_SB(0, 0), cB, voffB); PG8_STAGE(PG8_SB(0, 1), cB + hstep, voffB); PG8_STAGE(PG8_SA(0, 0), cA, vA0); PG8_STAGE(PG8_SA(0, 1), cA, vA1);
    if (wr == 1) PG8_BAR;
    PG8_WAIT_V(2); PG8_BAR;
    PG8_STAGE(PG8_SB(1, 0), cB + kstep, voffB); PG8_STAGE(PG8_SA(1, 0), cA + kstep, vA0); PG8_STAGE(PG8_SB(1, 1), cB + hstep + kstep, voffB);
    PG8_WAIT_V(6); PG8_BAR;
    for (;;) {
        const char* nB = has_next ? (const char*)Bbase + S.boff(nxt) : cB;
        for (int t = 0; t < nt; t += 2) {
            const bool last = (t == nt - 2);
            const char* a1 = cA + (size_t)(t + 1) * kstep;
            const char* b2 = last ? nB : cB + (size_t)(t + 2) * kstep;
            const char* a2 = last ? cA : cA + (size_t)(t + 2) * kstep;
            const char* a3 = a2 + kstep; const char* b3 = b2 + kstep;
            PG8_LDB(B0, 0, 0); PG8_LDB(B1, 0, 1); PG8_SCHED; PG8_LDA(At, 0, 0); PG8_STAGE(PG8_SA(1, 1), a1, vA1);
            if (last) { vA0[0] = nA0[0]; vA0[1] = nA0[1]; vA1[0] = nA1[0]; vA1[1] = nA1[1]; }
            PG8_WAIT_V(8); PG8_WAIT_L(0); PG8_BAR; PG8_MMA(0, 0, At, B0); PG8_MMA(0, 1, At, B1); PG8_BAR; PG8_SCHED;
            PG8_LDA(At, 0, 1); PG8_STAGE(PG8_SB(0, 0), b2, voffB); PG8_STAGE(PG8_SB(0, 1), b2 + hstep, voffB); PG8_STAGE(PG8_SA(0, 0), a2, vA0);
            PG8_WAIT_V(8); PG8_WAIT_L(0); PG8_BAR; PG8_MMA(1, 0, At, B0); PG8_MMA(1, 1, At, B1); PG8_BAR; PG8_SCHED;
            PG8_LDB(B0, 1, 0); PG8_LDB(B1, 1, 1); PG8_SCHED; PG8_LDA(At, 1, 0); PG8_STAGE(PG8_SA(0, 1), a2, vA1);
            PG8_WAIT_V(8); PG8_WAIT_L(0); PG8_BAR; PG8_MMA(0, 0, At, B0); PG8_MMA(0, 1, At, B1); PG8_BAR; PG8_SCHED;
            PG8_LDA(At, 1, 1); PG8_STAGE(PG8_SB(1, 0), b3, voffB); PG8_STAGE(PG8_SB(1, 1), b3 + hstep, voffB); PG8_STAGE(PG8_SA(1, 0), a3, vA0);
            PG8_WAIT_V(8); PG8_WAIT_L(0); PG8_BAR; PG8_MMA(1, 0, At, B0); PG8_MMA(1, 1, At, B1); PG8_BAR; PG8_SCHED;
        }
        if (wr == 0) PG8_BAR;
        E(acc, cur, wr, wc, fr, fq);
        if (!has_next) break;
#pragma unroll
        for (int a = 0; a < 2; ++a)
#pragma unroll
            for (int b = 0; b < 2; ++b)
#pragma unroll
                for (int m = 0; m < 4; ++m)
#pragma unroll
                    for (int n = 0; n < 2; ++n) acc[a][b][m][n] = (f32x4){0.f, 0.f, 0.f, 0.f};
        cur = nxt; cB = nB; ++ui;
        has_next = S.next(ui + 1, nxt);
        if (has_next) { PG8_AOFFS(nxt, nA0, nA1); }
        asm volatile("" : "+v"(nA0[0]), "+v"(nA0[1]), "+v"(nA1[0]), "+v"(nA1[1]));
        if (wr == 1) PG8_BAR;
    }
    PG8_WAIT_V(0);
    PG8_BAR;
#undef PG8_SA
#undef PG8_SB
#undef PG8_STAGE
#undef PG8_LDA
#undef PG8_LDB
#undef PG8_MMA
#undef PG8_WAIT_V
#undef PG8_WAIT_L
#undef PG8_BAR
#undef PG8_SCHED
#undef PG8_AOFFS
}
}

struct EpiProj {
    static constexpr bool PERM = true;
    bf16_t* proj; const float* rope;
    __device__ __forceinline__ void operator()(const f32x4 (&acc)[2][2][4][2], const pg8::Unit& u, int wr, int wc, int fr, int fq) const {
        const int type = u.pn >> 2;
        const int row0 = u.pm * 256 + wr * 64 + fr, b = row0 >> 11;
        const bool rot = (type == 2 || type == 3) && wc == 0;
        const float sgn = fq < 2 ? -1.f : 1.f;
#pragma unroll
        for (int ai = 0; ai < 2; ++ai)
#pragma unroll
            for (int m = 0; m < 4; ++m) {
                const int s = (row0 + ai * 128 + m * 16) & 2047;
                f32x4 c0, c1, s0, s1;
                if (rot) { const float* cp = rope + s * 16 + 8 * (fq & 1); c0 = *(const f32x4*)cp; c1 = *(const f32x4*)(cp + 4); s0 = *(const f32x4*)(cp + 32768); s1 = *(const f32x4*)(cp + 32768 + 4); }
#pragma unroll
                for (int bj = 0; bj < 2; ++bj) {
                    f32x4 v0 = acc[ai][bj][m][0], v1 = acc[ai][bj][m][1];
                    if (type == 1) {
#pragma unroll
                        for (int j = 0; j < 4; ++j) {
                            { const float x = v0[j]; const float e = __builtin_amdgcn_exp2f(-2.302208198f * (x + 0.044715f * x * x * x)); v0[j] = x * __builtin_amdgcn_rcpf(1.f + e); }
                            { const float x = v1[j]; const float e = __builtin_amdgcn_exp2f(-2.302208198f * (x + 0.044715f * x * x * x)); v1[j] = x * __builtin_amdgcn_rcpf(1.f + e); }
                        }
                    }
                    if (rot) {
                        f32x4 p0, p1;
#pragma unroll
                        for (int j = 0; j < 4; ++j) { p0[j] = __shfl_xor(v0[j], 32); p1[j] = __shfl_xor(v1[j], 32); }
                        v0 = v0 * c0 + sgn * (p0 * s0); v1 = v1 * c1 + sgn * (p1 * s1);
                    }
                    u32x4 w; w.x = cvt_pk_bf16(v0[0], v0[1]); w.y = cvt_pk_bf16(v0[2], v0[3]); w.z = cvt_pk_bf16(v1[0], v1[1]); w.w = cvt_pk_bf16(v1[2], v1[3]);
                    const int g = 2 * u.pn + bj;
                    *(u32x4*)(proj + (((size_t)(b * NGRP + g) * SEQ + s) * 128 + 32 * wc + 8 * fq)) = w;
                }
            }
    }
};
struct EpiY {
    static constexpr bool PERM = false;
    const float* x; float* y; float* rpart;
    __device__ __forceinline__ void operator()(const f32x4 (&acc)[2][2][4][2], const pg8::Unit& u, int wr, int wc, int fr, int fq) const {
        const int row0 = u.pm * 256 + wr * 64 + fr, col0 = u.pn * 256 + wc * 32 + 4 * fq;
#pragma unroll
        for (int ai = 0; ai < 2; ++ai)
#pragma unroll
            for (int m = 0; m < 4; ++m) {
                const int r = row0 + ai * 128 + m * 16; const size_t off = (size_t)r * DM + col0;
                float s1 = 0.f, s2 = 0.f;
#pragma unroll
                for (int bj = 0; bj < 2; ++bj)
#pragma unroll
                    for (int n = 0; n < 2; ++n) {
                        const f32x4 xv = *(const f32x4*)(x + off + bj * 128 + n * 16);
                        const f32x4 o = xv * DN_ALPHA + acc[ai][bj][m][n];
                        *(f32x4*)(y + off + bj * 128 + n * 16) = o;
                        s1 += (o[0] + o[1]) + (o[2] + o[3]); s2 += (o[0] * o[0] + o[1] * o[1]) + (o[2] * o[2] + o[3] * o[3]);
                    }
                s1 += __shfl_xor(s1, 16); s1 += __shfl_xor(s1, 32); s2 += __shfl_xor(s2, 16); s2 += __shfl_xor(s2, 32);
                if (fq == 0) *(f32x2*)(rpart + ((size_t)r * 32 + u.pn * 4 + wc) * 2) = (f32x2){s1, s2};
                asm volatile("" ::: "memory");
            }
    }
};
struct EpiH {
    static constexpr bool PERM = true;
    bf16_t* h;
    __device__ __forceinline__ void operator()(const f32x4 (&acc)[2][2][4][2], const pg8::Unit& u, int wr, int wc, int fr, int fq) const {
        const int row0 = u.row0 + u.pm * 256 + wr * 64 + fr, col0 = u.pn * 128 + wc * 32 + 8 * fq;
#pragma unroll
        for (int ai = 0; ai < 2; ++ai)
#pragma unroll
            for (int m = 0; m < 4; ++m) {
                f32x4 o[2];
#pragma unroll
                for (int n = 0; n < 2; ++n)
#pragma unroll
                    for (int j = 0; j < 4; ++j) { const float g = acc[ai][0][m][n][j], up = acc[ai][1][m][n][j];
                        const float e = __builtin_amdgcn_exp2f(-1.4426950408889634f * g); o[n][j] = g * __builtin_amdgcn_rcpf(1.f + e) * up; }
                u32x4 w; w.x = cvt_pk_bf16(o[0][0], o[0][1]); w.y = cvt_pk_bf16(o[0][2], o[0][3]); w.z = cvt_pk_bf16(o[1][0], o[1][1]); w.w = cvt_pk_bf16(o[1][2], o[1][3]);
                *(u32x4*)(h + (size_t)(row0 + ai * 128 + m * 16) * DEXP + col0) = w;
            }
    }
};
struct EpiPair {
    static constexpr bool PERM = true;
    bf16_t* yp; const float* slot_gate; const int* slot_pair;
    __device__ __forceinline__ void operator()(const f32x4 (&acc)[2][2][4][2], const pg8::Unit& u, int wr, int wc, int fr, int fq) const {
        const int s0 = u.pm * 256 + wr * 64 + fr, col0 = u.pn * 256 + wc * 32 + 8 * fq;
#pragma unroll
        for (int ai = 0; ai < 2; ++ai)
#pragma unroll
            for (int m = 0; m < 4; ++m) {
                const int s = s0 + ai * 128 + m * 16;
                if (s < u.cnt) {
                    const float g = slot_gate[(size_t)u.e * CAP + s]; const int pair = slot_pair[(size_t)u.e * CAP + s];
#pragma unroll
                    for (int bj = 0; bj < 2; ++bj) { const f32x4 v0 = acc[ai][bj][m][0] * g, v1 = acc[ai][bj][m][1] * g;
                        u32x4 w; w.x = cvt_pk_bf16(v0[0], v0[1]); w.y = cvt_pk_bf16(v0[2], v0[3]); w.z = cvt_pk_bf16(v1[0], v1[1]); w.w = cvt_pk_bf16(v1[2], v1[3]);
                        *(u32x4*)(yp + (size_t)pair * DM + col0 + bj * 128) = w; }
                }
            }
    }
};

namespace att {
constexpr float SCALE = 0.08838834764831845f;
constexpr float THR = 8.f;
constexpr int D = 128, NW = 8, QBLK = 32, KVBLK = 64, QB = NW * QBLK;
constexpr int SHM_V = KVBLK * D * 2, SHM_K = KVBLK * D * 2;
constexpr int LDS_BYTES = 2 * SHM_V + 2 * SHM_K + NW * 64 * 4;
#define KSWZ(row, colB) ((row) * 256 + ((colB) ^ (((row) & 7) << 4)))
#define SBAR() __builtin_amdgcn_sched_barrier(0)
__device__ __forceinline__ int v_st(int k, int c) { const int kk = (k & ~0xC) | ((k & 4) << 1) | ((k & 8) >> 1); return ((kk >> 3) * 4 + (c >> 5)) * 512 + ((kk & 7) * 32 + (c & 31)) * 2; }
__device__ __forceinline__ int v_rd_base(int lane) { return ((lane & 3) << 3) | (((lane >> 2) & 3) << 6) | (((lane >> 4) & 1) << 5) | (((lane >> 5) & 1) << 8); }
constexpr int v_rd_off(int d0, int ks, int half) { return d0 * 512 + ks * 4096 + half * 2048; }
__device__ __forceinline__ int crow(int r, int hi) { return (r & 3) + 8 * (r >> 2) + 4 * hi; }
__device__ __forceinline__ unsigned cvtpk(float lo, float hi) { unsigned r; asm volatile("v_cvt_pk_bf16_f32 %0, %1, %2" : "=v"(r) : "v"(lo), "v"(hi)); return r; }
__device__ __forceinline__ bf16x8 load8(const bf16_t* p) { return *reinterpret_cast<const bf16x8*>(p); }
__device__ __forceinline__ void mask_tile(f32x16& p0, f32x16& p1, int dq, unsigned W, unsigned par) {
    const float NEG = -__builtin_inff();
#pragma unroll
    for (int r = 0; r < 16; ++r) {
        const int c = (r & 3) + 8 * (r >> 2);
        const unsigned x0 = (unsigned)(dq - c), x1 = (unsigned)(dq - c - 32);
        if (x0 >= W || (x0 & par)) p0[r] = NEG;
        if (x1 >= W || (x1 & par)) p1[r] = NEG;
    }
}
__device__ __forceinline__ void partialSM(f32x16& p0, f32x16& p1, float& m_reg, float& mn, float& alpha) {
    float pmax = p0[0]; for (int r = 1; r < 16; ++r) pmax = fmaxf(pmax, p0[r]); for (int r = 0; r < 16; ++r) pmax = fmaxf(pmax, p1[r]);
    { auto rr = __builtin_amdgcn_permlane32_swap(__float_as_uint(pmax), __float_as_uint(pmax), false, false);
      pmax = fmaxf(__uint_as_float(rr[0]), __uint_as_float(rr[1])); }
    constexpr float C2 = 1.4426950408889634f * SCALE;
    if (__builtin_expect(__all((pmax - m_reg) * SCALE <= THR), 1)) { mn = m_reg; alpha = 1.f; }
    else { mn = fmaxf(m_reg, pmax); alpha = __builtin_amdgcn_exp2f((m_reg - mn) * C2); m_reg = mn; }
    const float mnL = -mn * C2;
    for (int r = 0; r < 16; ++r) p0[r] = fmaf(p0[r], C2, mnL); for (int r = 0; r < 16; ++r) p1[r] = fmaf(p1[r], C2, mnL);
    for (int r = 0; r < 16; ++r) p0[r] = __builtin_amdgcn_exp2f(p0[r]);
}
__device__ __forceinline__ void finishSM(f32x16& p0, f32x16& p1, float alpha, float& l_reg, bf16x8& pa0, bf16x8& pa1, bf16x8& pa2, bf16x8& pa3) {
    for (int r = 0; r < 16; ++r) p1[r] = __builtin_amdgcn_exp2f(p1[r]);
    float ps = 0; for (int r = 0; r < 16; ++r) ps += p0[r]; for (int r = 0; r < 16; ++r) ps += p1[r];
    { auto rr = __builtin_amdgcn_permlane32_swap(__float_as_uint(ps), __float_as_uint(ps), false, false);
      ps = __uint_as_float(rr[0]) + __uint_as_float(rr[1]); }
    l_reg = l_reg * alpha + ps;
#define PK4(P, B_, OUT) do { unsigned a0 = cvtpk(P[B_+0], P[B_+1]), a1 = cvtpk(P[B_+2], P[B_+3]);                          \
        unsigned b0 = cvtpk(P[B_+4], P[B_+5]), b1 = cvtpk(P[B_+6], P[B_+7]);                                             \
        auto r0 = __builtin_amdgcn_permlane32_swap(a0, b0, false, false); auto r1 = __builtin_amdgcn_permlane32_swap(a1, b1, false, false); \
        u32x4 w = {r0[0], r1[0], r0[1], r1[1]}; OUT = *reinterpret_cast<bf16x8*>(&w); } while (0)
    PK4(p0, 0, pa0); PK4(p0, 8, pa1); PK4(p1, 0, pa2); PK4(p1, 8, pa3);
#undef PK4
}
template <int KB>
__device__ __forceinline__ void qkt(f32x16& p0, f32x16& p1, const char* K_lds, int r32, int hi, const bf16x8* qr, bool act) {
    if (!act) { const float NEG = -__builtin_inff();
#pragma unroll
        for (int r = 0; r < 16; ++r) { p0[r] = NEG; p1[r] = NEG; } return; }
    p0 = f32x16{}; p1 = f32x16{};
    const char* kb[4];
#pragma unroll
    for (int dd = 0; dd < 4; ++dd) kb[dd] = K_lds + KB * SHM_K + KSWZ(r32, (dd * 16 + hi * 8) * 2);
#pragma unroll
    for (int d0 = 0; d0 < 8; ++d0) { const char* a = kb[d0 & 3] + (d0 >> 2) * 128;
        bf16x8 b0 = *reinterpret_cast<const bf16x8*>(a);
        bf16x8 b1 = *reinterpret_cast<const bf16x8*>(a + 32 * 256);
        p0 = __builtin_amdgcn_mfma_f32_32x32x16_bf16(b0, qr[d0], p0, 0, 0, 0);
        p1 = __builtin_amdgcn_mfma_f32_32x32x16_bf16(b1, qr[d0], p1, 0, 0, 0); }
}
template <int VB>
__device__ __forceinline__ void pv_tile(f32x16* o, int vb0, bf16x8 pa0, bf16x8 pa1, bf16x8 pa2, bf16x8 pa3, bool act) {
    if (!act) return;
#define TRRD(dst, off) asm volatile("ds_read_b64_tr_b16 %0, %1 offset:%2" : "=&v"(dst) : "v"(vb0), "i"(off) : "memory")
#define PV_D0(d0) do { s16x4 l0, l1, l2, l3, h0, h1, h2, h3; constexpr int b_ = VB * SHM_V + v_rd_off(d0, 0, 0); \
        TRRD(l0, b_); TRRD(h0, b_ + 2048); TRRD(l1, b_ + 4096); TRRD(h1, b_ + 6144); TRRD(l2, b_ + 8192); TRRD(h2, b_ + 10240); TRRD(l3, b_ + 12288); TRRD(h3, b_ + 14336); \
        asm volatile("s_waitcnt lgkmcnt(0)" ::: "memory"); SBAR(); \
        o[d0] = __builtin_amdgcn_mfma_f32_32x32x16_bf16(pa0, (bf16x8){l0[0], l0[1], l0[2], l0[3], h0[0], h0[1], h0[2], h0[3]}, o[d0], 0, 0, 0);   \
        o[d0] = __builtin_amdgcn_mfma_f32_32x32x16_bf16(pa1, (bf16x8){l1[0], l1[1], l1[2], l1[3], h1[0], h1[1], h1[2], h1[3]}, o[d0], 0, 0, 0);   \
        o[d0] = __builtin_amdgcn_mfma_f32_32x32x16_bf16(pa2, (bf16x8){l2[0], l2[1], l2[2], l2[3], h2[0], h2[1], h2[2], h2[3]}, o[d0], 0, 0, 0);   \
        o[d0] = __builtin_amdgcn_mfma_f32_32x32x16_bf16(pa3, (bf16x8){l3[0], l3[1], l3[2], l3[3], h3[0], h3[1], h3[2], h3[3]}, o[d0], 0, 0, 0); } while (0)
    PV_D0(0); PV_D0(1); PV_D0(2); PV_D0(3);
#undef PV_D0
#undef TRRD
}
struct BlockRef { const bf16_t* H; bf16_t* O; f32x2* ST; int P0, dil, W; };
constexpr size_t KOFF = (size_t)8 * SEQ * 128, VOFF = (size_t)16 * SEQ * 128;
struct Seam { bf16x8 qr[8]; bf16x8 st_v0, st_v1, st_k0, st_k1; };
__device__ __forceinline__ int swa_jlo(int P0, int W) { const int lowk = P0 - W + 1; return lowk > 0 ? lowk / KVBLK : 0; }
#define ROWP(p, rs_, k0, rr) ((p) + (size_t)((k0) + (rr)) * (rs_) + sc)
#define VMW() asm volatile("s_waitcnt vmcnt(0)" ::: "memory")
#define VMWN(n) asm volatile("s_waitcnt vmcnt(%0)" :: "i"(n) : "memory")
#define SLOAD_H(Kp, Vp, rs_, k0) do { S.st_v0 = load8(ROWP(Vp, rs_, k0, sr)); S.st_v1 = load8(ROWP(Vp, rs_, k0, 32 + sr));              \
                         S.st_k0 = load8(ROWP(Kp, rs_, k0, sr)); S.st_k1 = load8(ROWP(Kp, rs_, k0, 32 + sr)); } while (0)
#define SWRITE_HK(bf) do { *(bf16x8*)(K_lds + (bf) * SHM_K + kws) = S.st_k0; *(bf16x8*)(K_lds + (bf) * SHM_K + kws + 32 * 256) = S.st_k1; } while (0)
#define SWRITE_HV(bf) do { *(bf16x8*)(V_lds + (bf) * SHM_V + vst0) = S.st_v0; *(bf16x8*)(V_lds + (bf) * SHM_V + vst1) = S.st_v1; } while (0)
#define SWRITE_H(bf) do { SWRITE_HV(bf); SWRITE_HK(bf); } while (0)
__device__ __forceinline__ void swa_prime(const BlockRef& cur, char* lds, Seam& S) {
    const int tid = threadIdx.x, wid = __builtin_amdgcn_readfirstlane(tid >> 6), lane = tid & 63, r32 = lane & 31, hi = lane >> 5;
    const int sr = tid >> 4, sc = (tid & 15) * 8, kws = KSWZ(sr, sc * 2); char* K_lds = lds + 2 * SHM_V;
    const int kb0 = swa_jlo(cur.P0, cur.W) * KVBLK; const int rs0 = 128 * cur.dil;
    for (int d0 = 0; d0 < 8; ++d0) S.qr[d0] = load8(cur.H + (size_t)(cur.P0 + wid * QBLK + r32) * rs0 + d0 * 16 + hi * 8);
    SLOAD_H(cur.H + KOFF, cur.H + VOFF, rs0, kb0); VMW(); SWRITE_HK(0);
    __syncthreads();
}
__device__ __forceinline__ void swa_block(const BlockRef& cur, const BlockRef& nxt, char* lds, Seam& S) {
    const int tid = threadIdx.x, wid = __builtin_amdgcn_readfirstlane(tid >> 6), lane = tid & 63, r32 = lane & 31, hi = lane >> 5;
    const int W = cur.W; const unsigned par = (W == 256) ? 1u : 0u; const int rs = 128 * cur.dil, ors = 1024 * cur.dil, sst = 8 * cur.dil, skv = SEQ / cur.dil, nrs = 128 * nxt.dil;
    const int j_lo = swa_jlo(cur.P0, W);
    int j_hi = (cur.P0 + QB - 1) / KVBLK + 1; if (j_hi > skv / KVBLK) j_hi = skv / KVBLK;
    const int NT = j_hi - j_lo;
    const int kbn = swa_jlo(nxt.P0, nxt.W) * KVBLK;
    const int qlo = cur.P0 + wid * QBLK, qm = qlo + r32 - 4 * hi;
    char* V_lds = lds; char* K_lds = lds + 2 * SHM_V;
    float* ws = (float*)(lds + 2 * SHM_V + 2 * SHM_K) + wid * 64; float* li_l = ws, * al_l = ws + 32;
    float m_reg = -1e30f, l_reg = 0; f32x16 o[4] = {};
    const int sr = tid >> 4, sc = (tid & 15) * 8, vst0 = v_st(sr, sc), vst1 = v_st(32 + sr, sc), kws = KSWZ(sr, sc * 2);
    const int vb0 = (int)(uintptr_t)V_lds + v_rd_base(lane);
    const bf16_t* Kh = cur.H + KOFF; const bf16_t* Vh = cur.H + VOFF;
#define RESC(a) do { if (__any((a) < 1.f)) { if (hi == 0) al_l[r32] = (a); asm volatile("s_waitcnt lgkmcnt(0)" ::: "memory");              \
                     for (int d_ = 0; d_ < 4; ++d_) for (int r = 0; r < 16; ++r) o[d_][r] *= al_l[crow(r, hi)]; } } while (0)
#define KBASE(t) ((j_lo + (t)) * KVBLK)
#define ACT(t) (KBASE(t) <= qlo + QBLK - 1 && KBASE(t) + KVBLK - 1 >= qlo - W + 1)
#define MASKT(P0_, P1_, t) do { const int kb_ = KBASE(t); if (ACT(t) && (par != 0u || kb_ + KVBLK - 1 > qlo || kb_ <= qlo + QBLK - 1 - W)) mask_tile(P0_, P1_, qm - kb_, (unsigned)W, par); } while (0)
    constexpr int NQL = 8;
#define SEAM_K0() do { VMWN(NQL); SWRITE_HK(0); SBAR(); } while (0)
    f32x16 pA0, pA1, pB0, pB1; float mnA, mnB, alA, alB; bf16x8 pa0, pa1, pa2, pa3;
    SWRITE_HV(0); SBAR();
    if (NT > 1) { SLOAD_H(Kh, Vh, rs, KBASE(1)); }
    SBAR(); qkt<0>(pA0, pA1, K_lds, r32, hi, S.qr, ACT(0));
    MASKT(pA0, pA1, 0); partialSM(pA0, pA1, m_reg, mnA, alA);
    if (NT > 1) { VMW(); SWRITE_H(1); }
    __syncthreads();
#define HALF_STEP(PX0, PX1, mnX, alX, PY0, PY1, alY, t, KB, VB, SB) do {                                                      \
        SBAR(); qkt<KB>(PX0, PX1, K_lds, r32, hi, S.qr, ACT(t));                                                             \
        finishSM(PY0, PY1, alY, l_reg, pa0, pa1, pa2, pa3); SBAR();                                                           \
        if ((t) + 1 < NT) { SLOAD_H(Kh, Vh, rs, KBASE((t) + 1)); SBAR(); }                                                    \
        pv_tile<VB>(o, vb0, pa0, pa1, pa2, pa3, ACT((t) - 1)); MASKT(PX0, PX1, (t)); partialSM(PX0, PX1, m_reg, mnX, alX);    \
        __syncthreads();                                                                                                      \
        if ((t) + 1 < NT) { VMW(); SWRITE_H(SB); }                                                                            \
        RESC(alX); __syncthreads(); } while (0)
    for (int t = 1; t + 1 < NT; t += 2) {
        HALF_STEP(pB0, pB1, mnB, alB, pA0, pA1, alA, t, 1, 0, 0);
        HALF_STEP(pA0, pA1, mnA, alA, pB0, pB1, alB, t + 1, 0, 1, 1);
    }
    const bool even = (NT & 1) == 0;
    if (even) { SBAR(); qkt<1>(pB0, pB1, K_lds, r32, hi, S.qr, ACT(NT - 1)); SBAR(); }
    SLOAD_H(nxt.H + KOFF, nxt.H + VOFF, nrs, kbn); SBAR();
#pragma unroll
    for (int d0 = 0; d0 < 8; ++d0) S.qr[d0] = load8(nxt.H + (size_t)(nxt.P0 + wid * QBLK + r32) * nrs + d0 * 16 + hi * 8);
    SBAR();
    finishSM(pA0, pA1, alA, l_reg, pa0, pa1, pa2, pa3); SBAR();
    pv_tile<0>(o, vb0, pa0, pa1, pa2, pa3, ACT(even ? NT - 2 : NT - 1));
    if (even) { MASKT(pB0, pB1, NT - 1); partialSM(pB0, pB1, m_reg, mnB, alB); __syncthreads(); RESC(alB);
        finishSM(pB0, pB1, alB, l_reg, pa0, pa1, pa2, pa3); SBAR(); pv_tile<1>(o, vb0, pa0, pa1, pa2, pa3, ACT(NT - 1)); }
    SBAR(); SEAM_K0();
    if (hi == 0) { li_l[r32] = l_reg; cur.ST[(size_t)(wid * QBLK + r32) * sst] = (f32x2){m_reg, l_reg}; }
    asm volatile("s_waitcnt lgkmcnt(0)" ::: "memory");
    float rli[16];
#pragma unroll
    for (int r = 0; r < 16; ++r) rli[r] = __builtin_amdgcn_rcpf(li_l[crow(r, hi)]);
    bf16_t* Ow = cur.O + (size_t)(wid * QBLK) * ors;
#pragma unroll
    for (int r = 0; r < 16; ++r) { const int orow = crow(r, hi);
#pragma unroll
        for (int d0 = 0; d0 < 4; ++d0) { const float v = o[d0][r] * rli[r];
            const float vn = __shfl_xor(v, 1);
            if ((r32 & 1) == 0) *(unsigned*)(Ow + (size_t)orow * ors + d0 * 32 + r32) = cvtpk(v, vn); } }
    __syncthreads();
#undef RESC
#undef KBASE
#undef ACT
#undef MASKT
#undef SEAM_K0
#undef HALF_STEP
}
#undef ROWP
#undef VMW
#undef VMWN
#undef SLOAD_H
#undef SWRITE_HK
#undef SWRITE_HV
#undef SWRITE_H
}

struct Args {
    const float* x; const float* w_in; const float* conv_w; const float* conv_b; const float* w_rg_a; const float* b_rg_a; const float* w_rg_x; const float* b_rg_x;
    const float* lru_lambda; const float* w_out; const float* ln1_g; const float* ln1_b; const float* w_router; const float* router_bias;
    const float* w_gate; const float* w_up; const float* w_down; const float* ws_gate; const float* ws_up; const float* ws_down; const float* ln2_g; const float* ln2_b;
    float* out; unsigned char* ws; int ph_lo, ph_hi, coop, pad;
};

struct TrItem { const float* src; bf16_t* dst; int ld, ldd, k0, n0, dst_row0; };
__device__ __forceinline__ void tr_load(const TrItem& it, int lane, f32x4 (&v)[16]) {
    const float* p = it.src + (size_t)(it.k0 + (lane >> 4)) * it.ld + it.n0 + (lane & 15) * 4;
#pragma unroll
    for (int i = 0; i < 16; ++i) v[i] = *(const f32x4*)(p + (size_t)(4 * i) * it.ld);
}
__device__ __forceinline__ void tr_store(const TrItem& it, int lane, const f32x4 (&v)[16], LAS float* scr, int mode, size_t lo_off) {
    const int r = lane >> 4, c4 = (lane & 15) * 4;
#pragma unroll
    for (int i = 0; i < 16; ++i)
#pragma unroll
        for (int j = 0; j < 4; ++j) scr[(c4 + j) * 65 + 4 * i + r] = v[i][j];
    LDS_WAIT(); asm volatile("" ::: "memory");
    const int kc = lane & 7;
#pragma unroll
    for (int p = 0; p < 8; ++p) {
        const int n = (lane >> 3) + 8 * p; const LAS float* s = scr + n * 65 + 8 * kc;
        float f[8];
#pragma unroll
        for (int j = 0; j < 8; ++j) f[j] = s[j];
        u32x4 o; o.x = cvt_pk_bf16(f[0], f[1]); o.y = cvt_pk_bf16(f[2], f[3]); o.z = cvt_pk_bf16(f[4], f[5]); o.w = cvt_pk_bf16(f[6], f[7]);
        bf16_t* d = it.dst + (size_t)(it.dst_row0 + n) * it.ldd + it.k0 + 8 * kc;
        *(u32x4*)d = o;
        if (mode == 1) {
            u32x4 l; l.x = cvt_pk_bf16(f[0] - bflo(o.x), f[1] - bfhi(o.x)); l.y = cvt_pk_bf16(f[2] - bflo(o.y), f[3] - bfhi(o.y));
            l.z = cvt_pk_bf16(f[4] - bflo(o.z), f[5] - bfhi(o.z)); l.w = cvt_pk_bf16(f[6] - bflo(o.w), f[7] - bfhi(o.w));
            *(u32x4*)(d + lo_off) = l;
        }
    }
    LDS_WAIT(); asm volatile("" ::: "memory");
}
constexpr int IT_WIN = 32 * 80, IT_WOUT = 32 * 32, IT_GU1 = 32 * 8, IT_GU = NE1 * 2 * IT_GU1, IT_D1 = 8 * 32, IT_D = NE1 * IT_D1, IT_RG = 8 * 2 * 4, IT_RT = 32;
constexpr int IT_TOTAL = IT_WIN + IT_WOUT + IT_GU + IT_D + IT_RG + IT_RT;
__device__ __forceinline__ int tr_decode(const Args& a, int it, TrItem& t) {
    unsigned char* ws = a.ws;
    if (it < IT_WIN) { t.src = a.w_in; t.ld = NPROJ; t.k0 = (it / 80) * 64; t.n0 = (it % 80) * 64; t.dst = (bf16_t*)(ws + WS_WIN); t.ldd = DM; t.dst_row0 = t.n0; return 0; }
    it -= IT_WIN;
    if (it < IT_WOUT) { t.src = a.w_out; t.ld = DM; t.k0 = (it / 32) * 64; t.n0 = (it % 32) * 64; t.dst = (bf16_t*)(ws + WS_WOUT); t.ldd = DM; t.dst_row0 = t.n0; return 0; }
    it -= IT_WOUT;
    if (it < IT_GU) { const int e = it / (2 * IT_GU1), r = it % (2 * IT_GU1), up = r / IT_GU1, q = r % IT_GU1;
        const float* src = e < NEXP ? (up ? a.w_up : a.w_gate) + (size_t)e * DM * DEXP : (up ? a.ws_up : a.ws_gate);
        t.src = src; t.ld = DEXP; t.k0 = (q / 8) * 64; t.n0 = (q % 8) * 64; t.dst = (bf16_t*)(ws + WS_WGU) + (size_t)e * 1024 * DM; t.ldd = DM;
        t.dst_row0 = (t.n0 >> 7) * 256 + up * 128 + (t.n0 & 127); return 0; }
    it -= IT_GU;
    if (it < IT_D) { const int e = it / IT_D1, q = it % IT_D1;
        t.src = e < NEXP ? a.w_down + (size_t)e * DEXP * DM : a.ws_down; t.ld = DM; t.k0 = (q / 32) * 64; t.n0 = (q % 32) * 64;
        t.dst = (bf16_t*)(ws + WS_WD) + (size_t)e * DM * DEXP; t.ldd = DEXP; t.dst_row0 = t.n0; return 0; }
    it -= IT_D;
    if (it < IT_RG) { const int n = it / 8, r = it % 8, mat = r / 4, q = r % 4;
        t.src = (mat ? a.w_rg_x : a.w_rg_a) + (size_t)n * 128 * 128; t.ld = 128; t.k0 = (q / 2) * 64; t.n0 = (q % 2) * 64;
        t.dst = (bf16_t*)(ws + WS_WRG) + (size_t)n * 256 * 128; t.ldd = 128; t.dst_row0 = mat * 128 + t.n0; return 0; }
    it -= IT_RG;
    t.src = a.w_router; t.ld = NEXP; t.k0 = it * 64; t.n0 = 0; t.dst = (bf16_t*)(ws + WS_WR); t.ldd = DM; t.dst_row0 = 0; return 1;
}
__device__ __forceinline__ void p0_phase(const Args& a, LAS unsigned char* lds, int vcu, int G) {
    const int tid = threadIdx.x, lane = tid & 63, wave = __builtin_amdgcn_readfirstlane(tid >> 6);
    unsigned char* ws = a.ws;
    const int gt = vcu * NTHR + tid, NGT = G * NTHR;
    { unsigned* ctl = (unsigned*)(ws + WS_CTL);
      for (int i = gt; i < CW_BAR; i += NGT) ctl[i] = (i == CW_CNT + NEXP) ? (unsigned)NTOK : 0u;
      int* st = (int*)(ws + WS_SLOT) + (size_t)NEXP * CAP; float* sg = (float*)(ws + WS_SLOT + SLOT_ARR) + (size_t)NEXP * CAP; int* sp = (int*)(ws + WS_SLOT + 2 * SLOT_ARR) + (size_t)NEXP * CAP;
      for (int i = gt; i < NTOK; i += NGT) { st[i] = i; sg[i] = 1.f; sp[i] = i * NPAIR + 8; }
      float* tab = (float*)(ws + WS_TAB);
      for (int i = gt; i < 2048 * 16; i += NGT) { const int pos = i >> 4, j = i & 15;
          const double inv = pow(500000.0, -(double)j / 16.0), ang = (double)pos * inv; tab[i] = (float)cos(ang); tab[32768 + i] = (float)sin(ang); }
      for (int i = gt; i < 1024; i += NGT) { const float lam = a.lru_lambda[i]; tab[65536 + i] = 8.0f * log1pf(expf(-lam)); }
    }
    { const f32x4* xs = (const f32x4*)a.x; u32x4* xd = (u32x4*)(ws + WS_XB);
      constexpr int NCH = NTOK * DM / 8;
      for (int i = gt; i < NCH; i += NGT) { const f32x4 v0 = xs[2 * i], v1 = xs[2 * i + 1];
          u32x4 o; o.x = cvt_pk_bf16(v0[0], v0[1]); o.y = cvt_pk_bf16(v0[2], v0[3]); o.z = cvt_pk_bf16(v1[0], v1[1]); o.w = cvt_pk_bf16(v1[2], v1[3]); xd[i] = o; }
    }
    LAS float* scr = (LAS float*)(lds + wave * 16640);
    const int gw = vcu * NWAVES + wave, NGW = G * NWAVES;
    int it = gw;
    if (it < IT_TOTAL) {
        TrItem cur; int mode = tr_decode(a, it, cur); f32x4 v[16]; tr_load(cur, lane, v);
        for (;;) {
            const int itn = it + NGW; const bool more = itn < IT_TOTAL;
            TrItem nxt = cur; int moden = mode; f32x4 vn[16];
            if (more) { moden = tr_decode(a, itn, nxt); tr_load(nxt, lane, vn); }
            tr_store(cur, lane, v, scr, mode, (size_t)NEXP * DM);
            if (!more) break;
            cur = nxt; mode = moden; it = itn;
#pragma unroll
            for (int i = 0; i < 16; ++i) v[i] = vn[i];
        }
    }
}

constexpr int LRU_XC = 0, LRU_XCP = 272, LRU_AA = 69632, LRU_UU = LRU_AA + 32768, LRU_SA = LRU_UU + 32768, LRU_SH = LRU_SA + 2048, LRU_CARRY = LRU_SH + 2048;
static_assert(LRU_CARRY + 256 <= LDS_BYTES, "LRU LDS map");
__device__ __forceinline__ void lru_item(const Args& a, char* lds, int item) {
    const int tid = threadIdx.x, lane = tid & 63, wave = __builtin_amdgcn_readfirstlane(tid >> 6), r32 = lane & 31, hi = lane >> 5;
    const int b = item >> 5, n = (item >> 2) & 7, cq = item & 3;
    unsigned char* ws = a.ws;
    const bf16_t* proj = (const bf16_t*)(ws + WS_PROJ);
    const bf16_t* xl = proj + (size_t)(b * NGRP + n) * SEQ * 128;
    const bf16_t* gl = proj + (size_t)(b * NGRP + 8 + n) * SEQ * 128;
    bf16_t* mix = (bf16_t*)(ws + WS_MIX) + (size_t)b * SEQ * DM + n * 128 + cq * 32;
    const float* tab = (const float*)(ws + WS_TAB);
    char* XC = lds + LRU_XC; float* AA = (float*)(lds + LRU_AA); float* UU = (float*)(lds + LRU_UU); float* SA = (float*)(lds + LRU_SA); float* SH = (float*)(lds + LRU_SH); float* CARRY = (float*)(lds + LRU_CARRY);
    const bf16_t* wt = (const bf16_t*)(ws + WS_WRG) + (size_t)n * 256 * 128;
    const int chd = n * 128 + cq * 32 + r32;
    const float ba = a.b_rg_a[chd], bx = a.b_rg_x[chd], sp8 = tab[65536 + chd];
    const int cg8 = tid & 15, tg = tid >> 4;
    float cw[4][8], cb[8];
#pragma unroll
    for (int j = 0; j < 4; ++j)
#pragma unroll
        for (int c = 0; c < 8; ++c) cw[j][c] = a.conv_w[j * 1024 + n * 128 + cg8 * 8 + c];
#pragma unroll
    for (int c = 0; c < 8; ++c) cb[c] = a.conv_b[n * 128 + cg8 * 8 + c];
    if (tid < 32) CARRY[tid] = 0.f;
    const int sd = tid & 31, seg = tid >> 5;
    for (int ch = 0; ch < 8; ++ch) {
        const int s0 = ch * 256;
        { u32x4 xr[11];
#pragma unroll
          for (int i = 0; i < 11; ++i) { const int s = s0 + tg * 8 + i - 3;
              xr[i] = (u32x4){0u, 0u, 0u, 0u}; if (s >= 0) xr[i] = *(const u32x4*)(xl + (size_t)s * 128 + cg8 * 8); }
#pragma unroll
          for (int i = 0; i < 8; ++i) { float o[8];
#pragma unroll
              for (int c = 0; c < 8; ++c) o[c] = cb[c];
#pragma unroll
              for (int j = 0; j < 4; ++j) { const u32x4 w = xr[i + j];
                  o[0] += cw[j][0] * bflo(w.x); o[1] += cw[j][1] * bfhi(w.x); o[2] += cw[j][2] * bflo(w.y); o[3] += cw[j][3] * bfhi(w.y);
                  o[4] += cw[j][4] * bflo(w.z); o[5] += cw[j][5] * bfhi(w.z); o[6] += cw[j][6] * bflo(w.w); o[7] += cw[j][7] * bfhi(w.w); }
              u32x4 w; w.x = cvt_pk_bf16(o[0], o[1]); w.y = cvt_pk_bf16(o[2], o[3]); w.z = cvt_pk_bf16(o[4], o[5]); w.w = cvt_pk_bf16(o[6], o[7]);
              *(u32x4*)(XC + (tg * 8 + i) * LRU_XCP + cg8 * 16) = w; } }
        __syncthreads();
        { f32x16 ga = {}, gx = {};
          bf16x8 Ba[8], Bx[8];
#pragma unroll
          for (int ks = 0; ks < 8; ++ks) { Ba[ks] = *(const bf16x8*)(wt + (size_t)(cq * 32 + r32) * 128 + ks * 16 + hi * 8); Bx[ks] = *(const bf16x8*)(wt + (size_t)(128 + cq * 32 + r32) * 128 + ks * 16 + hi * 8); }
#pragma unroll
          for (int ks = 0; ks < 8; ++ks) { const bf16x8 af = *(const bf16x8*)(XC + (wave * 32 + r32) * LRU_XCP + (ks * 16 + hi * 8) * 2);
              ga = __builtin_amdgcn_mfma_f32_32x32x16_bf16(af, Ba[ks], ga, 0, 0, 0); gx = __builtin_amdgcn_mfma_f32_32x32x16_bf16(af, Bx[ks], gx, 0, 0, 0); }
#pragma unroll
          for (int r = 0; r < 16; ++r) { const int tok = wave * 32 + att::crow(r, hi);
              const float ra = __builtin_amdgcn_rcpf(1.f + __expf(-(ga[r] + ba))), ix = __builtin_amdgcn_rcpf(1.f + __expf(-(gx[r] + bx)));
              const float la = -ra * sp8, av = __expf(la), mult = sqrtf(-expm1f(2.f * la));
              const float xcv = bf2f(*(const unsigned short*)(XC + tok * LRU_XCP + (cq * 32 + r32) * 2));
              AA[tok * 32 + r32] = av; UU[tok * 32 + r32] = mult * ix * xcv; } }
        __syncthreads();
        { float av[16], uv[16]; float Ap = 1.f, Hp = 0.f;
          unsigned short glv[16];
#pragma unroll
          for (int i = 0; i < 16; ++i) glv[i] = gl[(size_t)(s0 + seg * 16 + i) * 128 + cq * 32 + sd];
#pragma unroll
          for (int i = 0; i < 16; ++i) { av[i] = AA[(seg * 16 + i) * 32 + sd]; uv[i] = UU[(seg * 16 + i) * 32 + sd]; Hp = av[i] * Hp + uv[i]; Ap *= av[i]; }
          SA[seg * 32 + sd] = Ap; SH[seg * 32 + sd] = Hp;
          __syncthreads();
          float carry = CARRY[(ch & 1) * 32 + sd];
          for (int s2 = 0; s2 < seg; ++s2) carry = SA[s2 * 32 + sd] * carry + SH[s2 * 32 + sd];
#pragma unroll
          for (int i = 0; i < 16; ++i) { carry = av[i] * carry + uv[i];
              mix[(size_t)(s0 + seg * 16 + i) * DM + sd] = (bf16_t)(cvt_pk_bf16(carry * bf2f(glv[i]), 0.f) & 0xffffu); }
          if (seg == 15) CARRY[((ch + 1) & 1) * 32 + sd] = carry; }
    }
    __syncthreads();
}

__device__ __forceinline__ att::BlockRef att_ref(const Args& a, int L) {
    unsigned char* ws = a.ws;
    const int p = L >> 9, q = L & 511, bh = q >> 3, sub = q & 7, b = bh >> 3, h = bh & 7;
    int dil, cls, qb;
    if (p == 0) { dil = 1; cls = 0; qb = sub; } else if (p == 1) { dil = 4; cls = sub >> 1; qb = sub & 1; } else { dil = 8; cls = sub; qb = 0; }
    const bf16_t* proj = (const bf16_t*)(ws + WS_PROJ);
    att::BlockRef r;
    r.H = proj + (size_t)(b * NGRP + 16 + h) * SEQ * 128 + cls * 128;
    r.dil = dil; r.W = (p == 2) ? 256 : 129; r.P0 = qb * 256;
    const size_t tok0 = (size_t)b * SEQ + cls + (size_t)qb * 256 * dil;
    r.O = (bf16_t*)a.out + (size_t)p * NTOK * 1024 + tok0 * 1024 + h * 128;
    r.ST = (f32x2*)(ws + WS_ASTAT) + (size_t)p * NTOK * 8 + tok0 * 8 + h;
    return r;
}
__device__ __forceinline__ void att_phase(const Args& a, char* lds, int c, int G) {
    constexpr int TOTAL = 3 * 512;
    int L = c; if (L >= TOTAL) return;
    att::BlockRef cur = att_ref(a, L);
    att::Seam S;
    att::swa_prime(cur, lds, S);
    for (;;) {
        const bool more = L + G < TOTAL;
        const att::BlockRef nxt = more ? att_ref(a, L + G) : cur;
        att::swa_block(cur, nxt, lds, S);
        if (!more) break;
        cur = nxt; L += G;
    }
}
__device__ __forceinline__ void merge_phase(const Args& a, int vcu, int G) {
    unsigned char* ws = a.ws;
    const int gt = vcu * NTHR + threadIdx.x, NGT = G * NTHR;
    const f32x2* st = (const f32x2*)(ws + WS_ASTAT); const bf16_t* op = (const bf16_t*)a.out; bf16_t* mix = (bf16_t*)(ws + WS_MIX);
    constexpr float C2 = 1.4426950408889634f * att::SCALE;
    for (int i = gt; i < NTOK * 8 * 16; i += NGT) {
        const int c = i & 15, th = i >> 4, t = th >> 3, h = th & 7;
        const f32x2 s0 = st[th], s1 = st[(size_t)NTOK * 8 + th], s2 = st[(size_t)2 * NTOK * 8 + th];
        const float mx = fmaxf(s0.x, fmaxf(s1.x, s2.x));
        const float w0 = s0.y * __builtin_amdgcn_exp2f((s0.x - mx) * C2), w1 = s1.y * __builtin_amdgcn_exp2f((s1.x - mx) * C2), w2 = s2.y * __builtin_amdgcn_exp2f((s2.x - mx) * C2);
        const float inv = 1.f / (w0 + w1 + w2);
        const size_t off = (size_t)t * 1024 + h * 128 + c * 8;
        const u32x4 a0 = *(const u32x4*)(op + off), a1 = *(const u32x4*)(op + (size_t)NTOK * 1024 + off), a2 = *(const u32x4*)(op + (size_t)2 * NTOK * 1024 + off);
        u32x4 o;
#define MRG(f) f = cvt_pk_bf16((w0 * bflo(a0.f) + w1 * bflo(a1.f) + w2 * bflo(a2.f)) * inv, (w0 * bfhi(a0.f) + w1 * bfhi(a1.f) + w2 * bfhi(a2.f)) * inv)
        o.MRG(x); o.MRG(y); o.MRG(z); o.MRG(w);
#undef MRG
        *(u32x4*)(mix + (size_t)t * DM + 1024 + h * 128 + c * 8) = o;
    }
}

__device__ __forceinline__ void p4_phase(const Args& a, char* lds, int vcu, int G) {
    const int tid = threadIdx.x, lane = tid & 63, wave = __builtin_amdgcn_readfirstlane(tid >> 6), r32 = lane & 31, hi = lane >> 5;
    unsigned char* ws = a.ws;
    const float* Y = a.out; bf16_t* X1 = (bf16_t*)(ws + WS_X1); const float* rpart = (const float*)(ws + WS_RPART);
    const bf16_t* WRh = (const bf16_t*)(ws + WS_WR); const bf16_t* WRl = WRh + (size_t)NEXP * DM;
    float* RED = (float*)lds;
    unsigned* cnt = (unsigned*)(ws + WS_CTL) + CW_CNT;
    int* slot_tok = (int*)(ws + WS_SLOT); float* slot_gate = (float*)(ws + WS_SLOT + SLOT_ARR); int* slot_pair = (int*)(ws + WS_SLOT + 2 * SLOT_ARR);
    const int wm = wave & 1, wk = wave >> 1;
    for (int tile = vcu; tile < NTOK / 64; tile += G) {
        const int t0 = tile * 64, row = t0 + 32 * wm + r32;
        float s1 = 0.f, s2 = 0.f;
        { const f32x4* rp = (const f32x4*)(rpart + (size_t)row * 64);
#pragma unroll
          for (int i = 0; i < 16; ++i) { const f32x4 v = rp[i]; s1 += v[0] + v[2]; s2 += v[1] + v[3]; } }
        const float mean = s1 * (1.f / DM), var = s2 * (1.f / DM) - mean * mean, rstd = 1.f / sqrtf(var + LN_EPS);
        const int kbase = 512 * wk + 256 * hi;
        const float* yrow = Y + (size_t)row * DM + kbase; bf16_t* x1row = X1 + (size_t)row * DM + kbase;
        const float* gp = a.ln1_g + kbase; const float* bp = a.ln1_b + kbase;
        const bf16_t* wh0 = WRh + (size_t)r32 * DM + kbase; const bf16_t* wh1 = WRh + (size_t)(32 + r32) * DM + kbase;
        const bf16_t* wl0 = WRl + (size_t)r32 * DM + kbase; const bf16_t* wl1 = WRl + (size_t)(32 + r32) * DM + kbase;
        f32x16 acc0 = {}, acc1 = {};
#pragma unroll 2
        for (int i = 0; i < 32; ++i) {
            const int k = 8 * i;
            const f32x4 v0 = *(const f32x4*)(yrow + k), v1 = *(const f32x4*)(yrow + k + 4);
            const f32x4 g0 = *(const f32x4*)(gp + k), g1 = *(const f32x4*)(gp + k + 4), b0 = *(const f32x4*)(bp + k), b1 = *(const f32x4*)(bp + k + 4);
            const f32x4 x0 = (v0 - mean) * rstd * g0 + b0, x1v = (v1 - mean) * rstd * g1 + b1;
            u32x4 hw; hw.x = cvt_pk_bf16(x0[0], x0[1]); hw.y = cvt_pk_bf16(x0[2], x0[3]); hw.z = cvt_pk_bf16(x1v[0], x1v[1]); hw.w = cvt_pk_bf16(x1v[2], x1v[3]);
            u32x4 lw; lw.x = cvt_pk_bf16(x0[0] - bflo(hw.x), x0[1] - bfhi(hw.x)); lw.y = cvt_pk_bf16(x0[2] - bflo(hw.y), x0[3] - bfhi(hw.y));
            lw.z = cvt_pk_bf16(x1v[0] - bflo(hw.z), x1v[1] - bfhi(hw.z)); lw.w = cvt_pk_bf16(x1v[2] - bflo(hw.w), x1v[3] - bfhi(hw.w));
            *(u32x4*)(x1row + k) = hw;
            const bf16x8 Ah = *reinterpret_cast<const bf16x8*>(&hw), Al = *reinterpret_cast<const bf16x8*>(&lw);
            const bf16x8 Bh0 = *(const bf16x8*)(wh0 + k), Bh1 = *(const bf16x8*)(wh1 + k), Bl0 = *(const bf16x8*)(wl0 + k), Bl1 = *(const bf16x8*)(wl1 + k);
            acc0 = __builtin_amdgcn_mfma_f32_32x32x16_bf16(Ah, Bh0, acc0, 0, 0, 0); acc0 = __builtin_amdgcn_mfma_f32_32x32x16_bf16(Ah, Bl0, acc0, 0, 0, 0); acc0 = __builtin_amdgcn_mfma_f32_32x32x16_bf16(Al, Bh0, acc0, 0, 0, 0);
            acc1 = __builtin_amdgcn_mfma_f32_32x32x16_bf16(Ah, Bh1, acc1, 0, 0, 0); acc1 = __builtin_amdgcn_mfma_f32_32x32x16_bf16(Ah, Bl1, acc1, 0, 0, 0); acc1 = __builtin_amdgcn_mfma_f32_32x32x16_bf16(Al, Bh1, acc1, 0, 0, 0);
        }
        __syncthreads();
#pragma unroll
        for (int r = 0; r < 16; ++r) { const int rr = 32 * wm + att::crow(r, hi);
            RED[(wk * 64 + rr) * 65 + r32] = acc0[r]; RED[(wk * 64 + rr) * 65 + 32 + r32] = acc1[r]; }
        __syncthreads();
        if (tid < 64) {
            const int t = t0 + tid; const float NEG = -__builtin_inff();
            float sel[64];
#pragma unroll
            for (int e = 0; e < 64; ++e) sel[e] = RED[(0 * 64 + tid) * 65 + e];
#pragma unroll
            for (int q = 1; q < 4; ++q) {
#pragma unroll
                for (int e = 0; e < 64; ++e) { sel[e] += RED[(q * 64 + tid) * 65 + e]; }
#pragma unroll
                for (int e = 0; e < 64; ++e) asm volatile("" : "+v"(sel[e])); }
#pragma unroll
            for (int e = 0; e < 64; ++e) { sel[e] = __builtin_amdgcn_rcpf(1.f + __expf(-sel[e])) + a.router_bias[e]; asm volatile("" : "+v"(sel[e])); }
            float gs[8];
#pragma unroll
            for (int g = 0; g < 8; ++g) { float m1 = NEG, m2 = NEG;
#pragma unroll
                for (int j = 0; j < 8; ++j) { const float v = sel[8 * g + j]; if (v > m1) { m2 = m1; m1 = v; } else if (v > m2) m2 = v; }
                gs[g] = m1 + m2; }
            unsigned gm = 0u;
#pragma unroll
            for (int it = 0; it < 4; ++it) { float best = NEG; int bi = 0;
#pragma unroll
                for (int g = 0; g < 8; ++g) if (!((gm >> g) & 1u) && gs[g] > best) { best = gs[g]; bi = g; }
                gm |= 1u << bi; }
#pragma unroll
            for (int e = 0; e < 64; ++e) if (!((gm >> (e >> 3)) & 1u)) sel[e] = NEG;
            int idx[8]; float gk[8]; float gsum = 0.f;
#pragma unroll
            for (int k = 0; k < 8; ++k) { float best = NEG; int bi = 0;
#pragma unroll
                for (int e = 0; e < 64; ++e) if (sel[e] > best) { best = sel[e]; bi = e; }
#pragma unroll
                for (int e = 0; e < 64; ++e) if (e == bi) sel[e] = NEG;
                const float bsc = best - a.router_bias[bi];
                idx[k] = bi; gk[k] = bsc; gsum += bsc; }
            const float gmul = 2.5f / gsum;
#pragma unroll
            for (int k = 0; k < 8; ++k) { const int e = idx[k]; const unsigned pos = atomicAdd(cnt + e, 1u);
                slot_tok[(size_t)e * CAP + pos] = t; slot_gate[(size_t)e * CAP + pos] = gk[k] * gmul; slot_pair[(size_t)e * CAP + pos] = t * NPAIR + k; }
        }
    }
    __syncthreads();
}

__device__ __forceinline__ void p8_phase(const Args& a, int vcu, int G) {
    const int tid = threadIdx.x, lane = tid & 63, wave = __builtin_amdgcn_readfirstlane(tid >> 6);
    unsigned char* ws = a.ws;
    const bf16_t* YP = (const bf16_t*)(ws + WS_BIG); const bf16_t* X1 = (const bf16_t*)(ws + WS_X1);
    const int gw = vcu * NWAVES + wave, NGW = G * NWAVES;
    f32x4 g2[8], b2[8];
#pragma unroll
    for (int j = 0; j < 4; ++j) { g2[2 * j] = *(const f32x4*)(a.ln2_g + 512 * j + 8 * lane); g2[2 * j + 1] = *(const f32x4*)(a.ln2_g + 512 * j + 8 * lane + 4);
        b2[2 * j] = *(const f32x4*)(a.ln2_b + 512 * j + 8 * lane); b2[2 * j + 1] = *(const f32x4*)(a.ln2_b + 512 * j + 8 * lane + 4); }
    for (int row = gw; row < NTOK; row += NGW) {
        f32x4 v[8];
        { const bf16_t* xr = X1 + (size_t)row * DM + 8 * lane;
#pragma unroll
          for (int j = 0; j < 4; ++j) { const u32x4 w = *(const u32x4*)(xr + 512 * j);
              v[2 * j] = (f32x4){bflo(w.x), bfhi(w.x), bflo(w.y), bfhi(w.y)} * DN_ALPHA; v[2 * j + 1] = (f32x4){bflo(w.z), bfhi(w.z), bflo(w.w), bfhi(w.w)} * DN_ALPHA; } }
#pragma unroll
        for (int p = 0; p < NPAIR; ++p) { const bf16_t* yr = YP + ((size_t)row * NPAIR + p) * DM + 8 * lane;
#pragma unroll
            for (int j = 0; j < 4; ++j) { const u32x4 w = *(const u32x4*)(yr + 512 * j);
                v[2 * j] += (f32x4){bflo(w.x), bfhi(w.x), bflo(w.y), bfhi(w.y)}; v[2 * j + 1] += (f32x4){bflo(w.z), bfhi(w.z), bflo(w.w), bfhi(w.w)}; } }
        float s = 0.f;
#pragma unroll
        for (int j = 0; j < 8; ++j) s += (v[j][0] + v[j][1]) + (v[j][2] + v[j][3]);
        const float mean = wave_sum(s) * (1.f / DM); float q = 0.f;
#pragma unroll
        for (int j = 0; j < 8; ++j) { v[j] = v[j] - mean; q += (v[j][0] * v[j][0] + v[j][1] * v[j][1]) + (v[j][2] * v[j][2] + v[j][3] * v[j][3]); }
        const float rstd = 1.f / sqrtf(wave_sum(q) * (1.f / DM) + LN_EPS);
        float* orow = a.out + (size_t)row * DM + 8 * lane;
#pragma unroll
        for (int j = 0; j < 4; ++j) { *(f32x4*)(orow + 512 * j) = v[2 * j] * rstd * g2[2 * j] + b2[2 * j]; *(f32x4*)(orow + 512 * j + 4) = v[2 * j + 1] * rstd * g2[2 * j + 1] + b2[2 * j + 1]; }
    }
}


#define XB_TMO      128
#define XB_XCNT(j)  (256  + 64 * (j))
#define XB_XSUB(j)  (1280 + 64 * (j))
#define XB_XGEN(j)  (2304 + 64 * (j))
#define XB_TOP      3328
#define XB_TOPGEN   3392
#define XCD_BAR_WORDS 3456
#define XB_SPIN_CAP (1u << 22)
__device__ __forceinline__ unsigned xb_ld(unsigned* p)              { return __hip_atomic_load(p, __ATOMIC_RELAXED, __HIP_MEMORY_SCOPE_AGENT); }
__device__ __forceinline__ unsigned xb_add(unsigned* p, unsigned v) { return __hip_atomic_fetch_add(p, v, __ATOMIC_RELAXED, __HIP_MEMORY_SCOPE_AGENT); }
__device__ __forceinline__ unsigned xb_xcc_id() { return (unsigned)__builtin_amdgcn_s_getreg((3 << 11) | 20) & 0xFu; }
#define XB_SPIN(cond, bar) do { unsigned _sp = 0; while (cond) { __builtin_amdgcn_s_sleep(1); \
    if ((++_sp & 255u) == 0u) { if (xb_ld(&(bar)[XB_TMO])) break; if (_sp > XB_SPIN_CAP) { atomicAdd(&(bar)[XB_TMO], 1u); break; } } } } while (0)
struct XcdBarrier { unsigned* bar; unsigned x; volatile LAS unsigned* st; };
__device__ __forceinline__ XcdBarrier xcd_barrier_post(unsigned* bar, volatile LAS unsigned* st) {
    XcdBarrier b; b.bar = bar; b.x = xb_xcc_id(); b.st = st;
    if (threadIdx.x == 0) (void)xb_add(&bar[XB_XCNT(b.x)], 1u);
    return b;
}
__device__ __forceinline__ void xcd_barrier_complete(unsigned* bar, unsigned x, unsigned& nloc, unsigned& nx) {
    const unsigned G = gridDim.x;
    unsigned sum, cnt, mine, sp = 0u;
    for (;;) {
        sum = 0u; cnt = 0u; mine = 0u;
#pragma unroll
        for (unsigned j = 0; j < 16; ++j) { const unsigned c = xb_ld(&bar[XB_XCNT(j)]); sum += c; cnt += (c > 0u) ? 1u : 0u; mine = (j == x) ? c : mine; }
        if (sum == G) break;
        __builtin_amdgcn_s_sleep(1);
        if ((++sp & 255u) == 0u) { if (xb_ld(&bar[XB_TMO])) break; if (sp > XB_SPIN_CAP) { atomicAdd(&bar[XB_TMO], 1u); break; } }
    }
    nloc = mine > 0u ? mine : 1u; nx = cnt > 0u ? cnt : 1u;
}
__device__ __forceinline__ void xcd_barrier(const XcdBarrier& b) {
    asm volatile("s_waitcnt vmcnt(0)" ::: "memory");
    __syncthreads();
    if (threadIdx.x == 0) {
        unsigned* bar = b.bar;
        __builtin_amdgcn_s_waitcnt(0);
        unsigned nloc = b.st[0], nx = b.st[1];
        if (nloc == 0u) { xcd_barrier_complete(bar, b.x, nloc, nx); b.st[0] = nloc; b.st[1] = nx; }
        const unsigned old = xb_add(&bar[XB_XSUB(b.x)], 1u);
        const unsigned gen = old / nloc;
        if (old + 1u == (gen + 1u) * nloc) {
            __builtin_amdgcn_fence(__ATOMIC_RELEASE, "agent");
            asm volatile("s_waitcnt vmcnt(0)" ::: "memory");
            const unsigned og = xb_add(&bar[XB_TOP], 1u);
            const unsigned tg = og / nx;
            if (og + 1u == (tg + 1u) * nx) xb_add(&bar[XB_TOPGEN], 1u);
            else XB_SPIN(xb_ld(&bar[XB_TOPGEN]) == tg, bar);
            __builtin_amdgcn_fence(__ATOMIC_ACQUIRE, "agent");
            xb_add(&bar[XB_XGEN(b.x)], 1u);
            asm volatile("s_waitcnt vmcnt(0)" ::: "memory");
        } else {
            XB_SPIN(xb_ld(&bar[XB_XGEN(b.x)]) == gen, bar);
            __builtin_amdgcn_fence(__ATOMIC_ACQUIRE, "agent");
            asm volatile("s_waitcnt vmcnt(0)" ::: "memory");
        }
    }
    __syncthreads();
}

constexpr int N_PHASES = 9;
constexpr int LDS_PRE = 131072;
constexpr int LDS_MISC = LDS_BYTES - 256;
__global__ void __launch_bounds__(NTHR, 2) hymba_fwd(Args args) {
    extern __shared__ __attribute__((aligned(16))) unsigned char lds_raw[];
    LAS unsigned char* lds = (LAS unsigned char*)lds_raw;
    const int G = gridDim.x, bx = blockIdx.x, tid = threadIdx.x;
    const int vcu = (G % 8 == 0) ? (bx % 8) * (G / 8) + bx / 8 : bx;
    unsigned char* ws = args.ws;
    const int lo = args.ph_lo, hi = args.ph_hi;
#ifndef PHASE_MASK
#define PHASE_MASK 0x1ff
#endif
#define IN(k) ((((PHASE_MASK) >> (k)) & 1) && lo <= (k) && (k) < hi)
#define SEAM(k) do { if (IN(k) && IN((k) + 1)) { xcd_barrier(bar); } } while (0)
    XcdBarrier bar; bar.bar = (unsigned*)(ws + WS_CTL) + CW_BAR; bar.x = 0; bar.st = (volatile LAS unsigned*)(lds + LDS_MISC);
    if (args.coop) {
        if (tid < 2) ((LAS unsigned*)(lds + LDS_MISC))[tid] = 0u;
        __syncthreads();
        bar = xcd_barrier_post((unsigned*)(ws + WS_CTL) + CW_BAR, (volatile LAS unsigned*)(lds + LDS_MISC));
    }
    if (IN(0)) { p0_phase(args, lds, vcu, G); }
    SEAM(0);
    if (IN(1)) {
        pg8::DenseOrder S; S.init(NTOK, NPROJ, DM, G, bx);
        EpiProj E{(bf16_t*)(ws + WS_PROJ), (const float*)(ws + WS_TAB)};
        pg8::gemm_phase<EpiProj, pg8::DenseOrder>(lds, (const bf16_t*)(ws + WS_XB), (const bf16_t*)(ws + WS_WIN), DM, S, E);
    }
    SEAM(1);
    if (IN(2)) {
#ifndef NO_LRU
        for (int item = vcu; item < 256; item += G) lru_item(args, (char*)lds_raw, item);
#endif
#ifndef NO_ATT
        att_phase(args, (char*)lds_raw, bx, G);
#endif
    }
    SEAM(2);
    if (IN(3)) { merge_phase(args, vcu, G); }
    SEAM(3);
    if (IN(4)) {
        pg8::DenseOrder S; S.init(NTOK, DM, DM, G, bx);
        EpiY E{args.x, args.out, (float*)(ws + WS_RPART)};
        pg8::gemm_phase<EpiY, pg8::DenseOrder>(lds, (const bf16_t*)(ws + WS_MIX), (const bf16_t*)(ws + WS_WOUT), DM, S, E);
    }
    SEAM(4);
    if (IN(5)) { p4_phase(args, (char*)lds_raw, vcu, G); }
    SEAM(5);
    if (IN(6) || IN(7)) {
        LAS int* pre = (LAS int*)(lds + LDS_PRE);
        if (tid == 0) { const unsigned* cnt = (const unsigned*)(ws + WS_CTL) + CW_CNT; int s = 0;
            for (int e = 0; e < NE1; ++e) { pre[e] = s; s += (int)((cnt[e] + 255u) >> 8); } pre[NE1] = s; }
        __syncthreads();
    }
    if (IN(6)) {
        pg8::GroupOrder<4, true> S{(const LAS int*)(lds + LDS_PRE), (const int*)(ws + WS_CTL) + CW_CNT, (const int*)(ws + WS_SLOT), G, vcu, (size_t)1024 * DM * 2, (size_t)256 * DM * 2};
        EpiH E{(bf16_t*)(ws + WS_H)};
        pg8::gemm_phase<EpiH, pg8::GroupOrder<4, true>>(lds, (const bf16_t*)(ws + WS_X1), (const bf16_t*)(ws + WS_WGU), DM, S, E);
    }
    SEAM(6);
    if (IN(7)) {
        pg8::GroupOrder<8, false> S{(const LAS int*)(lds + LDS_PRE), (const int*)(ws + WS_CTL) + CW_CNT, (const int*)(ws + WS_SLOT), G, vcu, (size_t)DM * DEXP * 2, (size_t)256 * DEXP * 2};
        EpiPair E{(bf16_t*)(ws + WS_BIG), (const float*)(ws + WS_SLOT + SLOT_ARR), (const int*)(ws + WS_SLOT + 2 * SLOT_ARR)};
        pg8::gemm_phase<EpiPair, pg8::GroupOrder<8, false>>(lds, (const bf16_t*)(ws + WS_H), (const bf16_t*)(ws + WS_WD), DEXP, S, E);
    }
    SEAM(7);
    if (IN(8)) { p8_phase(args, vcu, G); }
#undef IN
#undef SEAM
}

extern "C" void kernel_launch(void* const* d_in, const int* in_sizes, int n_in, void* d_out, int out_size, void* d_ws, size_t ws_size, hipStream_t stream) {
    static int grid = 0;
    if (grid == 0) {
        if (n_in != 22 || out_size != NTOK * DM || ws_size < WS_END) { fprintf(stderr, "kernel_launch: unexpected problem: n_in %d out %d ws %zu (need %zu)\n", n_in, out_size, ws_size, (size_t)WS_END); grid = -1; return; }
        int dev = 0, cus = 0, per_cu = 0;
        (void)hipGetDevice(&dev); (void)hipDeviceGetAttribute(&cus, hipDeviceAttributeMultiprocessorCount, dev);
        if (hipFuncSetAttribute((const void*)hymba_fwd, hipFuncAttributeMaxDynamicSharedMemorySize, LDS_BYTES) != hipSuccess) { fprintf(stderr, "kernel_launch: hipFuncSetAttribute failed\n"); grid = -1; return; }
        if (hipOccupancyMaxActiveBlocksPerMultiprocessor(&per_cu, (const void*)hymba_fwd, NTHR, LDS_BYTES) != hipSuccess || per_cu < 1) { fprintf(stderr, "kernel_launch: occupancy query says %d\n", per_cu); per_cu = 1; }
        (void)hipGetLastError();
        grid = cus > 0 ? cus : 256;
    }
    if (grid < 0) return;
    Args a{};
    const float** f = (const float**)&a;
    for (int i = 0; i < 22; ++i) f[i] = (const float*)d_in[i];
    a.out = (float*)d_out; a.ws = (unsigned char*)d_ws; a.coop = 0; a.pad = 0;
#ifndef ONE_LAUNCH
    for (int p = 0; p < N_PHASES; ++p) { a.ph_lo = p; a.ph_hi = p + 1; hipLaunchKernelGGL(hymba_fwd, dim3(grid), dim3(NTHR), LDS_BYTES, stream, a); }
#else
    a.ph_lo = 0; a.ph_hi = N_PHASES; a.coop = 1;
    (void)hipMemsetAsync((char*)d_ws + WS_CTL + (size_t)CW_BAR * 4, 0, (size_t)XCD_BAR_WORDS * 4, stream);
    hipLaunchKernelGGL(hymba_fwd, dim3(grid), dim3(NTHR), LDS_BYTES, stream, a);
#endif
}
```

```cpp
#include <hip/hip_runtime.h>
#ifndef MULTI_LAUNCH
#define ONE_LAUNCH 1
#endif
#include <cstdio>
#include <cstdint>

#define LAS __attribute__((address_space(3)))
typedef unsigned short bf16_t;
typedef short bf16x8 __attribute__((ext_vector_type(8)));
typedef short s16x4 __attribute__((ext_vector_type(4)));
typedef float f32x2 __attribute__((ext_vector_type(2)));
typedef float f32x4 __attribute__((ext_vector_type(4)));
typedef float f32x16 __attribute__((ext_vector_type(16)));
typedef unsigned u32x2 __attribute__((ext_vector_type(2)));
typedef unsigned u32x4 __attribute__((ext_vector_type(4)));

constexpr int NB = 8, SEQ = 2048, DM = 2048, NTOK = NB * SEQ;
constexpr int NPROJ = 5120, NGRP = 40;
constexpr int NEXP = 64, NE1 = 65, DEXP = 512, TOPK = 8, NPAIR = 9;
constexpr int CAP = NTOK;
constexpr float DN_ALPHA = 1.189207115002721f;
constexpr float LN_EPS = 1e-5f;
constexpr int NWAVES = 8, NTHR = 512;
constexpr int LDS_BYTES = 147456;

constexpr size_t MiB = 1u << 20;
constexpr size_t WS_CTL = 0;
constexpr size_t WS_TAB = 1 * MiB;
constexpr size_t WS_WRG = 2 * MiB;
constexpr size_t WS_WR = 3 * MiB;
constexpr size_t WS_SLOT = 4 * MiB;
constexpr size_t SLOT_ARR = (size_t)NE1 * CAP * 4;
constexpr size_t WS_RPART = 17 * MiB;
constexpr size_t WS_ASTAT = 21 * MiB;
constexpr size_t WS_WD = 24 * MiB;
constexpr size_t WS_X1 = 154 * MiB;
constexpr size_t WS_H = 218 * MiB;
constexpr size_t WS_BIG = 380 * MiB;
constexpr size_t WS_WGU = WS_BIG;
constexpr size_t WS_WIN = WS_BIG + 260 * MiB;
constexpr size_t WS_WOUT = WS_BIG + 280 * MiB;
constexpr size_t WS_XB = WS_BIG + 288 * MiB;
constexpr size_t WS_PROJ = WS_BIG + 352 * MiB;
constexpr size_t WS_MIX = WS_BIG + 512 * MiB;
constexpr size_t WS_END = WS_BIG + 576 * MiB;

constexpr int CW_CNT = 64, CNT_STRIDE = 32;
constexpr int CW_BAR = 4096;

__device__ __forceinline__ unsigned cvt_pk_bf16(float lo, float hi) { unsigned r; asm volatile("v_cvt_pk_bf16_f32 %0, %1, %2" : "=v"(r) : "v"(lo), "v"(hi)); return r; }
__device__ __forceinline__ float bf2f(unsigned short b) { return __uint_as_float(((unsigned)b) << 16); }
__device__ __forceinline__ float bflo(unsigned w) { return __uint_as_float(w << 16); }
__device__ __forceinline__ float bfhi(unsigned w) { return __uint_as_float(w & 0xffff0000u); }
__device__ __forceinline__ float wave_sum(float v) {
#pragma unroll
    for (int o = 1; o < 64; o <<= 1) v += __shfl_xor(v, o);
    return v;
}
#define LDS_WAIT() asm volatile("s_waitcnt lgkmcnt(0)" ::: "memory")
#define VM_WAIT() asm volatile("s_waitcnt vmcnt(0)" ::: "memory")

namespace pg8 {
constexpr int BM = 256, BK = 64, HALF = 128, HTB = HALF * BK * 2, STAGE_BYTES = 8 * HTB, NXCD = 8, WGM = 8;
__host__ __device__ __forceinline__ int lds_byte(int r, int c) { const int st = (r >> 4) * 2 + (c >> 5), rr = r & 15, cc = c & 31, ob = rr * 64 + cc * 2; return st * 1024 + (ob ^ (((ob >> 9) & 1) << 5)); }
__host__ __device__ __forceinline__ void stage_rc(int b, int& R, int& C) { const int st = b / 1024, sb = b % 1024, swz = sb ^ (((sb >> 9) & 1) << 5); R = (st >> 1) * 16 + swz / 64; C = (st & 1) * 32 + (swz % 64) / 2; }
__host__ __device__ __forceinline__ int perm32(int rho) { const int n = rho >> 4, i = rho & 15; return 8 * (i >> 2) + 4 * n + (i & 3); }

struct Unit { int pm, pn, e, cnt, row0; };

struct DenseOrder {
    int nM, nN, nwg, G, c; size_t bstride;
    __device__ void init(int M, int N, int K, int G_, int c_) { nM = M / BM; nN = N / BM; nwg = nM * nN; G = G_; c = c_; bstride = (size_t)BM * K * 2; }
    __device__ __forceinline__ bool next(int i, Unit& u) const {
        const long L = (long)i * G + c; if (L >= nwg) return false;
        int wgid = (int)L; { const int q = nwg / NXCD, r = nwg % NXCD, xcd = wgid % NXCD, off = wgid / NXCD; wgid = (xcd < r ? xcd * (q + 1) : r * (q + 1) + (xcd - r) * q) + off; }
        const int nig = WGM * nN, gid = wgid / nig, fm = gid * WGM, gsz = (nM - fm) < WGM ? (nM - fm) : WGM;
        u.pm = fm + ((wgid % nig) % gsz); u.pn = (wgid % nig) / gsz; u.e = 0; u.cnt = 0; u.row0 = 0; return true;
    }
    __device__ __forceinline__ int arow(const Unit& u, int r) const { return u.pm * BM + r; }
    __device__ __forceinline__ size_t boff(const Unit& u) const { return (size_t)u.pn * bstride; }
};
template <int NPN, bool GATHER> struct GroupOrder {
    const LAS int* pre; const int* cnt; const int* slot_tok; int G, vcu; size_t estride, pstride;
    __device__ __forceinline__ bool next(int i, Unit& u) const {
        const int L = i * G + vcu; const int total = pre[NE1] * NPN; if (L >= total) return false;
        const int T = L / NPN; u.pn = L - T * NPN;
        int lo = 0, hi = NE1;
        while (hi - lo > 1) { const int mid = (lo + hi) >> 1; if (pre[mid] <= T) lo = mid; else hi = mid; }
        u.e = lo; u.pm = T - pre[lo]; u.row0 = pre[lo] * BM; u.cnt = cnt[lo * CNT_STRIDE]; return true;
    }
    __device__ __forceinline__ int arow(const Unit& u, int r) const {
        const int s = u.pm * BM + r;
        if (GATHER) { return s < u.cnt ? slot_tok[(size_t)u.e * CAP + s] : 0; }
        else return u.row0 + s;
    }
    __device__ __forceinline__ size_t boff(const Unit& u) const { return (size_t)u.e * estride + (size_t)u.pn * pstride; }
};

template <class Epi, class Sched>
__device__ __forceinline__ void gemm_phase(LAS unsigned char* lds, const bf16_t* Abase, const bf16_t* Bbase, const int K, const Sched& S, const Epi& E) {
    const int tid = threadIdx.x, wid = __builtin_amdgcn_readfirstlane(tid >> 6), lane = tid & 63, wr = wid >> 2, wc = wid & 3, fr = lane & 15, fq = lane >> 4;
    const int nt = K / BK;
    int Rr[2], Cc[2]; unsigned voffB[2];
#pragma unroll
    for (int i = 0; i < 2; ++i) { int R, C; stage_rc(tid * 16 + i * 8192, R, C); Rr[i] = R; Cc[i] = C; const int Rb = Epi::PERM ? ((R & ~31) + perm32(R & 31)) : R; voffB[i] = (unsigned)(Rb * K + C) * 2u; }
    const size_t kstep = (size_t)(BK * 2);
    const size_t hstep = (size_t)HALF * K * 2;
    const unsigned ldsw = (unsigned)wid * 1024u;
    const int aoff = lds_byte(wr * 64 + fr, fq * 8), boff = lds_byte(wc * 32 + fr, fq * 8);
#define PG8_SA(b, h) (((b) * 2 + (h)) * HTB)
#define PG8_SB(b, h) ((4 + (b) * 2 + (h)) * HTB)
#define PG8_STAGE(bufoff, gbase, voff) do { _Pragma("unroll") for (int _i = 0; _i < 2; ++_i) \
        __builtin_amdgcn_global_load_lds((const unsigned*)((const char*)(gbase) + (voff)[_i]), (LAS unsigned*)(lds + (bufoff) + ldsw + _i * 8192), 16, 0, 0); } while (0)
#define PG8_LDA(dst, b, h) do { _Pragma("unroll") for (int m = 0; m < 4; ++m) _Pragma("unroll") for (int k = 0; k < 2; ++k) dst[m][k] = *(const LAS bf16x8*)(lds + PG8_SA(b, h) + aoff + m * 2048 + k * 1024); } while (0)
#define PG8_LDB(dst, b, h) do { _Pragma("unroll") for (int n = 0; n < 2; ++n) _Pragma("unroll") for (int k = 0; k < 2; ++k) dst[n][k] = *(const LAS bf16x8*)(lds + PG8_SB(b, h) + boff + n * 2048 + k * 1024); } while (0)
#define PG8_MMA(ai, bj, At, Bt) do { __builtin_amdgcn_s_setprio(1); _Pragma("unroll") for (int m = 0; m < 4; ++m) _Pragma("unroll") for (int n = 0; n < 2; ++n) _Pragma("unroll") for (int k = 0; k < 2; ++k) \
        acc[ai][bj][m][n] = __builtin_amdgcn_mfma_f32_16x16x32_bf16(Bt[n][k], At[m][k], acc[ai][bj][m][n], 0, 0, 0); __builtin_amdgcn_s_setprio(0); } while (0)
#define PG8_WAIT_V(n) asm volatile("s_waitcnt vmcnt(" #n ")" ::: "memory")
#define PG8_WAIT_L(n) asm volatile("s_waitcnt lgkmcnt(" #n ")" ::: "memory")
#define PG8_BAR __builtin_amdgcn_s_barrier()
#define PG8_SCHED __builtin_amdgcn_sched_barrier(0)
#define PG8_AOFFS(u, v0, v1) do { _Pragma("unroll") for (int _i = 0; _i < 2; ++_i) { \
        v0[_i] = (unsigned)(((size_t)S.arow(u, Rr[_i]) * K + Cc[_i]) * 2u); v1[_i] = (unsigned)(((size_t)S.arow(u, HALF + Rr[_i]) * K + Cc[_i]) * 2u); } } while (0)
    Unit cur, nxt; int ui = 0;
    if (!S.next(0, cur)) return;
    f32x4 acc[2][2][4][2];
#pragma unroll
    for (int a = 0; a < 2; ++a)
#pragma unroll
        for (int b = 0; b < 2; ++b)
#pragma unroll
            for (int m = 0; m < 4; ++m)
#pragma unroll
                for (int n = 0; n < 2; ++n) acc[a][b][m][n] = (f32x4){0.f, 0.f, 0.f, 0.f};
    bf16x8 At[4][2], B0[2][2], B1[2][2];
    unsigned vA0[2], vA1[2], nA0[2], nA1[2];
    PG8_AOFFS(cur, vA0, vA1);
    bool has_next = S.next(1, nxt);
    if (has_next) { PG8_AOFFS(nxt, nA0, nA1); } else { nA0[0] = vA0[0]; nA0[1] = vA0[1]; nA1[0] = vA1[0]; nA1[1] = vA1[1]; }
    asm volatile("" : "+v"(vA0[0]), "+v"(vA0[1]), "+v"(vA1[0]), "+v"(vA1[1]), "+v"(nA0[0]), "+v"(nA0[1]), "+v"(nA1[0]), "+v"(nA1[1]));
    const char* cA = (const char*)Abase; const char* cB = (const char*)Bbase + S.boff(cur);
    PG8_STAGE(PG8_SB(0, 0), cB, voffB); PG8_STAGE(PG8_SB(0, 1), cB + hstep, voffB); PG8_STAGE(PG8_SA(0, 0), cA, vA0); PG8_STAGE(PG8_SA(0, 1), cA, vA1);
    if (wr == 1) PG8_BAR;
    PG8_WAIT_V(2); PG8_BAR;
    PG8_STAGE(PG8_SB(1, 0), cB + kstep, voffB); PG8_STAGE(PG8_SA(1, 0), cA + kstep, vA0); PG8_STAGE(PG8_SB(1, 1), cB + hstep + kstep, voffB);
    PG8_WAIT_V(6); PG8_BAR;
    for (;;) {
        const char* nB = has_next ? (const char*)Bbase + S.boff(nxt) : cB;
        for (int t = 0; t < nt; t += 2) {
            const bool last = (t == nt - 2);
            const char* a1 = cA + (size_t)(t + 1) * kstep;
            const char* b2 = last ? nB : cB + (size_t)(t + 2) * kstep;
            const char* a2 = last ? cA : cA + (size_t)(t + 2) * kstep;
            const char* a3 = a2 + kstep; const char* b3 = b2 + kstep;
            PG8_LDB(B0, 0, 0); PG8_LDB(B1, 0, 1); PG8_SCHED; PG8_LDA(At, 0, 0); PG8_STAGE(PG8_SA(1, 1), a1, vA1);
            if (last) { vA0[0] = nA0[0]; vA0[1] = nA0[1]; vA1[0] = nA1[0]; vA1[1] = nA1[1]; }
            PG8_WAIT_V(8); PG8_WAIT_L(0); PG8_BAR; PG8_MMA(0, 0, At, B0); PG8_MMA(0, 1, At, B1); PG8_BAR; PG8_SCHED;
            PG8_LDA(At, 0, 1); PG8_STAGE(PG8_SB(0, 0), b2, voffB); PG8_STAGE(PG8_SB(0, 1), b2 + hstep, voffB); PG8_STAGE(PG8_SA(0, 0), a2, vA0);
            PG8_WAIT_V(8); PG8_WAIT_L(0); PG8_BAR; PG8_MMA(1, 0, At, B0); PG8_MMA(1, 1, At, B1); PG8_BAR; PG8_SCHED;
            PG8_LDB(B0, 1, 0); PG8_LDB(B1, 1, 1); PG8_SCHED; PG8_LDA(At, 1, 0); PG8_STAGE(PG8_SA(0, 1), a2, vA1);
            PG8_WAIT_V(8); PG8_WAIT_L(0); PG8_BAR; PG8_MMA(0, 0, At, B0); PG8_MMA(0, 1, At, B1); PG8_BAR; PG8_SCHED;
            PG8_LDA(At, 1, 1); PG8_STAGE(PG8_SB(1, 0), b3, voffB); PG8_STAGE(PG8_SB(1, 1), b3 + hstep, voffB); PG8_STAGE(PG8_SA(1, 0), a3, vA0);
            PG8_WAIT_V(8); PG8_WAIT_L(0); PG8_BAR; PG8_MMA(1, 0, At, B0); PG8_MMA(1, 1, At, B1); PG8_BAR; PG8_SCHED;
        }
        if (wr == 0) PG8_BAR;
        E(acc, cur, wr, wc, fr, fq);
        if (!has_next) break;
#pragma unroll
        for (int a = 0; a < 2; ++a)
#pragma unroll
            for (int b = 0; b < 2; ++b)
#pragma unroll
                for (int m = 0; m < 4; ++m)
#pragma unroll
                    for (int n = 0; n < 2; ++n) acc[a][b][m][n] = (f32x4){0.f, 0.f, 0.f, 0.f};
        cur = nxt; cB = nB; ++ui;
        has_next = S.next(ui + 1, nxt);
        if (has_next) { PG8_AOFFS(nxt, nA0, nA1); }
        asm volatile("" : "+v"(nA0[0]), "+v"(nA0[1]), "+v"(nA1[0]), "+v"(nA1[1]));
        if (wr == 1) PG8_BAR;
    }
    PG8_WAIT_V(0);
    PG8_BAR;
#undef PG8_SA
#undef PG8_SB
#undef PG8_STAGE
#undef PG8_LDA
#undef PG8_LDB
#undef PG8_MMA
#undef PG8_WAIT_V
#undef PG8_WAIT_L
#undef PG8_BAR
#undef PG8_SCHED
#undef PG8_AOFFS
}
}

struct EpiProj {
    static constexpr bool PERM = true;
    bf16_t* proj; const float* rope;
    __device__ __forceinline__ void operator()(const f32x4 (&acc)[2][2][4][2], const pg8::Unit& u, int wr, int wc, int fr, int fq) const {
        const int type = u.pn >> 2;
        const int row0 = u.pm * 256 + wr * 64 + fr, b = row0 >> 11;
        const bool rot = (type == 2 || type == 3) && wc == 0;
        const float sgn = fq < 2 ? -1.f : 1.f;
#pragma unroll
        for (int ai = 0; ai < 2; ++ai)
#pragma unroll
            for (int m = 0; m < 4; ++m) {
                const int s = (row0 + ai * 128 + m * 16) & 2047;
                f32x4 c0, c1, s0, s1;
                if (rot) { const float* cp = rope + s * 16 + 8 * (fq & 1); c0 = *(const f32x4*)cp; c1 = *(const f32x4*)(cp + 4); s0 = *(const f32x4*)(cp + 32768); s1 = *(const f32x4*)(cp + 32768 + 4); }
#pragma unroll
                for (int bj = 0; bj < 2; ++bj) {
                    f32x4 v0 = acc[ai][bj][m][0], v1 = acc[ai][bj][m][1];
                    if (type == 1) {
#pragma unroll
                        for (int j = 0; j < 4; ++j) {
                            { const float x = v0[j]; const float e = __builtin_amdgcn_exp2f(-2.302208198f * (x + 0.044715f * x * x * x)); v0[j] = x * __builtin_amdgcn_rcpf(1.f + e); }
                            { const float x = v1[j]; const float e = __builtin_amdgcn_exp2f(-2.302208198f * (x + 0.044715f * x * x * x)); v1[j] = x * __builtin_amdgcn_rcpf(1.f + e); }
                        }
                    }
                    if (rot) {
                        f32x4 p0, p1;
#pragma unroll
                        for (int j = 0; j < 4; ++j) { p0[j] = __shfl_xor(v0[j], 32); p1[j] = __shfl_xor(v1[j], 32); }
                        v0 = v0 * c0 + sgn * (p0 * s0); v1 = v1 * c1 + sgn * (p1 * s1);
                    }
                    u32x4 w; w.x = cvt_pk_bf16(v0[0], v0[1]); w.y = cvt_pk_bf16(v0[2], v0[3]); w.z = cvt_pk_bf16(v1[0], v1[1]); w.w = cvt_pk_bf16(v1[2], v1[3]);
                    const int g = 2 * u.pn + bj;
                    *(u32x4*)(proj + (((size_t)(b * NGRP + g) * SEQ + s) * 128 + 32 * wc + 8 * fq)) = w;
                }
            }
    }
};
struct EpiY {
    static constexpr bool PERM = false;
    const float* x; float* y; float* rpart;
    __device__ __forceinline__ void operator()(const f32x4 (&acc)[2][2][4][2], const pg8::Unit& u, int wr, int wc, int fr, int fq) const {
        const int row0 = u.pm * 256 + wr * 64 + fr, col0 = u.pn * 256 + wc * 32 + 4 * fq;
#pragma unroll
        for (int ai = 0; ai < 2; ++ai)
#pragma unroll
            for (int m = 0; m < 4; ++m) {
                const int r = row0 + ai * 128 + m * 16; const size_t off = (size_t)r * DM + col0;
                float s1 = 0.f, s2 = 0.f;
#pragma unroll
                for (int bj = 0; bj < 2; ++bj)
#pragma unroll
                    for (int n = 0; n < 2; ++n) {
                        const f32x4 xv = *(const f32x4*)(x + off + bj * 128 + n * 16);
                        const f32x4 o = xv * DN_ALPHA + acc[ai][bj][m][n];
                        *(f32x4*)(y + off + bj * 128 + n * 16) = o;
                        s1 += (o[0] + o[1]) + (o[2] + o[3]); s2 += (o[0] * o[0] + o[1] * o[1]) + (o[2] * o[2] + o[3] * o[3]);
                    }
                s1 += __shfl_xor(s1, 16); s1 += __shfl_xor(s1, 32); s2 += __shfl_xor(s2, 16); s2 += __shfl_xor(s2, 32);
                if (fq == 0) *(f32x2*)(rpart + ((size_t)r * 32 + u.pn * 4 + wc) * 2) = (f32x2){s1, s2};
                asm volatile("" ::: "memory");
            }
    }
};
struct EpiH {
    static constexpr bool PERM = true;
    bf16_t* h;
    __device__ __forceinline__ void operator()(const f32x4 (&acc)[2][2][4][2], const pg8::Unit& u, int wr, int wc, int fr, int fq) const {
        const int row0 = u.row0 + u.pm * 256 + wr * 64 + fr, col0 = u.pn * 128 + wc * 32 + 8 * fq;
#pragma unroll
        for (int ai = 0; ai < 2; ++ai)
#pragma unroll
            for (int m = 0; m < 4; ++m) {
                f32x4 o[2];
#pragma unroll
                for (int n = 0; n < 2; ++n)
#pragma unroll
                    for (int j = 0; j < 4; ++j) { const float g = acc[ai][0][m][n][j], up = acc[ai][1][m][n][j];
                        const float e = __builtin_amdgcn_exp2f(-1.4426950408889634f * g); o[n][j] = g * __builtin_amdgcn_rcpf(1.f + e) * up; }
                u32x4 w; w.x = cvt_pk_bf16(o[0][0], o[0][1]); w.y = cvt_pk_bf16(o[0][2], o[0][3]); w.z = cvt_pk_bf16(o[1][0], o[1][1]); w.w = cvt_pk_bf16(o[1][2], o[1][3]);
                *(u32x4*)(h + (size_t)(row0 + ai * 128 + m * 16) * DEXP + col0) = w;
            }
    }
};
struct EpiPair {
    static constexpr bool PERM = true;
    bf16_t* yp; const float* slot_gate; const int* slot_pair;
    __device__ __forceinline__ void operator()(const f32x4 (&acc)[2][2][4][2], const pg8::Unit& u, int wr, int wc, int fr, int fq) const {
        const int s0 = u.pm * 256 + wr * 64 + fr, col0 = u.pn * 256 + wc * 32 + 8 * fq;
#pragma unroll
        for (int ai = 0; ai < 2; ++ai)
#pragma unroll
            for (int m = 0; m < 4; ++m) {
                const int s = s0 + ai * 128 + m * 16;
                if (s < u.cnt) {
                    const float g = slot_gate[(size_t)u.e * CAP + s]; const int pair = slot_pair[(size_t)u.e * CAP + s];
#pragma unroll
                    for (int bj = 0; bj < 2; ++bj) { const f32x4 v0 = acc[ai][bj][m][0] * g, v1 = acc[ai][bj][m][1] * g;
                        u32x4 w; w.x = cvt_pk_bf16(v0[0], v0[1]); w.y = cvt_pk_bf16(v0[2], v0[3]); w.z = cvt_pk_bf16(v1[0], v1[1]); w.w = cvt_pk_bf16(v1[2], v1[3]);
                        *(u32x4*)(yp + (size_t)pair * DM + col0 + bj * 128) = w; }
                }
            }
    }
};

namespace att {
constexpr float SCALE = 0.08838834764831845f;
constexpr float THR = 8.f;
constexpr int D = 128, NW = 8, QBLK = 32, KVBLK = 64, QB = NW * QBLK;
constexpr int SHM_V = KVBLK * D * 2, SHM_K = KVBLK * D * 2;
constexpr int LDS_BYTES = 2 * SHM_V + 2 * SHM_K + NW * 64 * 4;
#define KSWZ(row, colB) ((row) * 256 + ((colB) ^ (((row) & 7) << 4)))
#define SBAR() __builtin_amdgcn_sched_barrier(0)
__device__ __forceinline__ int v_st(int k, int c) { const int kk = (k & ~0xC) | ((k & 4) << 1) | ((k & 8) >> 1); return ((kk >> 3) * 4 + (c >> 5)) * 512 + ((kk & 7) * 32 + (c & 31)) * 2; }
__device__ __forceinline__ int v_rd_base(int lane) { return ((lane & 3) << 3) | (((lane >> 2) & 3) << 6) | (((lane >> 4) & 1) << 5) | (((lane >> 5) & 1) << 8); }
constexpr int v_rd_off(int d0, int ks, int half) { return d0 * 512 + ks * 4096 + half * 2048; }
__device__ __forceinline__ int crow(int r, int hi) { return (r & 3) + 8 * (r >> 2) + 4 * hi; }
__device__ __forceinline__ unsigned cvtpk(float lo, float hi) { unsigned r; asm volatile("v_cvt_pk_bf16_f32 %0, %1, %2" : "=v"(r) : "v"(lo), "v"(hi)); return r; }
__device__ __forceinline__ bf16x8 load8(const bf16_t* p) { return *reinterpret_cast<const bf16x8*>(p); }
__device__ __forceinline__ void mask_tile(f32x16& p0, f32x16& p1, int dq, unsigned W, unsigned par) {
    const float NEG = -__builtin_inff();
#pragma unroll
    for (int r = 0; r < 16; ++r) {
        const int c = (r & 3) + 8 * (r >> 2);
        const unsigned x0 = (unsigned)(dq - c), x1 = (unsigned)(dq - c - 32);
        if (x0 >= W || (x0 & par)) p0[r] = NEG;
        if (x1 >= W || (x1 & par)) p1[r] = NEG;
    }
}
__device__ __forceinline__ void partialSM(f32x16& p0, f32x16& p1, float& m_reg, float& mn, float& alpha) {
    float pmax = p0[0]; for (int r = 1; r < 16; ++r) pmax = fmaxf(pmax, p0[r]); for (int r = 0; r < 16; ++r) pmax = fmaxf(pmax, p1[r]);
    { auto rr = __builtin_amdgcn_permlane32_swap(__float_as_uint(pmax), __float_as_uint(pmax), false, false);
      pmax = fmaxf(__uint_as_float(rr[0]), __uint_as_float(rr[1])); }
    constexpr float C2 = 1.4426950408889634f * SCALE;
    if (__builtin_expect(__all((pmax - m_reg) * SCALE <= THR), 1)) { mn = m_reg; alpha = 1.f; }
    else { mn = fmaxf(m_reg, pmax); alpha = __builtin_amdgcn_exp2f((m_reg - mn) * C2); m_reg = mn; }
    const float mnL = -mn * C2;
    for (int r = 0; r < 16; ++r) p0[r] = fmaf(p0[r], C2, mnL); for (int r = 0; r < 16; ++r) p1[r] = fmaf(p1[r], C2, mnL);
    for (int r = 0; r < 16; ++r) p0[r] = __builtin_amdgcn_exp2f(p0[r]);
}
__device__ __forceinline__ void finishSM(f32x16& p0, f32x16& p1, float alpha, float& l_reg, bf16x8& pa0, bf16x8& pa1, bf16x8& pa2, bf16x8& pa3) {
    for (int r = 0; r < 16; ++r) p1[r] = __builtin_amdgcn_exp2f(p1[r]);
    float ps = 0; for (int r = 0; r < 16; ++r) ps += p0[r]; for (int r = 0; r < 16; ++r) ps += p1[r];
    { auto rr = __builtin_amdgcn_permlane32_swap(__float_as_uint(ps), __float_as_uint(ps), false, false);
      ps = __uint_as_float(rr[0]) + __uint_as_float(rr[1]); }
    l_reg = l_reg * alpha + ps;
#define PK4(P, B_, OUT) do { unsigned a0 = cvtpk(P[B_+0], P[B_+1]), a1 = cvtpk(P[B_+2], P[B_+3]);                          \
        unsigned b0 = cvtpk(P[B_+4], P[B_+5]), b1 = cvtpk(P[B_+6], P[B_+7]);                                             \
        auto r0 = __builtin_amdgcn_permlane32_swap(a0, b0, false, false); auto r1 = __builtin_amdgcn_permlane32_swap(a1, b1, false, false); \
        u32x4 w = {r0[0], r1[0], r0[1], r1[1]}; OUT = *reinterpret_cast<bf16x8*>(&w); } while (0)
    PK4(p0, 0, pa0); PK4(p0, 8, pa1); PK4(p1, 0, pa2); PK4(p1, 8, pa3);
#undef PK4
}
template <int KB>
__device__ __forceinline__ void qkt(f32x16& p0, f32x16& p1, const char* K_lds, int r32, int hi, const bf16x8* qr, bool act) {
    if (!act) { const float NEG = -__builtin_inff();
#pragma unroll
        for (int r = 0; r < 16; ++r) { p0[r] = NEG; p1[r] = NEG; } return; }
    p0 = f32x16{}; p1 = f32x16{};
    const char* kb[4];
#pragma unroll
    for (int dd = 0; dd < 4; ++dd) kb[dd] = K_lds + KB * SHM_K + KSWZ(r32, (dd * 16 + hi * 8) * 2);
#pragma unroll
    for (int d0 = 0; d0 < 8; ++d0) { const char* a = kb[d0 & 3] + (d0 >> 2) * 128;
        bf16x8 b0 = *reinterpret_cast<const bf16x8*>(a);
        bf16x8 b1 = *reinterpret_cast<const bf16x8*>(a + 32 * 256);
        p0 = __builtin_amdgcn_mfma_f32_32x32x16_bf16(b0, qr[d0], p0, 0, 0, 0);
        p1 = __builtin_amdgcn_mfma_f32_32x32x16_bf16(b1, qr[d0], p1, 0, 0, 0); }
}
template <int VB>
__device__ __forceinline__ void pv_tile(f32x16* o, int vb0, bf16x8 pa0, bf16x8 pa1, bf16x8 pa2, bf16x8 pa3, bool act) {
    if (!act) return;
#define TRRD(dst, off) asm volatile("ds_read_b64_tr_b16 %0, %1 offset:%2" : "=&v"(dst) : "v"(vb0), "i"(off) : "memory")
#define PV_D0(d0) do { s16x4 l0, l1, l2, l3, h0, h1, h2, h3; constexpr int b_ = VB * SHM_V + v_rd_off(d0, 0, 0); \
        TRRD(l0, b_); TRRD(h0, b_ + 2048); TRRD(l1, b_ + 4096); TRRD(h1, b_ + 6144); TRRD(l2, b_ + 8192); TRRD(h2, b_ + 10240); TRRD(l3, b_ + 12288); TRRD(h3, b_ + 14336); \
        asm volatile("s_waitcnt lgkmcnt(0)" ::: "memory"); SBAR(); \
        o[d0] = __builtin_amdgcn_mfma_f32_32x32x16_bf16(pa0, (bf16x8){l0[0], l0[1], l0[2], l0[3], h0[0], h0[1], h0[2], h0[3]}, o[d0], 0, 0, 0);   \
        o[d0] = __builtin_amdgcn_mfma_f32_32x32x16_bf16(pa1, (bf16x8){l1[0], l1[1], l1[2], l1[3], h1[0], h1[1], h1[2], h1[3]}, o[d0], 0, 0, 0);   \
        o[d0] = __builtin_amdgcn_mfma_f32_32x32x16_bf16(pa2, (bf16x8){l2[0], l2[1], l2[2], l2[3], h2[0], h2[1], h2[2], h2[3]}, o[d0], 0, 0, 0);   \
        o[d0] = __builtin_amdgcn_mfma_f32_32x32x16_bf16(pa3, (bf16x8){l3[0], l3[1], l3[2], l3[3], h3[0], h3[1], h3[2], h3[3]}, o[d0], 0, 0, 0); } while (0)
    PV_D0(0); PV_D0(1); PV_D0(2); PV_D0(3);
#undef PV_D0
#undef TRRD
}
struct BlockRef { const bf16_t* H; bf16_t* O; f32x2* ST; int P0, dil, W; };
constexpr size_t KOFF = (size_t)8 * SEQ * 128, VOFF = (size_t)16 * SEQ * 128;
struct Seam { bf16x8 qr[8]; bf16x8 st_v0, st_v1, st_k0, st_k1; };
__device__ __forceinline__ int swa_jlo(int P0, int W) { const int lowk = P0 - W + 1; return lowk > 0 ? lowk / KVBLK : 0; }
#define ROWP(p, rs_, k0, rr) ((p) + (size_t)((k0) + (rr)) * (rs_) + sc)
#define VMW() asm volatile("s_waitcnt vmcnt(0)" ::: "memory")
#define VMWN(n) asm volatile("s_waitcnt vmcnt(%0)" :: "i"(n) : "memory")
#define SLOAD_H(Kp, Vp, rs_, k0) do { S.st_v0 = load8(ROWP(Vp, rs_, k0, sr)); S.st_v1 = load8(ROWP(Vp, rs_, k0, 32 + sr));              \
                         S.st_k0 = load8(ROWP(Kp, rs_, k0, sr)); S.st_k1 = load8(ROWP(Kp, rs_, k0, 32 + sr)); } while (0)
#define SWRITE_HK(bf) do { *(bf16x8*)(K_lds + (bf) * SHM_K + kws) = S.st_k0; *(bf16x8*)(K_lds + (bf) * SHM_K + kws + 32 * 256) = S.st_k1; } while (0)
#define SWRITE_HV(bf) do { *(bf16x8*)(V_lds + (bf) * SHM_V + vst0) = S.st_v0; *(bf16x8*)(V_lds + (bf) * SHM_V + vst1) = S.st_v1; } while (0)
#define SWRITE_H(bf) do { SWRITE_HV(bf); SWRITE_HK(bf); } while (0)
__device__ __forceinline__ void swa_prime(const BlockRef& cur, char* lds, Seam& S) {
    const int tid = threadIdx.x, wid = __builtin_amdgcn_readfirstlane(tid >> 6), lane = tid & 63, r32 = lane & 31, hi = lane >> 5;
    const int sr = tid >> 4, sc = (tid & 15) * 8, kws = KSWZ(sr, sc * 2); char* K_lds = lds + 2 * SHM_V;
    const int kb0 = swa_jlo(cur.P0, cur.W) * KVBLK; const int rs0 = 128 * cur.dil;
    for (int d0 = 0; d0 < 8; ++d0) S.qr[d0] = load8(cur.H + (size_t)(cur.P0 + wid * QBLK + r32) * rs0 + d0 * 16 + hi * 8);
    SLOAD_H(cur.H + KOFF, cur.H + VOFF, rs0, kb0); VMW(); SWRITE_HK(0);
    __syncthreads();
}
__device__ __forceinline__ void swa_block(const BlockRef& cur, const BlockRef& nxt, char* lds, Seam& S) {
    const int tid = threadIdx.x, wid = __builtin_amdgcn_readfirstlane(tid >> 6), lane = tid & 63, r32 = lane & 31, hi = lane >> 5;
    const int W = cur.W; const unsigned par = (W == 256) ? 1u : 0u; const int rs = 128 * cur.dil, ors = 1024 * cur.dil, sst = 8 * cur.dil, skv = SEQ / cur.dil, nrs = 128 * nxt.dil;
    const int j_lo = swa_jlo(cur.P0, W);
    int j_hi = (cur.P0 + QB - 1) / KVBLK + 1; if (j_hi > skv / KVBLK) j_hi = skv / KVBLK;
    const int NT = j_hi - j_lo;
    const int kbn = swa_jlo(nxt.P0, nxt.W) * KVBLK;
    const int qlo = cur.P0 + wid * QBLK, qm = qlo + r32 - 4 * hi;
    char* V_lds = lds; char* K_lds = lds + 2 * SHM_V;
    float* ws = (float*)(lds + 2 * SHM_V + 2 * SHM_K) + wid * 64; float* li_l = ws, * al_l = ws + 32;
    float m_reg = -1e30f, l_reg = 0; f32x16 o[4] = {};
    const int sr = tid >> 4, sc = (tid & 15) * 8, vst0 = v_st(sr, sc), vst1 = v_st(32 + sr, sc), kws = KSWZ(sr, sc * 2);
    const int vb0 = (int)(uintptr_t)V_lds + v_rd_base(lane);
    const bf16_t* Kh = cur.H + KOFF; const bf16_t* Vh = cur.H + VOFF;
#define RESC(a) do { if (__any((a) < 1.f)) { if (hi == 0) al_l[r32] = (a); asm volatile("s_waitcnt lgkmcnt(0)" ::: "memory");              \
                     for (int d_ = 0; d_ < 4; ++d_) for (int r = 0; r < 16; ++r) o[d_][r] *= al_l[crow(r, hi)]; } } while (0)
#define KBASE(t) ((j_lo + (t)) * KVBLK)
#define ACT(t) (KBASE(t) <= qlo + QBLK - 1 && KBASE(t) + KVBLK - 1 >= qlo - W + 1)
#define MASKT(P0_, P1_, t) do { const int kb_ = KBASE(t); if (ACT(t) && (par != 0u || kb_ + KVBLK - 1 > qlo || kb_ <= qlo + QBLK - 1 - W)) mask_tile(P0_, P1_, qm - kb_, (unsigned)W, par); } while (0)
    constexpr int NQL = 8;
#define SEAM_K0() do { VMWN(NQL); SWRITE_HK(0); SBAR(); } while (0)
    f32x16 pA0, pA1, pB0, pB1; float mnA, mnB, alA, alB; bf16x8 pa0, pa1, pa2, pa3;
    SWRITE_HV(0); SBAR();
    if (NT > 1) { SLOAD_H(Kh, Vh, rs, KBASE(1)); }
    SBAR(); qkt<0>(pA0, pA1, K_lds, r32, hi, S.qr, ACT(0));
    MASKT(pA0, pA1, 0); partialSM(pA0, pA1, m_reg, mnA, alA);
    if (NT > 1) { VMW(); SWRITE_H(1); }
    __syncthreads();
#define HALF_STEP(PX0, PX1, mnX, alX, PY0, PY1, alY, t, KB, VB, SB) do {                                                      \
        SBAR(); qkt<KB>(PX0, PX1, K_lds, r32, hi, S.qr, ACT(t));                                                             \
        finishSM(PY0, PY1, alY, l_reg, pa0, pa1, pa2, pa3); SBAR();                                                           \
        if ((t) + 1 < NT) { SLOAD_H(Kh, Vh, rs, KBASE((t) + 1)); SBAR(); }                                                    \
        pv_tile<VB>(o, vb0, pa0, pa1, pa2, pa3, ACT((t) - 1)); MASKT(PX0, PX1, (t)); partialSM(PX0, PX1, m_reg, mnX, alX);    \
        __syncthreads();                                                                                                      \
        if ((t) + 1 < NT) { VMW(); SWRITE_H(SB); }                                                                            \
        RESC(alX); __syncthreads(); } while (0)
    for (int t = 1; t + 1 < NT; t += 2) {
        HALF_STEP(pB0, pB1, mnB, alB, pA0, pA1, alA, t, 1, 0, 0);
        HALF_STEP(pA0, pA1, mnA, alA, pB0, pB1, alB, t + 1, 0, 1, 1);
    }
    const bool even = (NT & 1) == 0;
    if (even) { SBAR(); qkt<1>(pB0, pB1, K_lds, r32, hi, S.qr, ACT(NT - 1)); SBAR(); }
    SLOAD_H(nxt.H + KOFF, nxt.H + VOFF, nrs, kbn); SBAR();
#pragma unroll
    for (int d0 = 0; d0 < 8; ++d0) S.qr[d0] = load8(nxt.H + (size_t)(nxt.P0 + wid * QBLK + r32) * nrs + d0 * 16 + hi * 8);
    SBAR();
    finishSM(pA0, pA1, alA, l_reg, pa0, pa1, pa2, pa3); SBAR();
    pv_tile<0>(o, vb0, pa0, pa1, pa2, pa3, ACT(even ? NT - 2 : NT - 1));
    if (even) { MASKT(pB0, pB1, NT - 1); partialSM(pB0, pB1, m_reg, mnB, alB); __syncthreads(); RESC(alB);
        finishSM(pB0, pB1, alB, l_reg, pa0, pa1, pa2, pa3); SBAR(); pv_tile<1>(o, vb0, pa0, pa1, pa2, pa3, ACT(NT - 1)); }
    SBAR(); SEAM_K0();
    if (hi == 0) { li_l[r32] = l_reg; cur.ST[(size_t)(wid * QBLK + r32) * sst] = (f32x2){m_reg, l_reg}; }
    asm volatile("s_waitcnt lgkmcnt(0)" ::: "memory");
    float rli[16];
#pragma unroll
    for (int r = 0; r < 16; ++r) rli[r] = __builtin_amdgcn_rcpf(li_l[crow(r, hi)]);
    bf16_t* Ow = cur.O + (size_t)(wid * QBLK) * ors;
#pragma unroll
    for (int r = 0; r < 16; ++r) { const int orow = crow(r, hi);
#pragma unroll
        for (int d0 = 0; d0 < 4; ++d0) { const float v = o[d0][r] * rli[r];
            const float vn = __shfl_xor(v, 1);
            if ((r32 & 1) == 0) *(unsigned*)(Ow + (size_t)orow * ors + d0 * 32 + r32) = cvtpk(v, vn); } }
    __syncthreads();
#undef RESC
#undef KBASE
#undef ACT
#undef MASKT
#undef SEAM_K0
#undef HALF_STEP
}
#undef ROWP
#undef VMW
#undef VMWN
#undef SLOAD_H
#undef SWRITE_HK
#undef SWRITE_HV
#undef SWRITE_H
}

struct Args {
    const float* x; const float* w_in; const float* conv_w; const float* conv_b; const float* w_rg_a; const float* b_rg_a; const float* w_rg_x; const float* b_rg_x;
    const float* lru_lambda; const float* w_out; const float* ln1_g; const float* ln1_b; const float* w_router; const float* router_bias;
    const float* w_gate; const float* w_up; const float* w_down; const float* ws_gate; const float* ws_up; const float* ws_down; const float* ln2_g; const float* ln2_b;
    float* out; unsigned char* ws; int ph_lo, ph_hi, coop, pad;
};

struct TrItem { const float* src; bf16_t* dst; int ld, ldd, k0, n0, dst_row0; };
__device__ __forceinline__ void tr_load(const TrItem& it, int lane, f32x4 (&v)[16]) {
    const float* p = it.src + (size_t)(it.k0 + (lane >> 4)) * it.ld + it.n0 + (lane & 15) * 4;
#pragma unroll
    for (int i = 0; i < 16; ++i) v[i] = *(const f32x4*)(p + (size_t)(4 * i) * it.ld);
}
__device__ __forceinline__ void tr_store(const TrItem& it, int lane, const f32x4 (&v)[16], LAS float* scr, int mode, size_t lo_off) {
    const int r = lane >> 4, c4 = (lane & 15) * 4;
#pragma unroll
    for (int i = 0; i < 16; ++i)
#pragma unroll
        for (int j = 0; j < 4; ++j) scr[(c4 + j) * 65 + 4 * i + r] = v[i][j];
    LDS_WAIT(); asm volatile("" ::: "memory");
    const int kc = lane & 7;
#pragma unroll
    for (int p = 0; p < 8; ++p) {
        const int n = (lane >> 3) + 8 * p; const LAS float* s = scr + n * 65 + 8 * kc;
        float f[8];
#pragma unroll
        for (int j = 0; j < 8; ++j) f[j] = s[j];
        u32x4 o; o.x = cvt_pk_bf16(f[0], f[1]); o.y = cvt_pk_bf16(f[2], f[3]); o.z = cvt_pk_bf16(f[4], f[5]); o.w = cvt_pk_bf16(f[6], f[7]);
        bf16_t* d = it.dst + (size_t)(it.dst_row0 + n) * it.ldd + it.k0 + 8 * kc;
        *(u32x4*)d = o;
        if (mode == 1) {
            u32x4 l; l.x = cvt_pk_bf16(f[0] - bflo(o.x), f[1] - bfhi(o.x)); l.y = cvt_pk_bf16(f[2] - bflo(o.y), f[3] - bfhi(o.y));
            l.z = cvt_pk_bf16(f[4] - bflo(o.z), f[5] - bfhi(o.z)); l.w = cvt_pk_bf16(f[6] - bflo(o.w), f[7] - bfhi(o.w));
            *(u32x4*)(d + lo_off) = l;
        }
    }
    LDS_WAIT(); asm volatile("" ::: "memory");
}
constexpr int IT_WIN = 32 * 80, IT_WOUT = 32 * 32, IT_GU1 = 32 * 8, IT_GU = NE1 * 2 * IT_GU1, IT_D1 = 8 * 32, IT_D = NE1 * IT_D1, IT_RG = 8 * 2 * 4, IT_RT = 32;
constexpr int IT_TOTAL = IT_WIN + IT_WOUT + IT_GU + IT_D + IT_RG + IT_RT;
__device__ __forceinline__ int tr_decode(const Args& a, int it, TrItem& t) {
    unsigned char* ws = a.ws;
    if (it < IT_WIN) { t.src = a.w_in; t.ld = NPROJ; t.k0 = (it / 80) * 64; t.n0 = (it % 80) * 64; t.dst = (bf16_t*)(ws + WS_WIN); t.ldd = DM; t.dst_row0 = t.n0; return 0; }
    it -= IT_WIN;
    if (it < IT_WOUT) { t.src = a.w_out; t.ld = DM; t.k0 = (it / 32) * 64; t.n0 = (it % 32) * 64; t.dst = (bf16_t*)(ws + WS_WOUT); t.ldd = DM; t.dst_row0 = t.n0; return 0; }
    it -= IT_WOUT;
    if (it < IT_GU) { const int e = it / (2 * IT_GU1), r = it % (2 * IT_GU1), up = r / IT_GU1, q = r % IT_GU1;
        const float* src = e < NEXP ? (up ? a.w_up : a.w_gate) + (size_t)e * DM * DEXP : (up ? a.ws_up : a.ws_gate);
        t.src = src; t.ld = DEXP; t.k0 = (q / 8) * 64; t.n0 = (q % 8) * 64; t.dst = (bf16_t*)(ws + WS_WGU) + (size_t)e * 1024 * DM; t.ldd = DM;
        t.dst_row0 = (t.n0 >> 7) * 256 + up * 128 + (t.n0 & 127); return 0; }
    it -= IT_GU;
    if (it < IT_D) { const int e = it / IT_D1, q = it % IT_D1;
        t.src = e < NEXP ? a.w_down + (size_t)e * DEXP * DM : a.ws_down; t.ld = DM; t.k0 = (q / 32) * 64; t.n0 = (q % 32) * 64;
        t.dst = (bf16_t*)(ws + WS_WD) + (size_t)e * DM * DEXP; t.ldd = DEXP; t.dst_row0 = t.n0; return 0; }
    it -= IT_D;
    if (it < IT_RG) { const int n = it / 8, r = it % 8, mat = r / 4, q = r % 4;
        t.src = (mat ? a.w_rg_x : a.w_rg_a) + (size_t)n * 128 * 128; t.ld = 128; t.k0 = (q / 2) * 64; t.n0 = (q % 2) * 64;
        t.dst = (bf16_t*)(ws + WS_WRG) + (size_t)n * 256 * 128; t.ldd = 128; t.dst_row0 = mat * 128 + t.n0; return 0; }
    it -= IT_RG;
    t.src = a.w_router; t.ld = NEXP; t.k0 = it * 64; t.n0 = 0; t.dst = (bf16_t*)(ws + WS_WR); t.ldd = DM; t.dst_row0 = 0; return 1;
}
__device__ __forceinline__ void p0_phase(const Args& a, LAS unsigned char* lds, int vcu, int G) {
    const int tid = threadIdx.x, lane = tid & 63, wave = __builtin_amdgcn_readfirstlane(tid >> 6);
    unsigned char* ws = a.ws;
    const int gt = vcu * NTHR + tid, NGT = G * NTHR;
    { unsigned* ctl = (unsigned*)(ws + WS_CTL);
      for (int i = gt; i < CW_BAR; i += NGT) ctl[i] = (i == CW_CNT + NEXP * CNT_STRIDE) ? (unsigned)NTOK : 0u;
      int* st = (int*)(ws + WS_SLOT) + (size_t)NEXP * CAP; float* sg = (float*)(ws + WS_SLOT + SLOT_ARR) + (size_t)NEXP * CAP; int* sp = (int*)(ws + WS_SLOT + 2 * SLOT_ARR) + (size_t)NEXP * CAP;
      for (int i = gt; i < NTOK; i += NGT) { st[i] = i; sg[i] = 1.f; sp[i] = i * NPAIR + 8; }
      float* tab = (float*)(ws + WS_TAB);
      for (int i = gt; i < 2048 * 16; i += NGT) { const int pos = i >> 4, j = i & 15;
          const double inv = pow(500000.0, -(double)j / 16.0), ang = (double)pos * inv; tab[i] = (float)cos(ang); tab[32768 + i] = (float)sin(ang); }
      for (int i = gt; i < 1024; i += NGT) { const float lam = a.lru_lambda[i]; tab[65536 + i] = 8.0f * log1pf(expf(-lam)); }
    }
    { const f32x4* xs = (const f32x4*)a.x; u32x4* xd = (u32x4*)(ws + WS_XB);
      constexpr int NCH = NTOK * DM / 8;
      for (int i = gt; i < NCH; i += NGT) { const f32x4 v0 = xs[2 * i], v1 = xs[2 * i + 1];
          u32x4 o; o.x = cvt_pk_bf16(v0[0], v0[1]); o.y = cvt_pk_bf16(v0[2], v0[3]); o.z = cvt_pk_bf16(v1[0], v1[1]); o.w = cvt_pk_bf16(v1[2], v1[3]); xd[i] = o; }
    }
    LAS float* scr = (LAS float*)(lds + wave * 16640);
    const int gw = vcu * NWAVES + wave, NGW = G * NWAVES;
    int it = gw;
    if (it < IT_TOTAL) {
        TrItem cur; int mode = tr_decode(a, it, cur); f32x4 v[16]; tr_load(cur, lane, v);
        for (;;) {
            const int itn = it + NGW; const bool more = itn < IT_TOTAL;
            TrItem nxt = cur; int moden = mode; f32x4 vn[16];
            if (more) { moden = tr_decode(a, itn, nxt); tr_load(nxt, lane, vn); }
            tr_store(cur, lane, v, scr, mode, (size_t)NEXP * DM);
            if (!more) break;
            cur = nxt; mode = moden; it = itn;
#pragma unroll
            for (int i = 0; i < 16; ++i) v[i] = vn[i];
        }
    }
}

constexpr int LRU_XC = 0, LRU_XCP = 272, LRU_AA = 69632, LRU_UU = LRU_AA + 32768, LRU_SA = LRU_UU + 32768, LRU_SH = LRU_SA + 2048, LRU_CARRY = LRU_SH + 2048;
static_assert(LRU_CARRY + 256 <= LDS_BYTES, "LRU LDS map");
__device__ __forceinline__ void lru_item(const Args& a, char* lds, int item) {
    const int tid = threadIdx.x, lane = tid & 63, wave = __builtin_amdgcn_readfirstlane(tid >> 6), r32 = lane & 31, hi = lane >> 5;
    const int b = item >> 5, n = (item >> 2) & 7, cq = item & 3;
    unsigned char* ws = a.ws;
    const bf16_t* proj = (const bf16_t*)(ws + WS_PROJ);
    const bf16_t* xl = proj + (size_t)(b * NGRP + n) * SEQ * 128;
    const bf16_t* gl = proj + (size_t)(b * NGRP + 8 + n) * SEQ * 128;
    bf16_t* mix = (bf16_t*)(ws + WS_MIX) + (size_t)b * SEQ * DM + n * 128 + cq * 32;
    const float* tab = (const float*)(ws + WS_TAB);
    char* XC = lds + LRU_XC; float* AA = (float*)(lds + LRU_AA); float* UU = (float*)(lds + LRU_UU); float* SA = (float*)(lds + LRU_SA); float* SH = (float*)(lds + LRU_SH); float* CARRY = (float*)(lds + LRU_CARRY);
    const bf16_t* wt = (const bf16_t*)(ws + WS_WRG) + (size_t)n * 256 * 128;
    const int chd = n * 128 + cq * 32 + r32;
    const float ba = a.b_rg_a[chd], bx = a.b_rg_x[chd], sp8 = tab[65536 + chd];
    const int cg8 = tid & 15, tg = tid >> 4;
    float cw[4][8], cb[8];
#pragma unroll
    for (int j = 0; j < 4; ++j)
#pragma unroll
        for (int c = 0; c < 8; ++c) cw[j][c] = a.conv_w[j * 1024 + n * 128 + cg8 * 8 + c];
#pragma unroll
    for (int c = 0; c < 8; ++c) cb[c] = a.conv_b[n * 128 + cg8 * 8 + c];
    if (tid < 32) CARRY[tid] = 0.f;
    const int sd = tid & 31, seg = tid >> 5;
    for (int ch = 0; ch < 8; ++ch) {
        const int s0 = ch * 256;
        { u32x4 xr[11];
#pragma unroll
          for (int i = 0; i < 11; ++i) { const int s = s0 + tg * 8 + i - 3;
              xr[i] = (u32x4){0u, 0u, 0u, 0u}; if (s >= 0) xr[i] = *(const u32x4*)(xl + (size_t)s * 128 + cg8 * 8); }
#pragma unroll
          for (int i = 0; i < 8; ++i) { float o[8];
#pragma unroll
              for (int c = 0; c < 8; ++c) o[c] = cb[c];
#pragma unroll
              for (int j = 0; j < 4; ++j) { const u32x4 w = xr[i + j];
                  o[0] += cw[j][0] * bflo(w.x); o[1] += cw[j][1] * bfhi(w.x); o[2] += cw[j][2] * bflo(w.y); o[3] += cw[j][3] * bfhi(w.y);
                  o[4] += cw[j][4] * bflo(w.z); o[5] += cw[j][5] * bfhi(w.z); o[6] += cw[j][6] * bflo(w.w); o[7] += cw[j][7] * bfhi(w.w); }
              u32x4 w; w.x = cvt_pk_bf16(o[0], o[1]); w.y = cvt_pk_bf16(o[2], o[3]); w.z = cvt_pk_bf16(o[4], o[5]); w.w = cvt_pk_bf16(o[6], o[7]);
              *(u32x4*)(XC + (tg * 8 + i) * LRU_XCP + cg8 * 16) = w; } }
        __syncthreads();
        { f32x16 ga = {}, gx = {};
          bf16x8 Ba[8], Bx[8];
#pragma unroll
          for (int ks = 0; ks < 8; ++ks) { Ba[ks] = *(const bf16x8*)(wt + (size_t)(cq * 32 + r32) * 128 + ks * 16 + hi * 8); Bx[ks] = *(const bf16x8*)(wt + (size_t)(128 + cq * 32 + r32) * 128 + ks * 16 + hi * 8); }
#pragma unroll
          for (int ks = 0; ks < 8; ++ks) { const bf16x8 af = *(const bf16x8*)(XC + (wave * 32 + r32) * LRU_XCP + (ks * 16 + hi * 8) * 2);
              ga = __builtin_amdgcn_mfma_f32_32x32x16_bf16(af, Ba[ks], ga, 0, 0, 0); gx = __builtin_amdgcn_mfma_f32_32x32x16_bf16(af, Bx[ks], gx, 0, 0, 0); }
#pragma unroll
          for (int r = 0; r < 16; ++r) { const int tok = wave * 32 + att::crow(r, hi);
              const float ra = __builtin_amdgcn_rcpf(1.f + __expf(-(ga[r] + ba))), ix = __builtin_amdgcn_rcpf(1.f + __expf(-(gx[r] + bx)));
              const float la = -ra * sp8, av = __expf(la), mult = sqrtf(-expm1f(2.f * la));
              const float xcv = bf2f(*(const unsigned short*)(XC + tok * LRU_XCP + (cq * 32 + r32) * 2));
              AA[tok * 32 + r32] = av; UU[tok * 32 + r32] = mult * ix * xcv; } }
        __syncthreads();
        { float av[16], uv[16]; float Ap = 1.f, Hp = 0.f;
          unsigned short glv[16];
#pragma unroll
          for (int i = 0; i < 16; ++i) glv[i] = gl[(size_t)(s0 + seg * 16 + i) * 128 + cq * 32 + sd];
#pragma unroll
          for (int i = 0; i < 16; ++i) { av[i] = AA[(seg * 16 + i) * 32 + sd]; uv[i] = UU[(seg * 16 + i) * 32 + sd]; Hp = av[i] * Hp + uv[i]; Ap *= av[i]; }
          SA[seg * 32 + sd] = Ap; SH[seg * 32 + sd] = Hp;
          __syncthreads();
          float carry = CARRY[(ch & 1) * 32 + sd];
          for (int s2 = 0; s2 < seg; ++s2) carry = SA[s2 * 32 + sd] * carry + SH[s2 * 32 + sd];
#pragma unroll
          for (int i = 0; i < 16; ++i) { carry = av[i] * carry + uv[i];
              mix[(size_t)(s0 + seg * 16 + i) * DM + sd] = (bf16_t)(cvt_pk_bf16(carry * bf2f(glv[i]), 0.f) & 0xffffu); }
          if (seg == 15) CARRY[((ch + 1) & 1) * 32 + sd] = carry; }
    }
    __syncthreads();
}

__device__ __forceinline__ att::BlockRef att_ref(const Args& a, int L) {
    unsigned char* ws = a.ws;
    const int p = L >> 9, q = L & 511, bh = q >> 3, sub = q & 7, b = bh >> 3, h = bh & 7;
    int dil, cls, qb;
    if (p == 0) { dil = 1; cls = 0; qb = sub; } else if (p == 1) { dil = 4; cls = sub >> 1; qb = sub & 1; } else { dil = 8; cls = sub; qb = 0; }
    const bf16_t* proj = (const bf16_t*)(ws + WS_PROJ);
    att::BlockRef r;
    r.H = proj + (size_t)(b * NGRP + 16 + h) * SEQ * 128 + cls * 128;
    r.dil = dil; r.W = (p == 2) ? 256 : 129; r.P0 = qb * 256;
    const size_t tok0 = (size_t)b * SEQ + cls + (size_t)qb * 256 * dil;
    r.O = (bf16_t*)a.out + (size_t)p * NTOK * 1024 + tok0 * 1024 + h * 128;
    r.ST = (f32x2*)(ws + WS_ASTAT) + (size_t)p * NTOK * 8 + tok0 * 8 + h;
    return r;
}
__device__ __forceinline__ void att_phase(const Args& a, char* lds, int c, int G) {
    constexpr int TOTAL = 3 * 512;
    int L = c; if (L >= TOTAL) return;
    att::BlockRef cur = att_ref(a, L);
    att::Seam S;
    att::swa_prime(cur, lds, S);
    for (;;) {
        const bool more = L + G < TOTAL;
        const att::BlockRef nxt = more ? att_ref(a, L + G) : cur;
        att::swa_block(cur, nxt, lds, S);
        if (!more) break;
        cur = nxt; L += G;
    }
}
__device__ __forceinline__ void merge_phase(const Args& a, int vcu, int G) {
    unsigned char* ws = a.ws;
    const int gt = vcu * NTHR + threadIdx.x, NGT = G * NTHR;
    const f32x2* st = (const f32x2*)(ws + WS_ASTAT); const bf16_t* op = (const bf16_t*)a.out; bf16_t* mix = (bf16_t*)(ws + WS_MIX);
    constexpr float C2 = 1.4426950408889634f * att::SCALE;
    for (int i = gt; i < NTOK * 8 * 16; i += NGT) {
        const int c = i & 15, th = i >> 4, t = th >> 3, h = th & 7;
        const f32x2 s0 = st[th], s1 = st[(size_t)NTOK * 8 + th], s2 = st[(size_t)2 * NTOK * 8 + th];
        const float mx = fmaxf(s0.x, fmaxf(s1.x, s2.x));
        const float w0 = s0.y * __builtin_amdgcn_exp2f((s0.x - mx) * C2), w1 = s1.y * __builtin_amdgcn_exp2f((s1.x - mx) * C2), w2 = s2.y * __builtin_amdgcn_exp2f((s2.x - mx) * C2);
        const float inv = 1.f / (w0 + w1 + w2);
        const size_t off = (size_t)t * 1024 + h * 128 + c * 8;
        const u32x4 a0 = *(const u32x4*)(op + off), a1 = *(const u32x4*)(op + (size_t)NTOK * 1024 + off), a2 = *(const u32x4*)(op + (size_t)2 * NTOK * 1024 + off);
        u32x4 o;
#define MRG(f) f = cvt_pk_bf16((w0 * bflo(a0.f) + w1 * bflo(a1.f) + w2 * bflo(a2.f)) * inv, (w0 * bfhi(a0.f) + w1 * bfhi(a1.f) + w2 * bfhi(a2.f)) * inv)
        o.MRG(x); o.MRG(y); o.MRG(z); o.MRG(w);
#undef MRG
        *(u32x4*)(mix + (size_t)t * DM + 1024 + h * 128 + c * 8) = o;
    }
}

constexpr int P4_ROWB = 272, P4_AH = 0, P4_AL = 64 * P4_ROWB, P4_WH = 2 * 64 * P4_ROWB, P4_WL = 3 * 64 * P4_ROWB, P4_RED = 4 * 64 * P4_ROWB, P4_STAT = P4_RED + 2 * 64 * 65 * 4, P4_LCNT = P4_STAT + 512, P4_BASE = P4_LCNT + 256, P4_REC = P4_BASE + 256;
__device__ __forceinline__ float grp8_max(float v) { v = fmaxf(v, __shfl_xor(v, 1)); v = fmaxf(v, __shfl_xor(v, 2)); v = fmaxf(v, __shfl_xor(v, 4)); return v; }
__device__ __forceinline__ float wave_max(float v) {
#pragma unroll
    for (int o = 1; o < 64; o <<= 1) v = fmaxf(v, __shfl_xor(v, o));
    return v;
}
__device__ __forceinline__ void p4_phase(const Args& a, char* lds, int vcu, int G) {
    const int tid = threadIdx.x, lane = tid & 63, wave = __builtin_amdgcn_readfirstlane(tid >> 6), r32 = lane & 31, hi = lane >> 5;
    unsigned char* ws = a.ws;
    const float* Y = a.out; bf16_t* X1 = (bf16_t*)(ws + WS_X1); const float* rpart = (const float*)(ws + WS_RPART);
    const bf16_t* WRh = (const bf16_t*)(ws + WS_WR); const bf16_t* WRl = WRh + (size_t)NEXP * DM;
    float* RED = (float*)(lds + P4_RED); f32x2* STAT = (f32x2*)(lds + P4_STAT);
    unsigned* cnt = (unsigned*)(ws + WS_CTL) + CW_CNT;
    int* slot_tok = (int*)(ws + WS_SLOT); float* slot_gate = (float*)(ws + WS_SLOT + SLOT_ARR); int* slot_pair = (int*)(ws + WS_SLOT + 2 * SLOT_ARR);
    const int mt = wave & 1, nt = (wave >> 1) & 1, kh = wave >> 2;
    const int yc = 4 * (lane & 31), yr0 = 2 * wave + (lane >> 5);
    const int we = tid >> 4, wk8 = (tid & 15) * 8;
    const float bias = a.router_bias[lane];
    for (int tile = vcu; tile < NTOK / 64; tile += G) {
        const int t0 = tile * 64;
        __syncthreads();
        unsigned* LCNT = (unsigned*)(lds + P4_LCNT); unsigned* BASE = (unsigned*)(lds + P4_BASE); u32x4* REC = (u32x4*)(lds + P4_REC);
        if (tid < 64) { LCNT[tid] = 0u; const f32x4* rp = (const f32x4*)(rpart + (size_t)(t0 + tid) * 64); float s1 = 0.f, s2 = 0.f;
#pragma unroll
            for (int i = 0; i < 16; ++i) { const f32x4 v = rp[i]; s1 += v[0] + v[2]; s2 += v[1] + v[3]; }
            const float mean = s1 * (1.f / DM), var = s2 * (1.f / DM) - mean * mean; STAT[tid] = (f32x2){mean, 1.f / sqrtf(var + LN_EPS)}; }
        f32x4 yv[4], gv, bv; u32x4 wh[2], wl[2];
#define P4_LOAD(k0) do { _Pragma("unroll") for (int i = 0; i < 4; ++i) yv[i] = *(const f32x4*)(Y + (size_t)(t0 + yr0 + 16 * i) * DM + (k0) + yc); \
        gv = *(const f32x4*)(a.ln1_g + (k0) + yc); bv = *(const f32x4*)(a.ln1_b + (k0) + yc); \
        _Pragma("unroll") for (int j = 0; j < 2; ++j) { wh[j] = *(const u32x4*)(WRh + (size_t)(we + 32 * j) * DM + (k0) + wk8); wl[j] = *(const u32x4*)(WRl + (size_t)(we + 32 * j) * DM + (k0) + wk8); } } while (0)
        P4_LOAD(0);
        f32x16 acc = {};
        for (int ch = 0; ch < 16; ++ch) {
            const int k0 = ch * 128;
            __syncthreads();
#pragma unroll
            for (int i = 0; i < 4; ++i) { const int row = yr0 + 16 * i; const f32x2 st = STAT[row];
                const f32x4 x = (yv[i] - st.x) * st.y * gv + bv;
                u32x2 hw, lw; hw.x = cvt_pk_bf16(x[0], x[1]); hw.y = cvt_pk_bf16(x[2], x[3]);
                lw.x = cvt_pk_bf16(x[0] - bflo(hw.x), x[1] - bfhi(hw.x)); lw.y = cvt_pk_bf16(x[2] - bflo(hw.y), x[3] - bfhi(hw.y));
                *(u32x2*)(lds + P4_AH + row * P4_ROWB + yc * 2) = hw; *(u32x2*)(lds + P4_AL + row * P4_ROWB + yc * 2) = lw;
                *(u32x2*)(X1 + (size_t)(t0 + row) * DM + k0 + yc) = hw; }
#pragma unroll
            for (int j = 0; j < 2; ++j) { *(u32x4*)(lds + P4_WH + (we + 32 * j) * P4_ROWB + wk8 * 2) = wh[j]; *(u32x4*)(lds + P4_WL + (we + 32 * j) * P4_ROWB + wk8 * 2) = wl[j]; }
            __syncthreads();
            if (ch + 1 < 16) P4_LOAD(k0 + 128);
#pragma unroll
            for (int kk = 0; kk < 4; ++kk) { const int ko = ((kh * 4 + kk) * 16 + 8 * hi) * 2;
                const bf16x8 Ah = *(const bf16x8*)(lds + P4_AH + (32 * mt + r32) * P4_ROWB + ko), Al = *(const bf16x8*)(lds + P4_AL + (32 * mt + r32) * P4_ROWB + ko);
                const bf16x8 Bh = *(const bf16x8*)(lds + P4_WH + (32 * nt + r32) * P4_ROWB + ko), Bl = *(const bf16x8*)(lds + P4_WL + (32 * nt + r32) * P4_ROWB + ko);
                acc = __builtin_amdgcn_mfma_f32_32x32x16_bf16(Ah, Bh, acc, 0, 0, 0); acc = __builtin_amdgcn_mfma_f32_32x32x16_bf16(Ah, Bl, acc, 0, 0, 0); acc = __builtin_amdgcn_mfma_f32_32x32x16_bf16(Al, Bh, acc, 0, 0, 0); }
        }
#undef P4_LOAD
#pragma unroll
        for (int r = 0; r < 16; ++r) RED[(kh * 64 + 32 * mt + att::crow(r, hi)) * 65 + 32 * nt + r32] = acc[r];
        __syncthreads();
        const float NEG = -__builtin_inff(); const int grp = lane >> 3;
        for (int rr = 0; rr < 8; ++rr) {
            const int row = 8 * wave + rr;
            const float lg = RED[row * 65 + lane] + RED[(64 + row) * 65 + lane];
            const float sc = __builtin_amdgcn_rcpf(1.f + __expf(-lg)), sel = sc + bias;
            const float m1 = grp8_max(sel);
            const unsigned long long eq = __ballot(sel == m1);
            const int first = __builtin_ctz((unsigned)((eq >> (8 * grp)) & 0xffull));
            const float m2 = grp8_max((lane & 7) == first ? NEG : sel);
            const float gs = m1 + m2;
            int rank = 0;
#pragma unroll
            for (int g = 0; g < 8; ++g) { const float o = __shfl(gs, 8 * g); rank += (o > gs || (o == gs && g < grp)) ? 1 : 0; }
            float msel = rank < 4 ? sel : NEG;
            int myk = -1;
#pragma unroll
            for (int k = 0; k < 8; ++k) { const float mx = wave_max(msel); const unsigned long long b = __ballot(msel == mx); const int win = __builtin_ctzll(b);
                if (lane == win) { myk = k; msel = NEG; } }
            const float gsum = wave_sum(myk >= 0 ? sc : 0.f);
            if (myk >= 0) { const unsigned lpos = atomicAdd(LCNT + lane, 1u);
                REC[row * 8 + myk] = (u32x4){(unsigned)lane, lpos, __float_as_uint(sc * (2.5f / gsum)), 0u}; }
        }
        __syncthreads();
        if (tid < 64) BASE[tid] = atomicAdd(cnt + tid * CNT_STRIDE, LCNT[tid]);
        __syncthreads();
        { const u32x4 rc = REC[tid]; const int e = (int)rc.x; const unsigned pos = BASE[e] + rc.y; const int t = t0 + (tid >> 3);
          slot_tok[(size_t)e * CAP + pos] = t; slot_gate[(size_t)e * CAP + pos] = __uint_as_float(rc.z); slot_pair[(size_t)e * CAP + pos] = t * NPAIR + (tid & 7); }
    }
    __syncthreads();
}

__device__ __forceinline__ void p8_phase(const Args& a, int vcu, int G) {
    const int tid = threadIdx.x, lane = tid & 63, wave = __builtin_amdgcn_readfirstlane(tid >> 6);
    unsigned char* ws = a.ws;
    const bf16_t* YP = (const bf16_t*)(ws + WS_BIG); const bf16_t* X1 = (const bf16_t*)(ws + WS_X1);
    const int gw = vcu * NWAVES + wave, NGW = G * NWAVES;
    f32x4 g2[8], b2[8];
#pragma unroll
    for (int j = 0; j < 4; ++j) { g2[2 * j] = *(const f32x4*)(a.ln2_g + 512 * j + 8 * lane); g2[2 * j + 1] = *(const f32x4*)(a.ln2_g + 512 * j + 8 * lane + 4);
        b2[2 * j] = *(const f32x4*)(a.ln2_b + 512 * j + 8 * lane); b2[2 * j + 1] = *(const f32x4*)(a.ln2_b + 512 * j + 8 * lane + 4); }
    for (int row = gw; row < NTOK; row += NGW) {
        f32x4 v[8];
        { const bf16_t* xr = X1 + (size_t)row * DM + 8 * lane;
#pragma unroll
          for (int j = 0; j < 4; ++j) { const u32x4 w = *(const u32x4*)(xr + 512 * j);
              v[2 * j] = (f32x4){bflo(w.x), bfhi(w.x), bflo(w.y), bfhi(w.y)} * DN_ALPHA; v[2 * j + 1] = (f32x4){bflo(w.z), bfhi(w.z), bflo(w.w), bfhi(w.w)} * DN_ALPHA; } }
#pragma unroll
        for (int p = 0; p < NPAIR; ++p) { const bf16_t* yr = YP + ((size_t)row * NPAIR + p) * DM + 8 * lane;
#pragma unroll
            for (int j = 0; j < 4; ++j) { const u32x4 w = *(const u32x4*)(yr + 512 * j);
                v[2 * j] += (f32x4){bflo(w.x), bfhi(w.x), bflo(w.y), bfhi(w.y)}; v[2 * j + 1] += (f32x4){bflo(w.z), bfhi(w.z), bflo(w.w), bfhi(w.w)}; } }
        float s = 0.f;
#pragma unroll
        for (int j = 0; j < 8; ++j) s += (v[j][0] + v[j][1]) + (v[j][2] + v[j][3]);
        const float mean = wave_sum(s) * (1.f / DM); float q = 0.f;
#pragma unroll
        for (int j = 0; j < 8; ++j) { v[j] = v[j] - mean; q += (v[j][0] * v[j][0] + v[j][1] * v[j][1]) + (v[j][2] * v[j][2] + v[j][3] * v[j][3]); }
        const float rstd = 1.f / sqrtf(wave_sum(q) * (1.f / DM) + LN_EPS);
        float* orow = a.out + (size_t)row * DM + 8 * lane;
#pragma unroll
        for (int j = 0; j < 4; ++j) { *(f32x4*)(orow + 512 * j) = v[2 * j] * rstd * g2[2 * j] + b2[2 * j]; *(f32x4*)(orow + 512 * j + 4) = v[2 * j + 1] * rstd * g2[2 * j + 1] + b2[2 * j + 1]; }
    }
}


#define XB_TMO      128
#define XB_XCNT(j)  (256  + 64 * (j))
#define XB_XSUB(j)  (1280 + 64 * (j))
#define XB_XGEN(j)  (2304 + 64 * (j))
#define XB_TOP      3328
#define XB_TOPGEN   3392
#define XCD_BAR_WORDS 3456
#define XB_SPIN_CAP (1u << 22)
__device__ __forceinline__ unsigned xb_ld(unsigned* p)              { return __hip_atomic_load(p, __ATOMIC_RELAXED, __HIP_MEMORY_SCOPE_AGENT); }
__device__ __forceinline__ unsigned xb_add(unsigned* p, unsigned v) { return __hip_atomic_fetch_add(p, v, __ATOMIC_RELAXED, __HIP_MEMORY_SCOPE_AGENT); }
__device__ __forceinline__ unsigned xb_xcc_id() { return (unsigned)__builtin_amdgcn_s_getreg((3 << 11) | 20) & 0xFu; }
#define XB_SPIN(cond, bar) do { unsigned _sp = 0; while (cond) { __builtin_amdgcn_s_sleep(1); \
    if ((++_sp & 255u) == 0u) { if (xb_ld(&(bar)[XB_TMO])) break; if (_sp > XB_SPIN_CAP) { atomicAdd(&(bar)[XB_TMO], 1u); break; } } } } while (0)
struct XcdBarrier { unsigned* bar; unsigned x; volatile LAS unsigned* st; };
__device__ __forceinline__ XcdBarrier xcd_barrier_post(unsigned* bar, volatile LAS unsigned* st) {
    XcdBarrier b; b.bar = bar; b.x = xb_xcc_id(); b.st = st;
    if (threadIdx.x == 0) (void)xb_add(&bar[XB_XCNT(b.x)], 1u);
    return b;
}
__device__ __forceinline__ void xcd_barrier_complete(unsigned* bar, unsigned x, unsigned& nloc, unsigned& nx) {
    const unsigned G = gridDim.x;
    unsigned sum, cnt, mine, sp = 0u;
    for (;;) {
        sum = 0u; cnt = 0u; mine = 0u;
#pragma unroll
        for (unsigned j = 0; j < 16; ++j) { const unsigned c = xb_ld(&bar[XB_XCNT(j)]); sum += c; cnt += (c > 0u) ? 1u : 0u; mine = (j == x) ? c : mine; }
        if (sum == G) break;
        __builtin_amdgcn_s_sleep(1);
        if ((++sp & 255u) == 0u) { if (xb_ld(&bar[XB_TMO])) break; if (sp > XB_SPIN_CAP) { atomicAdd(&bar[XB_TMO], 1u); break; } }
    }
    nloc = mine > 0u ? mine : 1u; nx = cnt > 0u ? cnt : 1u;
}
__device__ __forceinline__ void xcd_barrier(const XcdBarrier& b) {
    asm volatile("s_waitcnt vmcnt(0)" ::: "memory");
    __syncthreads();
    if (threadIdx.x == 0) {
        unsigned* bar = b.bar;
        __builtin_amdgcn_s_waitcnt(0);
        unsigned nloc = b.st[0], nx = b.st[1];
        if (nloc == 0u) { xcd_barrier_complete(bar, b.x, nloc, nx); b.st[0] = nloc; b.st[1] = nx; }
        const unsigned old = xb_add(&bar[XB_XSUB(b.x)], 1u);
        const unsigned gen = old / nloc;
        if (old + 1u == (gen + 1u) * nloc) {
            __builtin_amdgcn_fence(__ATOMIC_RELEASE, "agent");
            asm volatile("s_waitcnt vmcnt(0)" ::: "memory");
            const unsigned og = xb_add(&bar[XB_TOP], 1u);
            const unsigned tg = og / nx;
            if (og + 1u == (tg + 1u) * nx) xb_add(&bar[XB_TOPGEN], 1u);
            else XB_SPIN(xb_ld(&bar[XB_TOPGEN]) == tg, bar);
            __builtin_amdgcn_fence(__ATOMIC_ACQUIRE, "agent");
            xb_add(&bar[XB_XGEN(b.x)], 1u);
            asm volatile("s_waitcnt vmcnt(0)" ::: "memory");
        } else {
            XB_SPIN(xb_ld(&bar[XB_XGEN(b.x)]) == gen, bar);
            __builtin_amdgcn_fence(__ATOMIC_ACQUIRE, "agent");
            asm volatile("s_waitcnt vmcnt(0)" ::: "memory");
        }
    }
    __syncthreads();
}

constexpr int N_PHASES = 9;
constexpr int LDS_PRE = 131072;
constexpr int LDS_MISC = LDS_BYTES - 256;
__global__ void __launch_bounds__(NTHR, 2) hymba_fwd(Args args) {
    extern __shared__ __attribute__((aligned(16))) unsigned char lds_raw[];
    LAS unsigned char* lds = (LAS unsigned char*)lds_raw;
    const int G = gridDim.x, bx = blockIdx.x, tid = threadIdx.x;
    const int vcu = (G % 8 == 0) ? (bx % 8) * (G / 8) + bx / 8 : bx;
    unsigned char* ws = args.ws;
    const int lo = args.ph_lo, hi = args.ph_hi;
#ifndef PHASE_MASK
#define PHASE_MASK 0x1ff
#endif
#define IN(k) ((((PHASE_MASK) >> (k)) & 1) && lo <= (k) && (k) < hi)
#ifndef REP_MASK
#define REP_MASK 0
#endif
#define REPS(k) for (int rep_ = 0; rep_ < 1 + (((REP_MASK) >> (k)) & 1); ++rep_)
#define REPBAR(k) do { if ((((REP_MASK) >> (k)) & 1) && rep_ == 0 && args.coop) xcd_barrier(bar); } while (0)
#define SEAM(k) do { if (IN(k) && IN((k) + 1)) { xcd_barrier(bar); } } while (0)
    XcdBarrier bar; bar.bar = (unsigned*)(ws + WS_CTL) + CW_BAR; bar.x = 0; bar.st = (volatile LAS unsigned*)(lds + LDS_MISC);
    if (args.coop) {
        if (tid < 2) ((LAS unsigned*)(lds + LDS_MISC))[tid] = 0u;
        __syncthreads();
        bar = xcd_barrier_post((unsigned*)(ws + WS_CTL) + CW_BAR, (volatile LAS unsigned*)(lds + LDS_MISC));
    }
    if (IN(0)) REPS(0) { p0_phase(args, lds, vcu, G); REPBAR(0); }
    SEAM(0);
    if (IN(1)) {
        pg8::DenseOrder S; S.init(NTOK, NPROJ, DM, G, bx);
        EpiProj E{(bf16_t*)(ws + WS_PROJ), (const float*)(ws + WS_TAB)};
        pg8::gemm_phase<EpiProj, pg8::DenseOrder>(lds, (const bf16_t*)(ws + WS_XB), (const bf16_t*)(ws + WS_WIN), DM, S, E);
#ifdef DUP_P1
        if (args.coop) xcd_barrier(bar);
        pg8::gemm_phase<EpiProj, pg8::DenseOrder>(lds, (const bf16_t*)(ws + WS_XB), (const bf16_t*)(ws + WS_WIN), DM, S, E);
#endif
    }
    SEAM(1);
    if (IN(2)) {
        for (int item = vcu; item < 256; item += G) lru_item(args, (char*)lds_raw, item);
#ifdef DUP_LRU
        if (args.coop) xcd_barrier(bar);
        for (int item = vcu; item < 256; item += G) lru_item(args, (char*)lds_raw, item);
#endif
        att_phase(args, (char*)lds_raw, bx, G);
#ifdef DUP_ATT
        if (args.coop) xcd_barrier(bar);
        att_phase(args, (char*)lds_raw, bx, G);
#endif
    }
    SEAM(2);
    if (IN(3)) REPS(3) { merge_phase(args, vcu, G); REPBAR(3); }
    SEAM(3);
    if (IN(4)) {
        pg8::DenseOrder S; S.init(NTOK, DM, DM, G, bx);
        EpiY E{args.x, args.out, (float*)(ws + WS_RPART)};
        pg8::gemm_phase<EpiY, pg8::DenseOrder>(lds, (const bf16_t*)(ws + WS_MIX), (const bf16_t*)(ws + WS_WOUT), DM, S, E);
#ifdef DUP_P3
        if (args.coop) xcd_barrier(bar);
        pg8::gemm_phase<EpiY, pg8::DenseOrder>(lds, (const bf16_t*)(ws + WS_MIX), (const bf16_t*)(ws + WS_WOUT), DM, S, E);
#endif
    }
    SEAM(4);
    if (IN(5)) { p4_phase(args, (char*)lds_raw, vcu, G);
#ifdef DUP_P4
        if (args.coop) { xcd_barrier(bar); if (bx == 0 && tid < NEXP) ((unsigned*)(ws + WS_CTL))[CW_CNT + tid * CNT_STRIDE] = 0u; xcd_barrier(bar); }
        p4_phase(args, (char*)lds_raw, vcu, G);
#endif
    }
    SEAM(5);
    if (IN(6) || IN(7)) {
        LAS int* pre = (LAS int*)(lds + LDS_PRE);
        if (tid == 0) { const unsigned* cnt = (const unsigned*)(ws + WS_CTL) + CW_CNT; int s = 0;
            for (int e = 0; e < NE1; ++e) { pre[e] = s; s += (int)((cnt[e * CNT_STRIDE] + 255u) >> 8); } pre[NE1] = s; }
        __syncthreads();
    }
    if (IN(6)) REPS(6) {
        pg8::GroupOrder<4, true> S{(const LAS int*)(lds + LDS_PRE), (const int*)(ws + WS_CTL) + CW_CNT, (const int*)(ws + WS_SLOT), G, vcu, (size_t)1024 * DM * 2, (size_t)256 * DM * 2};
        EpiH E{(bf16_t*)(ws + WS_H)};
        pg8::gemm_phase<EpiH, pg8::GroupOrder<4, true>>(lds, (const bf16_t*)(ws + WS_X1), (const bf16_t*)(ws + WS_WGU), DM, S, E);
        REPBAR(6);
    }
    SEAM(6);
    if (IN(7)) REPS(7) {
        pg8::GroupOrder<8, false> S{(const LAS int*)(lds + LDS_PRE), (const int*)(ws + WS_CTL) + CW_CNT, (const int*)(ws + WS_SLOT), G, vcu, (size_t)DM * DEXP * 2, (size_t)256 * DEXP * 2};
        EpiPair E{(bf16_t*)(ws + WS_BIG), (const float*)(ws + WS_SLOT + SLOT_ARR), (const int*)(ws + WS_SLOT + 2 * SLOT_ARR)};
        pg8::gemm_phase<EpiPair, pg8::GroupOrder<8, false>>(lds, (const bf16_t*)(ws + WS_H), (const bf16_t*)(ws + WS_WD), DEXP, S, E);
        REPBAR(7);
    }
    SEAM(7);
    if (IN(8)) REPS(8) { p8_phase(args, vcu, G); REPBAR(8); }
#undef IN
#undef SEAM
}

extern "C" void kernel_launch(void* const* d_in, const int* in_sizes, int n_in, void* d_out, int out_size, void* d_ws, size_t ws_size, hipStream_t stream) {
    static int grid = 0;
    if (grid == 0) {
        if (n_in != 22 || out_size != NTOK * DM || ws_size < WS_END) { fprintf(stderr, "kernel_launch: unexpected problem: n_in %d out %d ws %zu (need %zu)\n", n_in, out_size, ws_size, (size_t)WS_END); grid = -1; return; }
        int dev = 0, cus = 0, per_cu = 0;
        (void)hipGetDevice(&dev); (void)hipDeviceGetAttribute(&cus, hipDeviceAttributeMultiprocessorCount, dev);
        if (hipFuncSetAttribute((const void*)hymba_fwd, hipFuncAttributeMaxDynamicSharedMemorySize, LDS_BYTES) != hipSuccess) { fprintf(stderr, "kernel_launch: hipFuncSetAttribute failed\n"); grid = -1; return; }
        if (hipOccupancyMaxActiveBlocksPerMultiprocessor(&per_cu, (const void*)hymba_fwd, NTHR, LDS_BYTES) != hipSuccess || per_cu < 1) { fprintf(stderr, "kernel_launch: occupancy query says %d\n", per_cu); per_cu = 1; }
        (void)hipGetLastError();
        grid = cus > 0 ? cus : 256;
    }
    if (grid < 0) return;
    Args a{};
    const float** f = (const float**)&a;
    for (int i = 0; i < 22; ++i) f[i] = (const float*)d_in[i];
    a.out = (float*)d_out; a.ws = (unsigned char*)d_ws; a.coop = 0; a.pad = 0;
#ifndef ONE_LAUNCH
    for (int p = 0; p < N_PHASES; ++p) { a.ph_lo = p; a.ph_hi = p + 1; hipLaunchKernelGGL(hymba_fwd, dim3(grid), dim3(NTHR), LDS_BYTES, stream, a); }
#else
    a.ph_lo = 0; a.ph_hi = N_PHASES; a.coop = 1;
    (void)hipMemsetAsync((char*)d_ws + WS_CTL + (size_t)CW_BAR * 4, 0, (size_t)XCD_BAR_WORDS * 4, stream);
    hipLaunchKernelGGL(hymba_fwd, dim3(grid), dim3(NTHR), LDS_BYTES, stream, a);
#endif
}
```

```cpp
#include <hip/hip_runtime.h>
#ifndef MULTI_LAUNCH
#define ONE_LAUNCH 1
#endif
#include <cstdio>
#include <cstdint>

#define LAS __attribute__((address_space(3)))
typedef unsigned short bf16_t;
typedef short bf16x8 __attribute__((ext_vector_type(8)));
typedef short s16x4 __attribute__((ext_vector_type(4)));
typedef float f32x2 __attribute__((ext_vector_type(2)));
typedef float f32x4 __attribute__((ext_vector_type(4)));
typedef float f32x16 __attribute__((ext_vector_type(16)));
typedef unsigned u32x2 __attribute__((ext_vector_type(2)));
typedef unsigned u32x4 __attribute__((ext_vector_type(4)));
typedef int v4i_t __attribute__((ext_vector_type(4)));
typedef int v8i_t __attribute__((ext_vector_type(8)));

constexpr int NB = 8, SEQ = 2048, DM = 2048, NTOK = NB * SEQ;
constexpr int NPROJ = 5120, NGRP = 40;
constexpr int NEXP = 64, NE1 = 65, DEXP = 512, TOPK = 8, NPAIR = 9;
constexpr int CAP = NTOK;
constexpr float DN_ALPHA = 1.189207115002721f;
constexpr float LN_EPS = 1e-5f;
constexpr int NWAVES = 8, NTHR = 512;
constexpr int LDS_BYTES = 163840;
constexpr int LDS_EPI = 131072 + 1024, EPI_ROWB = 144, EPI_WAVEB = 16 * EPI_ROWB;

constexpr size_t MiB = 1u << 20;
constexpr size_t WS_CTL = 0;
constexpr size_t WS_TAB = 1 * MiB;
constexpr size_t WS_WRG = 2 * MiB;
constexpr size_t WS_WR = 3 * MiB;
constexpr size_t WS_SLOT = 4 * MiB;
constexpr size_t SLOT_ARR = (size_t)NE1 * CAP * 4;
constexpr size_t WS_RPART = 17 * MiB;
constexpr size_t WS_ASTAT = 21 * MiB;
constexpr size_t WS_WD = 24 * MiB;
constexpr size_t WS_X1 = 154 * MiB;
constexpr size_t WS_H = 218 * MiB;
constexpr size_t WS_BIG = 380 * MiB;
constexpr size_t WS_WGU = WS_BIG;
constexpr size_t WS_XIN8 = WS_BIG + 168 * MiB;
constexpr size_t WS_WIN8 = WS_BIG + 200 * MiB;
constexpr size_t WS_X8 = WS_BIG + 132 * MiB;
constexpr size_t WS_WIN = WS_BIG + 260 * MiB;
constexpr size_t WS_WOUT = WS_BIG + 280 * MiB;
constexpr size_t WS_XB = WS_BIG + 288 * MiB;
constexpr size_t WS_PROJ = WS_BIG + 352 * MiB;
constexpr size_t WS_MIX = WS_BIG + 512 * MiB;
constexpr size_t WS_END = WS_BIG + 576 * MiB;

constexpr float Y8_SCALE = 32.f, W8_SCALE = 64.f, H8_SCALE = 8.f, A8_SCALE = 16.f;
constexpr int CW_CNT = 64, CNT_STRIDE = 32;
constexpr int CW_BAR = 4096;

__device__ __forceinline__ unsigned cvt_pk_bf16(float lo, float hi) { unsigned r; asm volatile("v_cvt_pk_bf16_f32 %0, %1, %2" : "=v"(r) : "v"(lo), "v"(hi)); return r; }
__device__ __forceinline__ float bf2f(unsigned short b) { return __uint_as_float(((unsigned)b) << 16); }
__device__ __forceinline__ float bflo(unsigned w) { return __uint_as_float(w << 16); }
__device__ __forceinline__ float bfhi(unsigned w) { return __uint_as_float(w & 0xffff0000u); }
__device__ __forceinline__ float wave_sum(float v) {
#pragma unroll
    for (int o = 1; o < 64; o <<= 1) v += __shfl_xor(v, o);
    return v;
}
#define LDS_WAIT() asm volatile("s_waitcnt lgkmcnt(0)" ::: "memory")
#define VM_WAIT() asm volatile("s_waitcnt vmcnt(0)" ::: "memory")

namespace pg8 {
constexpr int BM = 256, BK = 64, HALF = 128, HTB = HALF * BK * 2, STAGE_BYTES = 8 * HTB, NXCD = 8, WGM = 8;
__host__ __device__ __forceinline__ int lds_byte(int r, int c) { const int st = (r >> 4) * 2 + (c >> 5), rr = r & 15, cc = c & 31, ob = rr * 64 + cc * 2; return st * 1024 + (ob ^ (((ob >> 9) & 1) << 5)); }
__host__ __device__ __forceinline__ void stage_rc(int b, int& R, int& C) { const int st = b / 1024, sb = b % 1024, swz = sb ^ (((sb >> 9) & 1) << 5); R = (st >> 1) * 16 + swz / 64; C = (st & 1) * 32 + (swz % 64) / 2; }
__host__ __device__ __forceinline__ int perm32(int rho) { const int n = rho >> 4, i = rho & 15; return 8 * (i >> 2) + 4 * n + (i & 3); }

struct Unit { int pm, pn, e, cnt, row0; };

struct DenseOrder {
    int nM, nN, nwg, G, c, base, imax; size_t bstride;
    __device__ void init(int M, int N, int K, int G_, int c_, int base_ = 0, int imax_ = 1 << 20) { nM = M / BM; nN = N / BM; nwg = nM * nN; G = G_; c = c_; base = base_; imax = imax_; bstride = (size_t)BM * K * 2; }
    __device__ __forceinline__ bool next(int i, Unit& u) const {
        if (i >= imax) return false;
        const long L = (long)base + (long)i * G + c; if (L >= nwg) return false;
        int wgid = (int)L; { const int q = nwg / NXCD, r = nwg % NXCD, xcd = wgid % NXCD, off = wgid / NXCD; wgid = (xcd < r ? xcd * (q + 1) : r * (q + 1) + (xcd - r) * q) + off; }
        const int nig = WGM * nN, gid = wgid / nig, fm = gid * WGM, gsz = (nM - fm) < WGM ? (nM - fm) : WGM;
        u.pm = fm + ((wgid % nig) % gsz); u.pn = (wgid % nig) / gsz; u.e = 0; u.cnt = 0; u.row0 = 0; return true;
    }
    __device__ __forceinline__ int arow(const Unit& u, int r) const { return u.pm * BM + r; }
    __device__ __forceinline__ size_t boff(const Unit& u) const { return (size_t)u.pn * bstride; }
};
template <int NPN, bool GATHER> struct GroupOrder {
    const LAS int* pre; const int* cnt; const int* slot_tok; int G, vcu; size_t estride, pstride;
    LAS v4i_t* list;
    static constexpr int MAXU = 32;
    __device__ __forceinline__ void build() const {
        if (threadIdx.x < MAXU) { const int i = threadIdx.x; const int L = i * G + vcu; const int total = pre[NE1] * NPN; v4i_t r = (v4i_t){-1, 0, 0, 0};
            if (L < total) { const int T = L / NPN, pn = L - T * NPN; int lo = 0, hi = NE1;
                while (hi - lo > 1) { const int mid = (lo + hi) >> 1; if (pre[mid] <= T) lo = mid; else hi = mid; }
                r = (v4i_t){lo, (T - pre[lo]) | (pn << 16), cnt[lo * CNT_STRIDE], pre[lo] * BM}; }
            list[i] = r; }
        __syncthreads();
    }
    __device__ __forceinline__ bool next(int i, Unit& u) const {
        if (i >= MAXU) return false;
        const v4i_t r = list[i]; if (r.x < 0) return false;
        u.e = r.x; u.pm = r.y & 0xffff; u.pn = r.y >> 16; u.cnt = r.z; u.row0 = r.w; return true;
    }
    __device__ __forceinline__ int arow(const Unit& u, int r) const {
        const int s = u.pm * BM + r;
        if (GATHER) { return s < u.cnt ? slot_tok[(size_t)u.e * CAP + s] : 0; }
        else return u.row0 + s;
    }
    __device__ __forceinline__ size_t boff(const Unit& u) const { return (size_t)u.e * estride + (size_t)u.pn * pstride; }
};

template <class Epi, class Sched, bool F8 = false, int MIX1 = 0, int MIX2 = 0, int PROBE = 0>
__device__ __forceinline__ void gemm_phase(LAS unsigned char* lds, const bf16_t* Abase, const bf16_t* Bbase, const int K, const Sched& S, const Epi& E, const void* Abase2 = nullptr, const void* Bbase2 = nullptr) {
    const int tid = threadIdx.x, wid = __builtin_amdgcn_readfirstlane(tid >> 6), lane = tid & 63, wr = wid >> 2, wc = wid & 3, fr = lane & 15, fq = lane >> 4;
    const int nt = MIX1 ? (MIX1 + MIX2) : K / BK;
    constexpr int SCW = MIX1 ? 0x79797979 : 0x7f7f7f7f, SCX = MIX1 ? 0x7b7b7b7b : 0x7f7f7f7f;
    int Rr[2], Cc[2]; unsigned voffB[2];
#pragma unroll
    for (int i = 0; i < 2; ++i) { int R, C; stage_rc(tid * 16 + i * 8192, R, C); Rr[i] = R; Cc[i] = C; int Rb = Epi::PERM ? ((R & ~31) + perm32(R & 31)) : R;
        if constexpr (Epi::RELABEL) Rb = 64 * (R >> 5) + (Epi::PERM ? perm32(R & 31) : (R & 31));
        voffB[i] = (unsigned)(Rb * K + C) * 2u; }
    const size_t kstep = (size_t)(BK * 2);
    const size_t hstep = (size_t)(Epi::RELABEL ? 32 : HALF) * K * 2;
    const unsigned ldsw = (unsigned)wid * 1024u;
    const int aoff = lds_byte(wr * 64 + fr, fq * 8), boff = lds_byte(wc * 32 + fr, fq * 8);
#define PG8_SA(b, h) (((b) * 2 + (h)) * HTB)
#define PG8_SB(b, h) ((4 + (b) * 2 + (h)) * HTB)
#define PG8_STAGE(bufoff, gbase, voff) do { _Pragma("unroll") for (int _i = 0; _i < 2; ++_i) \
        __builtin_amdgcn_global_load_lds((const unsigned*)((const char*)(gbase) + (voff)[_i]), (LAS unsigned*)(lds + (bufoff) + ldsw + _i * 8192), 16, 0, 0); } while (0)
#define PG8_LDA(dst, b, h) do { _Pragma("unroll") for (int m = 0; m < 4; ++m) { const v4i_t lo_ = *(const LAS v4i_t*)(lds + PG8_SA(b, h) + aoff + m * 2048), hi_ = *(const LAS v4i_t*)(lds + PG8_SA(b, h) + aoff + m * 2048 + 1024); \
        dst[m] = __builtin_shufflevector(lo_, hi_, 0, 1, 2, 3, 4, 5, 6, 7); } } while (0)
#define PG8_LDB(dst, b, h) do { _Pragma("unroll") for (int n = 0; n < 2; ++n) { const v4i_t lo_ = *(const LAS v4i_t*)(lds + PG8_SB(b, h) + boff + n * 2048), hi_ = *(const LAS v4i_t*)(lds + PG8_SB(b, h) + boff + n * 2048 + 1024); \
        dst[n] = __builtin_shufflevector(lo_, hi_, 0, 1, 2, 3, 4, 5, 6, 7); } } while (0)
#define PG8_LO(x) __builtin_bit_cast(bf16x8, __builtin_shufflevector(x, x, 0, 1, 2, 3))
#define PG8_HI(x) __builtin_bit_cast(bf16x8, __builtin_shufflevector(x, x, 4, 5, 6, 7))
#define PG8_MMA(ai, bj, At, Bt) do { __builtin_amdgcn_s_setprio(1); _Pragma("unroll") for (int m = 0; m < 4; ++m) _Pragma("unroll") for (int n = 0; n < 2; ++n) { \
        if (f8t) { acc[ai][bj][m][n] = __builtin_amdgcn_mfma_scale_f32_16x16x128_f8f6f4(Bt[n], At[m], acc[ai][bj][m][n], 0, 0, 0, SCW, 0, SCX); } \
        else { acc[ai][bj][m][n] = __builtin_amdgcn_mfma_f32_16x16x32_bf16(PG8_LO(Bt[n]), PG8_LO(At[m]), acc[ai][bj][m][n], 0, 0, 0); \
               acc[ai][bj][m][n] = __builtin_amdgcn_mfma_f32_16x16x32_bf16(PG8_HI(Bt[n]), PG8_HI(At[m]), acc[ai][bj][m][n], 0, 0, 0); } } \
        __builtin_amdgcn_s_setprio(0); } while (0)
#define PG8_WAIT_V(n) asm volatile("s_waitcnt vmcnt(" #n ")" ::: "memory")
#define PG8_WAIT_L(n) asm volatile("s_waitcnt lgkmcnt(" #n ")" ::: "memory")
#define PG8_BAR __builtin_amdgcn_s_barrier()
#define PG8_SCHED __builtin_amdgcn_sched_barrier(0)
#define PG8_AOFFS(u, v0, v1) do { _Pragma("unroll") for (int _i = 0; _i < 2; ++_i) { \
        v0[_i] = (unsigned)(((size_t)S.arow(u, Rr[_i]) * K + Cc[_i]) * 2u); v1[_i] = (unsigned)(((size_t)S.arow(u, HALF + Rr[_i]) * K + Cc[_i]) * 2u); } } while (0)
    Unit cur, nxt; int ui = 0;
    if (!S.next(0, cur)) return;
    f32x4 acc[2][2][4][2];
#pragma unroll
    for (int a = 0; a < 2; ++a)
#pragma unroll
        for (int b = 0; b < 2; ++b)
#pragma unroll
            for (int m = 0; m < 4; ++m)
#pragma unroll
                for (int n = 0; n < 2; ++n) acc[a][b][m][n] = (f32x4){0.f, 0.f, 0.f, 0.f};
    v8i_t At[4], B0[2], B1[2];
    unsigned vA0[2], vA1[2], nA0[2], nA1[2];
    PG8_AOFFS(cur, vA0, vA1);
    bool has_next = S.next(1, nxt);
    if (has_next) { PG8_AOFFS(nxt, nA0, nA1); } else { nA0[0] = vA0[0]; nA0[1] = vA0[1]; nA1[0] = vA1[0]; nA1[1] = vA1[1]; }
    asm volatile("" : "+v"(vA0[0]), "+v"(vA0[1]), "+v"(vA1[0]), "+v"(vA1[1]), "+v"(nA0[0]), "+v"(nA0[1]), "+v"(nA1[0]), "+v"(nA1[1]));
    const char* cA = (const char*)Abase; const char* cB = (const char*)Bbase + S.boff(cur);
    const char* cA2 = (const char*)Abase2; const char* cB2 = MIX1 ? (const char*)Bbase2 + S.boff(cur) : nullptr;
#define PG8_A_AT(tau) ((MIX1 && (tau) >= MIX1) ? cA2 + (size_t)((tau) - MIX1) * kstep : cA + (size_t)(tau) * kstep)
#define PG8_B_AT(tau) ((MIX1 && (tau) >= MIX1) ? cB2 + (size_t)((tau) - MIX1) * kstep : cB + (size_t)(tau) * kstep)
    PG8_STAGE(PG8_SB(0, 0), cB, voffB); PG8_STAGE(PG8_SB(0, 1), cB + hstep, voffB); PG8_STAGE(PG8_SA(0, 0), cA, vA0); PG8_STAGE(PG8_SA(0, 1), cA, vA1);
    if (wr == 1) PG8_BAR;
    PG8_WAIT_V(2); PG8_BAR;
    PG8_STAGE(PG8_SB(1, 0), cB + kstep, voffB); PG8_STAGE(PG8_SA(1, 0), cA + kstep, vA0); PG8_STAGE(PG8_SB(1, 1), cB + hstep + kstep, voffB);
    PG8_WAIT_V(6); PG8_BAR;
    for (;;) {
        const char* nB = has_next ? (const char*)Bbase + S.boff(nxt) : cB;
        const char* nB2 = (MIX1 && has_next) ? (const char*)Bbase2 + S.boff(nxt) : cB2;
#define PG8_KBODY(F8T_) do { \
            constexpr bool f8t = (F8T_); const bool last = (t == nt - 2); \
            const char* a1 = PG8_A_AT(t + 1); \
            const char* b2 = last ? nB : PG8_B_AT(t + 2); \
            const char* a2 = last ? cA : PG8_A_AT(t + 2); \
            const char* a3 = last ? cA + kstep : PG8_A_AT(t + 3); const char* b3 = last ? nB + kstep : PG8_B_AT(t + 3); \
              \
            PG8_LDB(B0, 0, 0); PG8_LDB(B1, 0, 1); PG8_SCHED; PG8_LDA(At, 0, 0); PG8_STAGE(PG8_SA(1, 1), a1, vA1); \
            if (last) { vA0[0] = nA0[0]; vA0[1] = nA0[1]; vA1[0] = nA1[0]; vA1[1] = nA1[1]; } \
            PG8_WAIT_V(8); PG8_WAIT_L(0); PG8_BAR; PG8_SCHED; PG8_MMA(0, 0, At, B0); PG8_MMA(0, 1, At, B1); PG8_SCHED; PG8_BAR; PG8_SCHED; \
              \
            PG8_LDA(At, 0, 1); PG8_STAGE(PG8_SB(0, 0), b2, voffB); PG8_STAGE(PG8_SB(0, 1), b2 + hstep, voffB); PG8_STAGE(PG8_SA(0, 0), a2, vA0); \
            PG8_WAIT_V(8); PG8_WAIT_L(0); PG8_BAR; PG8_SCHED; if constexpr (PROBE == 0) { PG8_MMA(1, 0, At, B0); PG8_MMA(1, 1, At, B1); } PG8_SCHED; PG8_BAR; PG8_SCHED; \
              \
            PG8_LDB(B0, 1, 0); PG8_LDB(B1, 1, 1); PG8_SCHED; PG8_LDA(At, 1, 0); PG8_STAGE(PG8_SA(0, 1), a2, vA1); \
            PG8_WAIT_V(8); PG8_WAIT_L(0); PG8_BAR; PG8_SCHED; PG8_MMA(0, 0, At, B0); PG8_MMA(0, 1, At, B1); PG8_SCHED; PG8_BAR; PG8_SCHED; \
              \
            PG8_LDA(At, 1, 1); PG8_STAGE(PG8_SB(1, 0), b3, voffB); PG8_STAGE(PG8_SB(1, 1), b3 + hstep, voffB); PG8_STAGE(PG8_SA(1, 0), a3, vA0); \
            PG8_WAIT_V(8); PG8_WAIT_L(0); PG8_BAR; PG8_SCHED; if constexpr (PROBE == 0) { PG8_MMA(1, 0, At, B0); PG8_MMA(1, 1, At, B1); } PG8_SCHED; PG8_BAR; PG8_SCHED; \
        } while (0)
        if constexpr (MIX1 > 0) {
            int t = 0;
#pragma unroll 1
            for (; t < MIX1; t += 2) PG8_KBODY(false);
#pragma unroll 1
            for (; t < nt; t += 2) PG8_KBODY(true);
        } else {
#pragma unroll 1
            for (int t = 0; t < nt; t += 2) PG8_KBODY(F8);
        }
#undef PG8_KBODY
        if (wr == 0) PG8_BAR;
        E(acc, cur, wr, wc, fr, fq);
        if (!has_next) break;
#pragma unroll
        for (int a = 0; a < 2; ++a)
#pragma unroll
            for (int b = 0; b < 2; ++b)
#pragma unroll
                for (int m = 0; m < 4; ++m)
#pragma unroll
                    for (int n = 0; n < 2; ++n) acc[a][b][m][n] = (f32x4){0.f, 0.f, 0.f, 0.f};
        cur = nxt; cB = nB; cB2 = nB2; ++ui;
        has_next = S.next(ui + 1, nxt);
        if (has_next) { PG8_AOFFS(nxt, nA0, nA1); }
        asm volatile("" : "+v"(nA0[0]), "+v"(nA0[1]), "+v"(nA1[0]), "+v"(nA1[1]));
        if (wr == 1) PG8_BAR;
    }
    PG8_WAIT_V(0);
    PG8_BAR;
#undef PG8_SA
#undef PG8_SB
#undef PG8_STAGE
#undef PG8_LDA
#undef PG8_LDB
#undef PG8_MMA
#undef PG8_WAIT_V
#undef PG8_WAIT_L
#undef PG8_BAR
#undef PG8_SCHED
#undef PG8_AOFFS
#undef PG8_A_AT
#undef PG8_B_AT
}
}

struct EpiProj {
    static constexpr bool RELABEL = true, PERM = true;
    bf16_t* proj; const float* rope; LAS unsigned char* lds; int pn_off; float scale;
    __device__ __forceinline__ void operator()(const f32x4 (&acc)[2][2][4][2], const pg8::Unit& u, int wr, int wc, int fr, int fq) const {
        const int pnl = u.pn + pn_off, type = pnl >> 2;
        const int lane = 16 * fq + fr, wid = wr * 4 + wc;
        LAS unsigned char* scr = lds + LDS_EPI + wid * EPI_WAVEB;
        const int row0 = u.pm * 256 + wr * 64, b = row0 >> 11;
        const bool rot = (type == 2 || type == 3) && (wc & 1) == 0;
        const float sgn = fq < 2 ? -1.f : 1.f;
        const int g = 2 * pnl + (wc >> 1);
        bf16_t* gbase = proj + ((size_t)(b * NGRP + g) * SEQ) * 128 + 64 * (wc & 1) + 8 * (lane & 7);
#pragma unroll
        for (int ai = 0; ai < 2; ++ai)
#pragma unroll
            for (int m = 0; m < 4; ++m) {
                const int sb = (row0 + ai * 128 + m * 16) & 2047, s = sb + fr;
                u32x4 x[2];
#pragma unroll
                for (int bj = 0; bj < 2; ++bj) {
                    f32x4 v0 = acc[ai][bj][m][0] * scale, v1 = acc[ai][bj][m][1] * scale;
                    if (type == 1) {
#pragma unroll
                        for (int j = 0; j < 4; ++j) {
                            { const float xx = v0[j]; const float e = __builtin_amdgcn_exp2f(-2.302208198f * (xx + 0.044715f * xx * xx * xx)); v0[j] = xx * __builtin_amdgcn_rcpf(1.f + e); }
                            { const float xx = v1[j]; const float e = __builtin_amdgcn_exp2f(-2.302208198f * (xx + 0.044715f * xx * xx * xx)); v1[j] = xx * __builtin_amdgcn_rcpf(1.f + e); }
                        }
                    }
                    if (rot && bj == 0) {
                        const float* cp = rope + s * 16 + 8 * (fq & 1);
                        const f32x4 c0 = *(const f32x4*)cp, c1 = *(const f32x4*)(cp + 4), s0 = *(const f32x4*)(cp + 32768), s1 = *(const f32x4*)(cp + 32768 + 4);
                        f32x4 p0, p1;
#pragma unroll
                        for (int j = 0; j < 4; ++j) { p0[j] = __shfl_xor(v0[j], 32); p1[j] = __shfl_xor(v1[j], 32); }
                        v0 = v0 * c0 + sgn * (p0 * s0); v1 = v1 * c1 + sgn * (p1 * s1);
                    }
                    x[bj].x = cvt_pk_bf16(v0[0], v0[1]); x[bj].y = cvt_pk_bf16(v0[2], v0[3]); x[bj].z = cvt_pk_bf16(v1[0], v1[1]); x[bj].w = cvt_pk_bf16(v1[2], v1[3]);
                }
                *(LAS u32x4*)(scr + fr * EPI_ROWB + fq * 16) = x[0]; *(LAS u32x4*)(scr + fr * EPI_ROWB + 64 + fq * 16) = x[1];
                const u32x4 ta = *(const LAS u32x4*)(scr + (lane >> 3) * EPI_ROWB + (lane & 7) * 16), tb = *(const LAS u32x4*)(scr + (8 + (lane >> 3)) * EPI_ROWB + (lane & 7) * 16);
                *(u32x4*)(gbase + (size_t)(sb + (lane >> 3)) * 128) = ta; *(u32x4*)(gbase + (size_t)(sb + 8 + (lane >> 3)) * 128) = tb;
            }
    }
};
struct EpiY {
    static constexpr bool RELABEL = false, PERM = false;
    const bf16_t* xbf; float* y; float* rpart; LAS unsigned char* lds;
    __device__ __forceinline__ void operator()(const f32x4 (&acc)[2][2][4][2], const pg8::Unit& u, int wr, int wc, int fr, int fq) const {
        const int lane = 16 * fq + fr, wid = wr * 4 + wc;
        LAS unsigned char* scr = lds + LDS_EPI + wid * EPI_WAVEB;
        const int rA = lane >> 3, ch = lane & 7;
        const int rowb = u.pm * 256 + wr * 64 + rA, colb = u.pn * 256 + wc * 32 + 4 * ch;
        u32x2 xa[4], xb[4], xc[4];
#define EPIY_LOAD(dst, g) do { const size_t off_ = (size_t)(rowb + ((g) >> 2) * 128 + ((g) & 3) * 16) * DM + colb; \
        _Pragma("unroll") for (int bj = 0; bj < 2; ++bj) { dst[bj * 2] = __builtin_nontemporal_load((const u32x2*)(xbf + off_ + bj * 128)); dst[bj * 2 + 1] = __builtin_nontemporal_load((const u32x2*)(xbf + off_ + 8 * DM + bj * 128)); } } while (0)
        EPIY_LOAD(xa, 0); EPIY_LOAD(xb, 1);
#pragma unroll
        for (int g = 0; g < 8; ++g) {
            const int ai = g >> 2, m = g & 3;
            if (g + 2 < 8) EPIY_LOAD(xc, g + 2);
            const int r0 = rowb + ai * 128 + m * 16;
            float sA1 = 0.f, sA2 = 0.f, sB1 = 0.f, sB2 = 0.f;
#pragma unroll
            for (int bj = 0; bj < 2; ++bj) {
                *(LAS f32x4*)(scr + fr * EPI_ROWB + fq * 16) = acc[ai][bj][m][0]; *(LAS f32x4*)(scr + fr * EPI_ROWB + 64 + fq * 16) = acc[ai][bj][m][1];
                const f32x4 ta = *(const LAS f32x4*)(scr + rA * EPI_ROWB + ch * 16), tb = *(const LAS f32x4*)(scr + (8 + rA) * EPI_ROWB + ch * 16);
                const u32x2 wa = xa[bj * 2], wb = xa[bj * 2 + 1];
                const f32x4 oa = (f32x4){bflo(wa.x), bfhi(wa.x), bflo(wa.y), bfhi(wa.y)} * DN_ALPHA + ta, ob = (f32x4){bflo(wb.x), bfhi(wb.x), bflo(wb.y), bfhi(wb.y)} * DN_ALPHA + tb;
                *(f32x4*)(y + (size_t)r0 * DM + colb + bj * 128) = oa; *(f32x4*)(y + (size_t)(r0 + 8) * DM + colb + bj * 128) = ob;
                sA1 += (oa[0] + oa[1]) + (oa[2] + oa[3]); sA2 += (oa[0] * oa[0] + oa[1] * oa[1]) + (oa[2] * oa[2] + oa[3] * oa[3]);
                sB1 += (ob[0] + ob[1]) + (ob[2] + ob[3]); sB2 += (ob[0] * ob[0] + ob[1] * ob[1]) + (ob[2] * ob[2] + ob[3] * ob[3]);
            }
#pragma unroll
            for (int o = 1; o < 8; o <<= 1) { sA1 += __shfl_xor(sA1, o); sA2 += __shfl_xor(sA2, o); sB1 += __shfl_xor(sB1, o); sB2 += __shfl_xor(sB2, o); }
            if (ch == 0) { *(f32x2*)(rpart + ((size_t)r0 * 32 + u.pn * 4 + wc) * 2) = (f32x2){sA1, sA2}; *(f32x2*)(rpart + ((size_t)(r0 + 8) * 32 + u.pn * 4 + wc) * 2) = (f32x2){sB1, sB2}; }
#pragma unroll
            for (int i = 0; i < 4; ++i) { xa[i] = xb[i]; xb[i] = xc[i]; }
        }
#undef EPIY_LOAD
    }
};
struct EpiH {
    static constexpr bool RELABEL = false, PERM = true;
    unsigned char* h8; const float* slot_gate;
    __device__ __forceinline__ void operator()(const f32x4 (&acc)[2][2][4][2], const pg8::Unit& u, int wr, int wc, int fr, int fq) const {
        const int s0 = u.pm * 256 + wr * 64 + fr, row0 = u.row0 + s0, col0 = u.pn * 128 + wc * 32 + 8 * fq;
#pragma unroll
        for (int ai = 0; ai < 2; ++ai)
#pragma unroll
            for (int m = 0; m < 4; ++m) {
                const float rg = H8_SCALE;
                f32x4 o[2];
#pragma unroll
                for (int n = 0; n < 2; ++n)
#pragma unroll
                    for (int j = 0; j < 4; ++j) { const float g = acc[ai][0][m][n][j] * (1.f / W8_SCALE), up = acc[ai][1][m][n][j] * (1.f / W8_SCALE);
                        const float e = __builtin_amdgcn_exp2f(-1.4426950408889634f * g); o[n][j] = g * __builtin_amdgcn_rcpf(1.f + e) * (up * rg); }
                u32x2 w; int t = __builtin_amdgcn_cvt_pk_fp8_f32(o[0][0], o[0][1], 0, false); t = __builtin_amdgcn_cvt_pk_fp8_f32(o[0][2], o[0][3], t, true); w.x = (unsigned)t;
                t = __builtin_amdgcn_cvt_pk_fp8_f32(o[1][0], o[1][1], 0, false); t = __builtin_amdgcn_cvt_pk_fp8_f32(o[1][2], o[1][3], t, true); w.y = (unsigned)t;
                *(u32x2*)(h8 + (size_t)(row0 + ai * 128 + m * 16) * DEXP + col0) = w;
            }
    }
};
struct EpiPair {
    static constexpr bool RELABEL = false, PERM = true;
    unsigned char* y8; LAS unsigned char* lds; int dry;
    __device__ __forceinline__ void operator()(const f32x4 (&acc)[2][2][4][2], const pg8::Unit& u, int wr, int wc, int fr, int fq) const {
        const int lane = 16 * fq + fr, wid = wr * 4 + wc;
        LAS unsigned char* scr = lds + LDS_EPI + wid * EPI_WAVEB;
        const size_t row0 = (size_t)u.row0 + u.pm * 256 + wr * 64 + (lane >> 2); const int col0 = u.pn * 256 + wc * 64 + 16 * (lane & 3);
#pragma unroll
        for (int ai = 0; ai < 2; ++ai)
#pragma unroll
            for (int m = 0; m < 4; ++m) {
#pragma unroll
                for (int bj = 0; bj < 2; ++bj) { const f32x4 v0 = acc[ai][bj][m][0] * (Y8_SCALE / (H8_SCALE * W8_SCALE)), v1 = acc[ai][bj][m][1] * (Y8_SCALE / (H8_SCALE * W8_SCALE));
                    u32x2 w; int t = __builtin_amdgcn_cvt_pk_fp8_f32(v0[0], v0[1], 0, false); t = __builtin_amdgcn_cvt_pk_fp8_f32(v0[2], v0[3], t, true); w.x = (unsigned)t;
                    t = __builtin_amdgcn_cvt_pk_fp8_f32(v1[0], v1[1], 0, false); t = __builtin_amdgcn_cvt_pk_fp8_f32(v1[2], v1[3], t, true); w.y = (unsigned)t;
                    *(LAS u32x2*)(scr + fr * 80 + bj * 32 + fq * 8) = w; }
                const u32x4 o = *(const LAS u32x4*)(scr + (lane >> 2) * 80 + (lane & 3) * 16);
                if (dry) { asm volatile("" :: "v"(o)); } else *(u32x4*)(y8 + (row0 + ai * 128 + m * 16) * DM + col0) = o;
            }
    }
};
namespace att {
constexpr float SCALE = 0.08838834764831845f;
constexpr float THR = 8.f;
constexpr int D = 128, NW = 8, QBLK = 32, KVBLK = 64, QB = NW * QBLK;
constexpr int SHM_V = KVBLK * D * 2, SHM_K = KVBLK * D * 2;
constexpr int LDS_BYTES = 2 * SHM_V + 2 * SHM_K + NW * 64 * 4;
#define KSWZ(row, colB) ((row) * 256 + ((colB) ^ (((row) & 7) << 4)))
#define SBAR() __builtin_amdgcn_sched_barrier(0)
__device__ __forceinline__ int v_st(int k, int c) { const int kk = (k & ~0xC) | ((k & 4) << 1) | ((k & 8) >> 1); return ((kk >> 3) * 4 + (c >> 5)) * 512 + ((kk & 7) * 32 + (c & 31)) * 2; }
__device__ __forceinline__ int v_rd_base(int lane) { return ((lane & 3) << 3) | (((lane >> 2) & 3) << 6) | (((lane >> 4) & 1) << 5) | (((lane >> 5) & 1) << 8); }
constexpr int v_rd_off(int d0, int ks, int half) { return d0 * 512 + ks * 4096 + half * 2048; }
__device__ __forceinline__ int crow(int r, int hi) { return (r & 3) + 8 * (r >> 2) + 4 * hi; }
__device__ __forceinline__ unsigned cvtpk(float lo, float hi) { unsigned r; asm volatile("v_cvt_pk_bf16_f32 %0, %1, %2" : "=v"(r) : "v"(lo), "v"(hi)); return r; }
__device__ __forceinline__ bf16x8 load8(const bf16_t* p) { return *reinterpret_cast<const bf16x8*>(p); }
__device__ __forceinline__ void mask_tile(f32x16& p0, f32x16& p1, int dq, unsigned W, unsigned par) {
    const float NEG = -__builtin_inff();
#pragma unroll
    for (int r = 0; r < 16; ++r) {
        const int c = (r & 3) + 8 * (r >> 2);
        const unsigned x0 = (unsigned)(dq - c), x1 = (unsigned)(dq - c - 32);
        if (x0 >= W || (x0 & par)) p0[r] = NEG;
        if (x1 >= W || (x1 & par)) p1[r] = NEG;
    }
}
__device__ __forceinline__ void partialSM(f32x16& p0, f32x16& p1, float& m_reg, float& mn, float& alpha) {
    float pmax = p0[0]; for (int r = 1; r < 16; ++r) pmax = fmaxf(pmax, p0[r]); for (int r = 0; r < 16; ++r) pmax = fmaxf(pmax, p1[r]);
    { auto rr = __builtin_amdgcn_permlane32_swap(__float_as_uint(pmax), __float_as_uint(pmax), false, false);
      pmax = fmaxf(__uint_as_float(rr[0]), __uint_as_float(rr[1])); }
    constexpr float C2 = 1.4426950408889634f * SCALE;
    if (__builtin_expect(__all((pmax - m_reg) * SCALE <= THR), 1)) { mn = m_reg; alpha = 1.f; }
    else { mn = fmaxf(m_reg, pmax); alpha = __builtin_amdgcn_exp2f((m_reg - mn) * C2); m_reg = mn; }
    const float mnL = -mn * C2;
    for (int r = 0; r < 16; ++r) p0[r] = fmaf(p0[r], C2, mnL); for (int r = 0; r < 16; ++r) p1[r] = fmaf(p1[r], C2, mnL);
    for (int r = 0; r < 16; ++r) p0[r] = __builtin_amdgcn_exp2f(p0[r]);
}
__device__ __forceinline__ void finishSM(f32x16& p0, f32x16& p1, float alpha, float& l_reg, bf16x8& pa0, bf16x8& pa1, bf16x8& pa2, bf16x8& pa3) {
    for (int r = 0; r < 16; ++r) p1[r] = __builtin_amdgcn_exp2f(p1[r]);
    float ps = 0; for (int r = 0; r < 16; ++r) ps += p0[r]; for (int r = 0; r < 16; ++r) ps += p1[r];
    { auto rr = __builtin_amdgcn_permlane32_swap(__float_as_uint(ps), __float_as_uint(ps), false, false);
      ps = __uint_as_float(rr[0]) + __uint_as_float(rr[1]); }
    l_reg = l_reg * alpha + ps;
#define PK4(P, B_, OUT) do { unsigned a0 = cvtpk(P[B_+0], P[B_+1]), a1 = cvtpk(P[B_+2], P[B_+3]);                          \
        unsigned b0 = cvtpk(P[B_+4], P[B_+5]), b1 = cvtpk(P[B_+6], P[B_+7]);                                             \
        auto r0 = __builtin_amdgcn_permlane32_swap(a0, b0, false, false); auto r1 = __builtin_amdgcn_permlane32_swap(a1, b1, false, false); \
        u32x4 w = {r0[0], r1[0], r0[1], r1[1]}; OUT = *reinterpret_cast<bf16x8*>(&w); } while (0)
    PK4(p0, 0, pa0); PK4(p0, 8, pa1); PK4(p1, 0, pa2); PK4(p1, 8, pa3);
#undef PK4
}
template <int KB>
__device__ __forceinline__ void qkt(f32x16& p0, f32x16& p1, const char* K_lds, int r32, int hi, const bf16x8* qr, bool act) {
    if (!act) { const float NEG = -__builtin_inff();
#pragma unroll
        for (int r = 0; r < 16; ++r) { p0[r] = NEG; p1[r] = NEG; } return; }
    p0 = f32x16{}; p1 = f32x16{};
    const char* kb[4];
#pragma unroll
    for (int dd = 0; dd < 4; ++dd) kb[dd] = K_lds + KB * SHM_K + KSWZ(r32, (dd * 16 + hi * 8) * 2);
#pragma unroll
    for (int d0 = 0; d0 < 8; ++d0) { const char* a = kb[d0 & 3] + (d0 >> 2) * 128;
        bf16x8 b0 = *reinterpret_cast<const bf16x8*>(a);
        bf16x8 b1 = *reinterpret_cast<const bf16x8*>(a + 32 * 256);
        p0 = __builtin_amdgcn_mfma_f32_32x32x16_bf16(b0, qr[d0], p0, 0, 0, 0);
        p1 = __builtin_amdgcn_mfma_f32_32x32x16_bf16(b1, qr[d0], p1, 0, 0, 0); }
}
template <int VB>
__device__ __forceinline__ void pv_tile(f32x16* o, int vb0, bf16x8 pa0, bf16x8 pa1, bf16x8 pa2, bf16x8 pa3, bool act) {
    if (!act) return;
#define TRRD(dst, off) asm volatile("ds_read_b64_tr_b16 %0, %1 offset:%2" : "=&v"(dst) : "v"(vb0), "i"(off) : "memory")
#define PV_D0(d0) do { s16x4 l0, l1, l2, l3, h0, h1, h2, h3; constexpr int b_ = VB * SHM_V + v_rd_off(d0, 0, 0); \
        TRRD(l0, b_); TRRD(h0, b_ + 2048); TRRD(l1, b_ + 4096); TRRD(h1, b_ + 6144); TRRD(l2, b_ + 8192); TRRD(h2, b_ + 10240); TRRD(l3, b_ + 12288); TRRD(h3, b_ + 14336); \
        asm volatile("s_waitcnt lgkmcnt(0)" ::: "memory"); SBAR(); \
        o[d0] = __builtin_amdgcn_mfma_f32_32x32x16_bf16(pa0, (bf16x8){l0[0], l0[1], l0[2], l0[3], h0[0], h0[1], h0[2], h0[3]}, o[d0], 0, 0, 0);   \
        o[d0] = __builtin_amdgcn_mfma_f32_32x32x16_bf16(pa1, (bf16x8){l1[0], l1[1], l1[2], l1[3], h1[0], h1[1], h1[2], h1[3]}, o[d0], 0, 0, 0);   \
        o[d0] = __builtin_amdgcn_mfma_f32_32x32x16_bf16(pa2, (bf16x8){l2[0], l2[1], l2[2], l2[3], h2[0], h2[1], h2[2], h2[3]}, o[d0], 0, 0, 0);   \
        o[d0] = __builtin_amdgcn_mfma_f32_32x32x16_bf16(pa3, (bf16x8){l3[0], l3[1], l3[2], l3[3], h3[0], h3[1], h3[2], h3[3]}, o[d0], 0, 0, 0); } while (0)
    PV_D0(0); PV_D0(1); PV_D0(2); PV_D0(3);
#undef PV_D0
#undef TRRD
}
struct BlockRef { const bf16_t* H; bf16_t* O; f32x2* ST; int P0, dil, W; };
constexpr size_t KOFF = (size_t)8 * SEQ * 128, VOFF = (size_t)16 * SEQ * 128;
struct Seam { bf16x8 qr[8]; bf16x8 st_v0, st_v1, st_k0, st_k1; };
__device__ __forceinline__ int swa_jlo(int P0, int W) { const int lowk = P0 - W + 1; return lowk > 0 ? lowk / KVBLK : 0; }
#define ROWP(p, rs_, k0, rr) ((p) + (size_t)((k0) + (rr)) * (rs_) + sc)
#define VMW() asm volatile("s_waitcnt vmcnt(0)" ::: "memory")
#define VMWN(n) asm volatile("s_waitcnt vmcnt(%0)" :: "i"(n) : "memory")
#define SLOAD_H(Kp, Vp, rs_, k0) do { S.st_v0 = load8(ROWP(Vp, rs_, k0, sr)); S.st_v1 = load8(ROWP(Vp, rs_, k0, 32 + sr));              \
                         S.st_k0 = load8(ROWP(Kp, rs_, k0, sr)); S.st_k1 = load8(ROWP(Kp, rs_, k0, 32 + sr)); } while (0)
#define SWRITE_HK(bf) do { *(bf16x8*)(K_lds + (bf) * SHM_K + kws) = S.st_k0; *(bf16x8*)(K_lds + (bf) * SHM_K + kws + 32 * 256) = S.st_k1; } while (0)
#define SWRITE_HV(bf) do { *(bf16x8*)(V_lds + (bf) * SHM_V + vst0) = S.st_v0; *(bf16x8*)(V_lds + (bf) * SHM_V + vst1) = S.st_v1; } while (0)
#define SWRITE_H(bf) do { SWRITE_HV(bf); SWRITE_HK(bf); } while (0)
__device__ __forceinline__ void swa_prime(const BlockRef& cur, char* lds, Seam& S) {
    const int tid = threadIdx.x, wid = __builtin_amdgcn_readfirstlane(tid >> 6), lane = tid & 63, r32 = lane & 31, hi = lane >> 5;
    const int sr = tid >> 4, sc = (tid & 15) * 8, kws = KSWZ(sr, sc * 2); char* K_lds = lds + 2 * SHM_V;
    const int kb0 = swa_jlo(cur.P0, cur.W) * KVBLK; const int rs0 = 128 * cur.dil;
    for (int d0 = 0; d0 < 8; ++d0) S.qr[d0] = load8(cur.H + (size_t)(cur.P0 + wid * QBLK + r32) * rs0 + d0 * 16 + hi * 8);
    SLOAD_H(cur.H + KOFF, cur.H + VOFF, rs0, kb0); VMW(); SWRITE_HK(0);
    __syncthreads();
}
__device__ __forceinline__ void swa_block(const BlockRef& cur, const BlockRef& nxt, char* lds, Seam& S) {
    const int tid = threadIdx.x, wid = __builtin_amdgcn_readfirstlane(tid >> 6), lane = tid & 63, r32 = lane & 31, hi = lane >> 5;
    const int W = cur.W; const unsigned par = (W == 256) ? 1u : 0u; const int rs = 128 * cur.dil, ors = 1024 * cur.dil, sst = 8 * cur.dil, skv = SEQ / cur.dil, nrs = 128 * nxt.dil;
    const int j_lo = swa_jlo(cur.P0, W);
    int j_hi = (cur.P0 + QB - 1) / KVBLK + 1; if (j_hi > skv / KVBLK) j_hi = skv / KVBLK;
    const int NT = j_hi - j_lo;
    const int kbn = swa_jlo(nxt.P0, nxt.W) * KVBLK;
    const int qlo = cur.P0 + wid * QBLK, qm = qlo + r32 - 4 * hi;
    char* V_lds = lds; char* K_lds = lds + 2 * SHM_V;
    float* ws = (float*)(lds + 2 * SHM_V + 2 * SHM_K) + wid * 64; float* li_l = ws, * al_l = ws + 32;
    float m_reg = -1e30f, l_reg = 0; f32x16 o[4] = {};
    const int sr = tid >> 4, sc = (tid & 15) * 8, vst0 = v_st(sr, sc), vst1 = v_st(32 + sr, sc), kws = KSWZ(sr, sc * 2);
    const int vb0 = (int)(uintptr_t)V_lds + v_rd_base(lane);
    const bf16_t* Kh = cur.H + KOFF; const bf16_t* Vh = cur.H + VOFF;
#define RESC(a) do { if (__any((a) < 1.f)) { if (hi == 0) al_l[r32] = (a); asm volatile("s_waitcnt lgkmcnt(0)" ::: "memory");              \
                     for (int d_ = 0; d_ < 4; ++d_) for (int r = 0; r < 16; ++r) o[d_][r] *= al_l[crow(r, hi)]; } } while (0)
#define KBASE(t) ((j_lo + (t)) * KVBLK)
#define ACT(t) (KBASE(t) <= qlo + QBLK - 1 && KBASE(t) + KVBLK - 1 >= qlo - W + 1)
#define MASKT(P0_, P1_, t) do { const int kb_ = KBASE(t); if (ACT(t) && (par != 0u || kb_ + KVBLK - 1 > qlo || kb_ <= qlo + QBLK - 1 - W)) mask_tile(P0_, P1_, qm - kb_, (unsigned)W, par); } while (0)
    constexpr int NQL = 8;
#define SEAM_K0() do { VMWN(NQL); SWRITE_HK(0); SBAR(); } while (0)
    f32x16 pA0, pA1, pB0, pB1; float mnA, mnB, alA, alB; bf16x8 pa0, pa1, pa2, pa3;
    SWRITE_HV(0); SBAR();
    if (NT > 1) { SLOAD_H(Kh, Vh, rs, KBASE(1)); }
    SBAR(); qkt<0>(pA0, pA1, K_lds, r32, hi, S.qr, ACT(0));
    MASKT(pA0, pA1, 0); partialSM(pA0, pA1, m_reg, mnA, alA);
    if (NT > 1) { VMW(); SWRITE_H(1); }
    __syncthreads();
#define HALF_STEP(PX0, PX1, mnX, alX, PY0, PY1, alY, t, KB, VB, SB) do {                                                      \
        SBAR(); if ((t) + 1 < NT) { SLOAD_H(Kh, Vh, rs, KBASE((t) + 1)); SBAR(); }     \
        qkt<KB>(PX0, PX1, K_lds, r32, hi, S.qr, ACT(t));                                                                     \
        finishSM(PY0, PY1, alY, l_reg, pa0, pa1, pa2, pa3); SBAR();                                                           \
        pv_tile<VB>(o, vb0, pa0, pa1, pa2, pa3, ACT((t) - 1)); MASKT(PX0, PX1, (t)); partialSM(PX0, PX1, m_reg, mnX, alX);    \
        __syncthreads();                                                                                                      \
        if ((t) + 1 < NT) { VMW(); SWRITE_H(SB); }                                                                            \
        RESC(alX); __syncthreads(); } while (0)
    for (int t = 1; t + 1 < NT; t += 2) {
        HALF_STEP(pB0, pB1, mnB, alB, pA0, pA1, alA, t, 1, 0, 0);
        HALF_STEP(pA0, pA1, mnA, alA, pB0, pB1, alB, t + 1, 0, 1, 1);
    }
    const bool even = (NT & 1) == 0;
    if (even) { SBAR(); qkt<1>(pB0, pB1, K_lds, r32, hi, S.qr, ACT(NT - 1)); SBAR(); }
    SLOAD_H(nxt.H + KOFF, nxt.H + VOFF, nrs, kbn); SBAR();
#pragma unroll
    for (int d0 = 0; d0 < 8; ++d0) S.qr[d0] = load8(nxt.H + (size_t)(nxt.P0 + wid * QBLK + r32) * nrs + d0 * 16 + hi * 8);
    SBAR();
    finishSM(pA0, pA1, alA, l_reg, pa0, pa1, pa2, pa3); SBAR();
    pv_tile<0>(o, vb0, pa0, pa1, pa2, pa3, ACT(even ? NT - 2 : NT - 1));
    if (even) { MASKT(pB0, pB1, NT - 1); partialSM(pB0, pB1, m_reg, mnB, alB); __syncthreads(); RESC(alB);
        finishSM(pB0, pB1, alB, l_reg, pa0, pa1, pa2, pa3); SBAR(); pv_tile<1>(o, vb0, pa0, pa1, pa2, pa3, ACT(NT - 1)); }
    SBAR(); SEAM_K0();
    if (hi == 0) { li_l[r32] = l_reg; cur.ST[(size_t)(wid * QBLK + r32) * sst] = (f32x2){m_reg, l_reg}; }
    asm volatile("s_waitcnt lgkmcnt(0)" ::: "memory");
    float rli[16];
#pragma unroll
    for (int r = 0; r < 16; ++r) rli[r] = __builtin_amdgcn_rcpf(li_l[crow(r, hi)]);
    bf16_t* Ow = cur.O + (size_t)(wid * QBLK) * ors;
#pragma unroll
    for (int r = 0; r < 16; ++r) { const int orow = crow(r, hi);
#pragma unroll
        for (int d0 = 0; d0 < 4; ++d0) { const float v = o[d0][r] * rli[r];
            const float vn = __shfl_xor(v, 1);
            if ((r32 & 1) == 0) *(unsigned*)(Ow + (size_t)orow * ors + d0 * 32 + r32) = cvtpk(v, vn); } }
    __syncthreads();
#undef RESC
#undef KBASE
#undef ACT
#undef MASKT
#undef SEAM_K0
#undef HALF_STEP
}
#undef ROWP
#undef VMW
#undef VMWN
#undef SLOAD_H
#undef SWRITE_HK
#undef SWRITE_HV
#undef SWRITE_H
}


namespace att {
constexpr int RING = 4, R_V = 0, R_K = RING * SHM_V, R_WS = R_K + RING * SHM_K, STREAM_LDS = R_WS + NW * 64 * 4;
struct DmaMap { int krow[2], kcol[2], vrow[2], vcol[2]; };
__device__ __forceinline__ DmaMap dma_map(int wid, int lane) {
    DmaMap m;
#pragma unroll
    for (int j = 0; j < 2; ++j) { const int p = (2 * wid + j) * 64 + lane;
        const int row = p >> 4, cpos = p & 15; m.krow[j] = row; m.kcol[j] = (cpos ^ (row & 7)) * 8;
        const int sub = p >> 5, kk = (sub >> 2) * 8 + ((p & 31) >> 2); m.vrow[j] = (kk & ~0xC) | ((kk & 4) << 1) | ((kk & 8) >> 1); m.vcol[j] = (sub & 3) * 32 + (p & 3) * 8; }
    return m;
}
__device__ __forceinline__ void dma_tile(const bf16_t* H, int rs, int kb0, LAS unsigned char* ldsl, int slot, int wid, const DmaMap& m) {
#pragma unroll
    for (int j = 0; j < 2; ++j) {
        __builtin_amdgcn_global_load_lds((const unsigned*)(H + KOFF + (size_t)(kb0 + m.krow[j]) * rs + m.kcol[j]), (LAS unsigned*)(ldsl + R_K + slot * SHM_K + (2 * wid + j) * 1024), 16, 0, 0);
        __builtin_amdgcn_global_load_lds((const unsigned*)(H + VOFF + (size_t)(kb0 + m.vrow[j]) * rs + m.vcol[j]), (LAS unsigned*)(ldsl + R_V + slot * SHM_V + (2 * wid + j) * 1024), 16, 0, 0); }
}
__device__ __forceinline__ void qkt_s(f32x16& p0, f32x16& p1, const char* Kslot, int r32, int hi, const bf16x8* qr, bool act) {
    if (!act) { const float NEG = -__builtin_inff();
#pragma unroll
        for (int r = 0; r < 16; ++r) { p0[r] = NEG; p1[r] = NEG; } return; }
    p0 = f32x16{}; p1 = f32x16{};
    asm volatile("" : "+v"(r32), "+v"(hi));
    const char* kb[4];
#pragma unroll
    for (int dd = 0; dd < 4; ++dd) kb[dd] = Kslot + KSWZ(r32, (dd * 16 + hi * 8) * 2);
#pragma unroll
    for (int d0 = 0; d0 < 8; ++d0) { const char* a = kb[d0 & 3] + (d0 >> 2) * 128;
        bf16x8 b0 = *reinterpret_cast<const bf16x8*>(a);
        bf16x8 b1 = *reinterpret_cast<const bf16x8*>(a + 32 * 256);
        p0 = __builtin_amdgcn_mfma_f32_32x32x16_bf16(b0, qr[d0], p0, 0, 0, 0);
        p1 = __builtin_amdgcn_mfma_f32_32x32x16_bf16(b1, qr[d0], p1, 0, 0, 0); }
}
__device__ __forceinline__ void pv_s(f32x16* o, int vb, bf16x8 pa0, bf16x8 pa1, bf16x8 pa2, bf16x8 pa3, bool act) {
    if (!act) return;
#define TRRD(dst, off) asm volatile("ds_read_b64_tr_b16 %0, %1 offset:%2" : "=&v"(dst) : "v"(vb), "i"(off) : "memory")
#define PV_D0(d0) do { s16x4 l0, l1, l2, l3, h0, h1, h2, h3; constexpr int b_ = v_rd_off(d0, 0, 0); \
        TRRD(l0, b_); TRRD(h0, b_ + 2048); TRRD(l1, b_ + 4096); TRRD(h1, b_ + 6144); TRRD(l2, b_ + 8192); TRRD(h2, b_ + 10240); TRRD(l3, b_ + 12288); TRRD(h3, b_ + 14336); \
        asm volatile("s_waitcnt lgkmcnt(0)" ::: "memory"); SBAR(); \
        o[d0] = __builtin_amdgcn_mfma_f32_32x32x16_bf16(pa0, (bf16x8){l0[0], l0[1], l0[2], l0[3], h0[0], h0[1], h0[2], h0[3]}, o[d0], 0, 0, 0);   \
        o[d0] = __builtin_amdgcn_mfma_f32_32x32x16_bf16(pa1, (bf16x8){l1[0], l1[1], l1[2], l1[3], h1[0], h1[1], h1[2], h1[3]}, o[d0], 0, 0, 0);   \
        o[d0] = __builtin_amdgcn_mfma_f32_32x32x16_bf16(pa2, (bf16x8){l2[0], l2[1], l2[2], l2[3], h2[0], h2[1], h2[2], h2[3]}, o[d0], 0, 0, 0);   \
        o[d0] = __builtin_amdgcn_mfma_f32_32x32x16_bf16(pa3, (bf16x8){l3[0], l3[1], l3[2], l3[3], h3[0], h3[1], h3[2], h3[3]}, o[d0], 0, 0, 0); } while (0)
    PV_D0(0); PV_D0(1); PV_D0(2); PV_D0(3);
#undef PV_D0
#undef TRRD
}
}

struct Args {
    const float* x; const float* w_in; const float* conv_w; const float* conv_b; const float* w_rg_a; const float* b_rg_a; const float* w_rg_x; const float* b_rg_x;
    const float* lru_lambda; const float* w_out; const float* ln1_g; const float* ln1_b; const float* w_router; const float* router_bias;
    const float* w_gate; const float* w_up; const float* w_down; const float* ws_gate; const float* ws_up; const float* ws_down; const float* ln2_g; const float* ln2_b;
    float* out; unsigned char* ws; int ph_lo, ph_hi, coop, pad;
};

__device__ __forceinline__ unsigned xb_ld(unsigned* p)              { return __hip_atomic_load(p, __ATOMIC_RELAXED, __HIP_MEMORY_SCOPE_AGENT); }
__device__ __forceinline__ unsigned xb_add(unsigned* p, unsigned v) { return __hip_atomic_fetch_add(p, v, __ATOMIC_RELAXED, __HIP_MEMORY_SCOPE_AGENT); }
struct TrItem { const float* src; bf16_t* dst; int ld, ldd, k0, n0, dst_row0; };
__device__ __forceinline__ void tr_load8(const TrItem& it, int lane, f32x4 (&v)[16]) {
    const float* p = it.src + (size_t)(it.k0 + 4 * (lane >> 3)) * it.ld + it.n0 + (lane & 7) * 4;
#pragma unroll
    for (int t = 0; t < 4; ++t)
#pragma unroll
        for (int j = 0; j < 4; ++j) v[4 * t + j] = __builtin_nontemporal_load((const f32x4*)(p + (size_t)(32 * t + j) * it.ld));
}
__device__ __forceinline__ void tr_store8(const TrItem& it, int lane, const f32x4 (&v)[16], LAS float* scr) {
    LAS unsigned char* T = (LAS unsigned char*)scr;
    const int kg = lane >> 3, n4 = (lane & 7) * 4;
#pragma unroll
    for (int t = 0; t < 4; ++t)
#pragma unroll
        for (int nn = 0; nn < 4; ++nn) {
            int w = __builtin_amdgcn_cvt_pk_fp8_f32(v[4 * t + 0][nn] * W8_SCALE, v[4 * t + 1][nn] * W8_SCALE, 0, false);
            w = __builtin_amdgcn_cvt_pk_fp8_f32(v[4 * t + 2][nn] * W8_SCALE, v[4 * t + 3][nn] * W8_SCALE, w, true);
            *(LAS int*)(T + (n4 + nn) * 136 + 32 * t + 4 * kg) = w; }
    LDS_WAIT(); asm volatile("" ::: "memory");
    const int kc = lane & 7;
#pragma unroll
    for (int p = 0; p < 4; ++p) {
        const int n = (lane >> 3) + 8 * p;
        const u32x2 lo = *(const LAS u32x2*)(T + n * 136 + 16 * kc), hi = *(const LAS u32x2*)(T + n * 136 + 16 * kc + 8);
        __builtin_nontemporal_store((u32x4){lo.x, lo.y, hi.x, hi.y}, (u32x4*)((unsigned char*)it.dst + (size_t)(it.dst_row0 + n) * it.ldd + it.k0 + 16 * kc));
    }
    LDS_WAIT(); asm volatile("" ::: "memory");
}
__device__ __forceinline__ void tr_load(const TrItem& it, int lane, f32x4 (&v)[16]) {
    const float* p = it.src + (size_t)(it.k0 + (lane >> 4)) * it.ld + it.n0 + (lane & 15) * 4;
#pragma unroll
    for (int i = 0; i < 16; ++i) v[i] = __builtin_nontemporal_load((const f32x4*)(p + (size_t)(4 * i) * it.ld));
}
__device__ __forceinline__ void tr_store(const TrItem& it, int lane, const f32x4 (&v)[16], LAS float* scr, int mode, size_t lo_off) {
    const int r = lane >> 4, c4 = (lane & 15) * 4;
#pragma unroll
    for (int i = 0; i < 16; ++i)
#pragma unroll
        for (int j = 0; j < 4; ++j) scr[(c4 + j) * 65 + 4 * i + r] = v[i][j];
    LDS_WAIT(); asm volatile("" ::: "memory");
    const int kc = lane & 7;
#pragma unroll
    for (int p = 0; p < 8; ++p) {
        const int n = (lane >> 3) + 8 * p; const LAS float* s = scr + n * 65 + 8 * kc;
        float f[8];
#pragma unroll
        for (int j = 0; j < 8; ++j) f[j] = s[j];
        u32x4 o; o.x = cvt_pk_bf16(f[0], f[1]); o.y = cvt_pk_bf16(f[2], f[3]); o.z = cvt_pk_bf16(f[4], f[5]); o.w = cvt_pk_bf16(f[6], f[7]);
        bf16_t* d = it.dst + (size_t)(it.dst_row0 + n) * it.ldd + it.k0 + 8 * kc;
        *(u32x4*)d = o;
        if (mode == 1) {
            u32x4 l; l.x = cvt_pk_bf16(f[0] - bflo(o.x), f[1] - bfhi(o.x)); l.y = cvt_pk_bf16(f[2] - bflo(o.y), f[3] - bfhi(o.y));
            l.z = cvt_pk_bf16(f[4] - bflo(o.z), f[5] - bfhi(o.z)); l.w = cvt_pk_bf16(f[6] - bflo(o.w), f[7] - bfhi(o.w));
            *(u32x4*)(d + lo_off) = l;
        }
    }
    LDS_WAIT(); asm volatile("" ::: "memory");
}
constexpr int IT_WIN = 32 * 80, IT_WOUT = 32 * 32, IT_GU1 = 32 * 8, IT_GU = NE1 * 2 * IT_GU1, IT_D1 = 8 * 32, IT_D = NE1 * IT_D1, IT_RG = 8 * 2 * 4, IT_RT = 32;
constexpr int IT_TOTAL = IT_WIN + IT_WOUT + IT_GU + IT_D + IT_RG + IT_RT;
__device__ __forceinline__ int tr_decode(const Args& a, int it, TrItem& t) {
    unsigned char* ws = a.ws;
    if (it < IT_WIN) { t.src = a.w_in; t.ld = NPROJ;
        if (it < 1024) { t.k0 = (it / 32) * 64; t.n0 = (it % 32) * 64; t.dst = (bf16_t*)(ws + WS_WIN); t.ldd = DM; t.dst_row0 = t.n0; return 0; }
        const int i2 = it - 1024; t.k0 = (i2 / 96) * 128; t.n0 = 2048 + (i2 % 96) * 32; t.dst = (bf16_t*)(ws + WS_WIN8); t.ldd = DM; t.dst_row0 = t.n0 - 2048; return 2; }
    it -= IT_WIN;
    if (it < IT_WOUT) { t.src = a.w_out; t.ld = DM;
        if (it < 512) { t.k0 = (it / 32) * 64; t.n0 = (it % 32) * 64; t.dst = (bf16_t*)(ws + WS_WOUT); t.ldd = 1024; t.dst_row0 = t.n0; return 0; }
        const int i2 = it - 512; t.k0 = 1024 + (i2 / 64) * 128; t.n0 = (i2 % 64) * 32; t.dst = (bf16_t*)(ws + WS_WOUT + 4 * MiB - 1024); t.ldd = DM; t.dst_row0 = t.n0; return 2; }
    it -= IT_WOUT;
    if (it < IT_GU) { const int e = it / (2 * IT_GU1), r = it % (2 * IT_GU1), up = r / IT_GU1, q = r % IT_GU1;
        const float* src = e < NEXP ? (up ? a.w_up : a.w_gate) + (size_t)e * DM * DEXP : (up ? a.ws_up : a.ws_gate);
        t.src = src; t.ld = DEXP; t.k0 = (q / 16) * 128; t.n0 = (q % 16) * 32; t.dst = (bf16_t*)(ws + WS_WGU + (size_t)e * 1024 * DM); t.ldd = DM;
        t.dst_row0 = (t.n0 >> 7) * 256 + up * 128 + (t.n0 & 127); return 2; }
    it -= IT_GU;
    if (it < IT_D) { const int e = it / IT_D1, q = it % IT_D1;
        t.src = e < NEXP ? a.w_down + (size_t)e * DEXP * DM : a.ws_down; t.ld = DM; t.k0 = (q / 64) * 128; t.n0 = (q % 64) * 32;
        t.dst = (bf16_t*)(ws + WS_WD + (size_t)e * DM * DEXP); t.ldd = DEXP; t.dst_row0 = t.n0; return 2; }
    it -= IT_D;
    if (it < IT_RG) { const int n = it / 8, r = it % 8, mat = r / 4, q = r % 4;
        t.src = (mat ? a.w_rg_x : a.w_rg_a) + (size_t)n * 128 * 128; t.ld = 128; t.k0 = (q / 2) * 64; t.n0 = (q % 2) * 64;
        t.dst = (bf16_t*)(ws + WS_WRG) + (size_t)n * 256 * 128; t.ldd = 128; t.dst_row0 = mat * 128 + t.n0; return 0; }
    it -= IT_RG;
    t.src = a.w_router; t.ld = NEXP; t.k0 = it * 64; t.n0 = 0; t.dst = (bf16_t*)(ws + WS_WR); t.ldd = DM; t.dst_row0 = 0; return 1;
}
#ifndef BG_NC
#define BG_NC 76
#endif
constexpr int CW_DONE = 2304, CW_PROG = 2560, BG_GC = 256 - BG_NC, BG_NS = BG_NC * NWAVES;
constexpr int BG_Q = (1792 + BG_GC - 1) / BG_GC, BG_X = 512 - 2 * BG_GC, BG_F3 = BG_Q - 6;
static_assert(BG_NC % 4 == 0 && CW_PROG + BG_NS <= CW_BAR && BG_X >= 0 && BG_X <= BG_GC && BG_X % 8 == 0 && BG_F3 >= 0 && BG_X * BG_F3 <= 768 && BG_X * BG_F3 + (BG_GC - BG_X) * (BG_Q - 4) >= 768, "background streams / projection split");
template <int MAP, bool STOP> __device__ __forceinline__ int p0_items(const Args& a, LAS unsigned char* lds, int first, int stride, unsigned* done = nullptr) {
    constexpr int COUNT = MAP == 0 ? IT_WIN + IT_WOUT + IT_RG + IT_RT : IT_GU + IT_D;
    const int lane = threadIdx.x & 63, wave = __builtin_amdgcn_readfirstlane(threadIdx.x >> 6);
    LAS float* scr = (LAS float*)(lds + wave * 16640);
#define P0_MAP(i) (MAP == 0 ? ((i) < IT_WIN + IT_WOUT ? (i) : (i) + IT_GU + IT_D) : (i) + IT_WIN + IT_WOUT)
    int it = first, n = 0; if (it >= COUNT) return 0;
    TrItem cur; int mode = tr_decode(a, P0_MAP(it), cur); f32x4 v[16]; if (MAP == 1 || mode == 2) tr_load8(cur, lane, v); else tr_load(cur, lane, v);
    for (;;) {
        unsigned d = 0u; if (STOP) d = xb_ld(done);
        const int itn = it + stride; const bool more = itn < COUNT;
        TrItem nxt = cur; int moden = mode; f32x4 vn[16];
        if (more) { moden = tr_decode(a, P0_MAP(itn), nxt); if (MAP == 1 || moden == 2) tr_load8(nxt, lane, vn); else tr_load(nxt, lane, vn); }
        if (MAP == 1 || mode == 2) tr_store8(cur, lane, v, scr); else tr_store(cur, lane, v, scr, mode, (size_t)NEXP * DM);
        ++n;
        if (!more) break;
        cur = nxt; mode = moden; it = itn;
#pragma unroll
        for (int i = 0; i < 16; ++i) v[i] = vn[i];
        if (STOP && __builtin_amdgcn_readfirstlane((int)d) != 0) { tr_store8(cur, lane, v, scr); ++n; break; }
    }
#undef P0_MAP
    return n;
}
__device__ __forceinline__ void p0_phase(const Args& a, LAS unsigned char* lds, int vcu, int G, int parts = 7) {
    const int tid = threadIdx.x, lane = tid & 63, wave = __builtin_amdgcn_readfirstlane(tid >> 6);
    unsigned char* ws = a.ws;
    const int gt = vcu * NTHR + tid, NGT = G * NTHR;
    if (parts & 1) { unsigned* ctl = (unsigned*)(ws + WS_CTL);
      for (int i = gt; i < CW_BAR; i += NGT) ctl[i] = (i == CW_CNT + NEXP * CNT_STRIDE) ? (unsigned)NTOK : 0u;
      int* st = (int*)(ws + WS_SLOT) + (size_t)NEXP * CAP;
      for (int i = gt; i < NTOK; i += NGT) { st[i] = i; }
      float* tab = (float*)(ws + WS_TAB);
      for (int i = gt; i < 2048 * 16; i += NGT) { const int pos = i >> 4, j = i & 15;
          const double inv = pow(500000.0, -(double)j / 16.0), ang = (double)pos * inv; tab[i] = (float)cos(ang); tab[32768 + i] = (float)sin(ang); }
      for (int i = gt; i < 1024; i += NGT) { const float lam = a.lru_lambda[i]; tab[65536 + i] = 8.0f * log1pf(expf(-lam)); }
    }
    if (parts & 2) { const f32x4* xs = (const f32x4*)a.x; u32x4* xd = (u32x4*)(ws + WS_XB); u32x2* x8d = (u32x2*)(ws + WS_XIN8);
      constexpr int NCH = NTOK * DM / 8;
      for (int i = gt; i < NCH; i += NGT) { const f32x4 v0 = __builtin_nontemporal_load(xs + 2 * i), v1 = __builtin_nontemporal_load(xs + 2 * i + 1);
          u32x4 o; o.x = cvt_pk_bf16(v0[0], v0[1]); o.y = cvt_pk_bf16(v0[2], v0[3]); o.z = cvt_pk_bf16(v1[0], v1[1]); o.w = cvt_pk_bf16(v1[2], v1[3]); xd[i] = o;
          u32x2 o8; int t8 = __builtin_amdgcn_cvt_pk_fp8_f32(v0[0], v0[1], 0, false); t8 = __builtin_amdgcn_cvt_pk_fp8_f32(v0[2], v0[3], t8, true); o8.x = (unsigned)t8;
          t8 = __builtin_amdgcn_cvt_pk_fp8_f32(v1[0], v1[1], 0, false); t8 = __builtin_amdgcn_cvt_pk_fp8_f32(v1[2], v1[3], t8, true); o8.y = (unsigned)t8; x8d[i] = o8; }
    }
    const int gw = vcu * NWAVES + wave, NGW = G * NWAVES;
    if (parts & 4) {
        p0_items<0, false>(a, lds, gw, NGW);
        if (!(parts & 8)) p0_items<1, false>(a, lds, gw, NGW);
    }
}

constexpr int LRU_XC = 0, LRU_XCP = 272, LRU_AA = 69632, LRU_UU = LRU_AA + 32768, LRU_SA = LRU_UU + 32768, LRU_SH = LRU_SA + 2048, LRU_CARRY = LRU_SH + 2048, LRU_WB = LRU_CARRY + 256;
static_assert(LRU_WB + 64 * LRU_XCP <= LDS_BYTES - 256, "LRU LDS map");
__device__ __forceinline__ void lru_item(const Args& a, char* lds, int item) {
    const int tid = threadIdx.x, lane = tid & 63, wave = __builtin_amdgcn_readfirstlane(tid >> 6), r32 = lane & 31, hi = lane >> 5;
    const int b = item >> 5, n = (item >> 2) & 7, cq = item & 3;
    unsigned char* ws = a.ws;
    const bf16_t* proj = (const bf16_t*)(ws + WS_PROJ);
    const bf16_t* xl = proj + (size_t)(b * NGRP + n) * SEQ * 128;
    const bf16_t* gl = proj + (size_t)(b * NGRP + 8 + n) * SEQ * 128;
    bf16_t* mix = (bf16_t*)(ws + WS_MIX) + (size_t)b * SEQ * 1024 + n * 128 + cq * 32;
    const float* tab = (const float*)(ws + WS_TAB);
    char* XC = lds + LRU_XC; float* AA = (float*)(lds + LRU_AA); float* UU = (float*)(lds + LRU_UU); float* SA = (float*)(lds + LRU_SA); float* SH = (float*)(lds + LRU_SH); float* CARRY = (float*)(lds + LRU_CARRY);
    char* WB = lds + LRU_WB;
    { const bf16_t* wt = (const bf16_t*)(ws + WS_WRG) + (size_t)n * 256 * 128;
#pragma unroll
      for (int i = 0; i < 2; ++i) { const int q = tid + 512 * i, row = q >> 4, c16 = q & 15; const int srow = (row < 32 ? cq * 32 + row : 128 + cq * 32 + (row - 32));
          *(u32x4*)(WB + row * LRU_XCP + c16 * 16) = *(const u32x4*)(wt + (size_t)srow * 128 + c16 * 8); } }
    const int chd = n * 128 + cq * 32 + r32;
    const float ba = a.b_rg_a[chd], bx = a.b_rg_x[chd], sp8 = tab[65536 + chd];
    const int cg8 = tid & 15, tg = tid >> 4;
    float cw[4][8], cb[8];
#pragma unroll
    for (int j = 0; j < 4; ++j)
#pragma unroll
        for (int c = 0; c < 8; ++c) cw[j][c] = a.conv_w[j * 1024 + n * 128 + cg8 * 8 + c];
#pragma unroll
    for (int c = 0; c < 8; ++c) cb[c] = a.conv_b[n * 128 + cg8 * 8 + c];
    if (tid < 32) CARRY[tid] = 0.f;
    const int sd = tid & 31, seg = tid >> 5;
    u32x4 xr[11];
#define LRU_XLOAD(s0_) do { const bf16_t* pb_ = xl + ((s0_) + tg * 8 - 3) * 128 + cg8 * 8; const int sneg_ = 3 - ((s0_) + tg * 8); \
        _Pragma("unroll") for (int i = 0; i < 11; ++i) { xr[i] = *(const u32x4*)(pb_ + i * 128); if (i < 3 && i < sneg_) xr[i] = (u32x4){0u, 0u, 0u, 0u}; } } while (0)
    LRU_XLOAD(0);
    for (int ch = 0; ch < 8; ++ch) {
        const int s0 = ch * 256;
#pragma unroll
        for (int i = 0; i < 8; ++i) { float o[8];
#pragma unroll
            for (int c = 0; c < 8; ++c) o[c] = cb[c];
#pragma unroll
            for (int j = 0; j < 4; ++j) { const u32x4 w = xr[i + j];
                o[0] += cw[j][0] * bflo(w.x); o[1] += cw[j][1] * bfhi(w.x); o[2] += cw[j][2] * bflo(w.y); o[3] += cw[j][3] * bfhi(w.y);
                o[4] += cw[j][4] * bflo(w.z); o[5] += cw[j][5] * bfhi(w.z); o[6] += cw[j][6] * bflo(w.w); o[7] += cw[j][7] * bfhi(w.w); }
            u32x4 w; w.x = cvt_pk_bf16(o[0], o[1]); w.y = cvt_pk_bf16(o[2], o[3]); w.z = cvt_pk_bf16(o[4], o[5]); w.w = cvt_pk_bf16(o[6], o[7]);
            *(u32x4*)(XC + (tg * 8 + i) * LRU_XCP + cg8 * 16) = w; }
        if (ch + 1 < 8) LRU_XLOAD(s0 + 256);
        __syncthreads();
        { f32x16 ga = {}, gx = {};
#pragma unroll
          for (int ks = 0; ks < 8; ++ks) { const bf16x8 af = *(const bf16x8*)(XC + (wave * 32 + r32) * LRU_XCP + (ks * 16 + hi * 8) * 2);
              const bf16x8 Bak = *(const bf16x8*)(WB + r32 * LRU_XCP + (ks * 16 + hi * 8) * 2), Bxk = *(const bf16x8*)(WB + (32 + r32) * LRU_XCP + (ks * 16 + hi * 8) * 2);
              ga = __builtin_amdgcn_mfma_f32_32x32x16_bf16(af, Bak, ga, 0, 0, 0); gx = __builtin_amdgcn_mfma_f32_32x32x16_bf16(af, Bxk, gx, 0, 0, 0); }
#pragma unroll
          for (int r = 0; r < 16; ++r) { const int tok = wave * 32 + att::crow(r, hi);
              const float ra = __builtin_amdgcn_rcpf(1.f + __expf(-(ga[r] + ba))), ix = __builtin_amdgcn_rcpf(1.f + __expf(-(gx[r] + bx)));
              const float la = -ra * sp8, av = __expf(la), x2 = 2.f * la;
              float pz = fmaf(x2, 1.f / 7.f, 1.f); pz = fmaf(x2 * (1.f / 6.f), pz, 1.f); pz = fmaf(x2 * (1.f / 5.f), pz, 1.f); pz = fmaf(x2 * 0.25f, pz, 1.f); pz = fmaf(x2 * (1.f / 3.f), pz, 1.f); pz = fmaf(x2 * 0.5f, pz, 1.f);
              const float mult = sqrtf(-x2 * pz);
              const float xcv = bf2f(*(const unsigned short*)(XC + tok * LRU_XCP + (cq * 32 + r32) * 2));
              AA[tok * 32 + r32] = av; UU[tok * 32 + r32] = mult * ix * xcv; } }
        __syncthreads();
        { float av[16], uv[16]; float Ap = 1.f, Hp = 0.f;
          unsigned short glv[16];
#pragma unroll
          for (int i = 0; i < 16; ++i) glv[i] = gl[(size_t)(s0 + seg * 16 + i) * 128 + cq * 32 + sd];
#pragma unroll
          for (int i = 0; i < 16; ++i) { av[i] = AA[(seg * 16 + i) * 32 + sd]; uv[i] = UU[(seg * 16 + i) * 32 + sd]; Hp = av[i] * Hp + uv[i]; Ap *= av[i]; }
          SA[seg * 32 + sd] = Ap; SH[seg * 32 + sd] = Hp;
          __syncthreads();
          float carry = CARRY[(ch & 1) * 32 + sd];
          for (int s2 = 0; s2 < seg; ++s2) carry = SA[s2 * 32 + sd] * carry + SH[s2 * 32 + sd];
#pragma unroll
          for (int i = 0; i < 16; ++i) { carry = av[i] * carry + uv[i];
              mix[(size_t)(s0 + seg * 16 + i) * 1024 + sd] = (bf16_t)(cvt_pk_bf16(carry * bf2f(glv[i]), 0.f) & 0xffffu); }
          if (seg == 15) CARRY[((ch + 1) & 1) * 32 + sd] = carry; }
    }
    __syncthreads();
}

__device__ __forceinline__ att::BlockRef att_ref(const Args& a, int L) {
    unsigned char* ws = a.ws;
    const int p = L >> 9, q = L & 511, bh = q >> 3, sub = q & 7, b = bh >> 3, h = bh & 7;
    int dil, cls, qb;
    if (p == 0) { dil = 1; cls = 0; qb = sub; } else if (p == 1) { dil = 4; cls = sub >> 1; qb = sub & 1; } else { dil = 8; cls = sub; qb = 0; }
    const bf16_t* proj = (const bf16_t*)(ws + WS_PROJ);
    att::BlockRef r;
    r.H = proj + (size_t)(b * NGRP + 16 + h) * SEQ * 128 + cls * 128;
    r.dil = dil; r.W = (p == 2) ? 256 : 129; r.P0 = qb * 256;
    const size_t tok0 = (size_t)b * SEQ + cls + (size_t)qb * 256 * dil;
    r.O = (bf16_t*)((unsigned char*)a.out + (size_t)p * NTOK * 1024 + tok0 * 1024 + h * 128);
    r.ST = (f32x2*)(ws + WS_ASTAT) + (size_t)p * NTOK * 8 + tok0 * 8 + h;
    return r;
}
__device__ __forceinline__ void att_phase_v1(const Args& a, char* lds, int c, int G) {
    constexpr int TOTAL = 3 * 512;
    int L = c; if (L >= TOTAL) return;
    att::BlockRef cur = att_ref(a, L);
    att::Seam S;
    att::swa_prime(cur, lds, S);
    for (;;) {
        const bool more = L + G < TOTAL;
        const att::BlockRef nxt = more ? att_ref(a, L + G) : cur;
        att::swa_block(cur, nxt, lds, S);
        if (!more) break;
        cur = nxt; L += G;
    }
}
__device__ __forceinline__ void att_phase(const Args& a, char* lds, LAS unsigned char* ldsl, int c, int G) {
    using namespace att;
    constexpr int TOTAL = 3 * 512;
    int L = c; if (L >= TOTAL) return;
    const int tid = threadIdx.x, wid = __builtin_amdgcn_readfirstlane(tid >> 6), lane = tid & 63, r32 = lane & 31, hi = lane >> 5;
    char* V_lds = lds + R_V; char* K_lds = lds + R_K;
    float* wsf = (float*)(lds + R_WS) + wid * 64; float* li_l = wsf, * al_l = wsf + 32;
    const int vb0 = (int)(uintptr_t)V_lds + v_rd_base(lane);
    bf16x8 qr[8];
#define QLOAD(ref) do { _Pragma("unroll") for (int d0 = 0; d0 < 8; ++d0) qr[d0] = load8((ref).H + (size_t)((ref).P0 + wid * QBLK + r32) * (128 * (ref).dil) + d0 * 16 + hi * 8); } while (0)
    const bf16_t* iH; int irs, ikb, irem, iss_L = L, pos_iss = 0; bool iss_ok = true;
#define ISS_SET(ref) do { const int jl_ = swa_jlo((ref).P0, (ref).W); int jh_ = ((ref).P0 + QB - 1) / KVBLK + 1; const int skv_ = SEQ / (ref).dil; if (jh_ > skv_ / KVBLK) jh_ = skv_ / KVBLK; \
        iH = (ref).H; irs = 128 * (ref).dil; ikb = jl_ * KVBLK; irem = jh_ - jl_; } while (0)
#define ISSUE_NEXT() do { if (iss_ok) { { int lo_ = lane; asm volatile("" : "+v"(lo_)); dma_tile(iH, irs, ikb, ldsl, pos_iss & 3, wid, dma_map(wid, lo_)); } ++pos_iss;     ikb += KVBLK; \
        if (--irem == 0) { iss_L += G; if (iss_L < TOTAL) { const BlockRef nr_ = att_ref(a, iss_L); ISS_SET(nr_); } else iss_ok = false; } } } while (0)
    { const BlockRef c0 = att_ref(a, L); ISS_SET(c0); QLOAD(c0); }
    ISSUE_NEXT(); ISSUE_NEXT();
    asm volatile("s_waitcnt vmcnt(4)" ::: "memory");
    __syncthreads();
    int pos = 0;
    for (;;) {
        int W, NT, j_lo, P0c;
        { const BlockRef cr = att_ref(a, L); W = cr.W; P0c = cr.P0; const int skv = SEQ / cr.dil; j_lo = swa_jlo(cr.P0, W);
          int j_hi = (cr.P0 + QB - 1) / KVBLK + 1; if (j_hi > skv / KVBLK) j_hi = skv / KVBLK; NT = j_hi - j_lo; }
        const unsigned par = (W == 256) ? 1u : 0u;
        const int qlo = P0c + wid * QBLK, qm = qlo + r32 - 4 * hi;
        const bool more = L + G < TOTAL;
        float m_reg = -1e30f, l_reg = 0; f32x16 o[4] = {};
        f32x16 pA0, pA1, pB0, pB1; float mnA, mnB, alA, alB; bf16x8 pa0, pa1, pa2, pa3;
#define RESC(a_) do { if (__any((a_) < 1.f)) { if (hi == 0) al_l[r32] = (a_); asm volatile("s_waitcnt lgkmcnt(0)" ::: "memory");              \
                     for (int d_ = 0; d_ < 4; ++d_) for (int r = 0; r < 16; ++r) o[d_][r] *= al_l[crow(r, hi)]; } } while (0)
#define KBASE(t) ((j_lo + (t)) * KVBLK)
#define ACT(t) (KBASE(t) <= qlo + QBLK - 1 && KBASE(t) + KVBLK - 1 >= qlo - W + 1)
#define MASKT(P0_, P1_, t) do { const int kb_ = KBASE(t); if (ACT(t) && (par != 0u || kb_ + KVBLK - 1 > qlo || kb_ <= qlo + QBLK - 1 - W)) mask_tile(P0_, P1_, qm - kb_, (unsigned)W, par); } while (0)
#define STEP(PX0, PX1, mnX, alX, PY0, PY1, alY, t, HAVEPREV, LASTQ) do {                                                                 \
            const bool issued_ = iss_ok; ISSUE_NEXT(); SBAR();                                                                              \
            qkt_s(PX0, PX1, K_lds + (pos & 3) * SHM_K, r32, hi, qr, ACT(t)); SBAR();                                                       \
            const bool qn_ = (LASTQ) && more; if (qn_) { const BlockRef nq_ = att_ref(a, L + G); QLOAD(nq_); SBAR(); }        \
            if (HAVEPREV) { finishSM(PY0, PY1, alY, l_reg, pa0, pa1, pa2, pa3); SBAR();                                                    \
                            pv_s(o, vb0 + ((pos - 1) & 3) * SHM_V, pa0, pa1, pa2, pa3, ACT((t) - 1)); }                                    \
            MASKT(PX0, PX1, (t)); partialSM(PX0, PX1, m_reg, mnX, alX);                                                                    \
            if (issued_) { if (qn_) asm volatile("s_waitcnt vmcnt(12)" ::: "memory"); else asm volatile("s_waitcnt vmcnt(4)" ::: "memory"); } \
            else { if (qn_) asm volatile("s_waitcnt vmcnt(8)" ::: "memory"); else asm volatile("s_waitcnt vmcnt(0)" ::: "memory"); }        \
            __syncthreads();                                                                                                                \
            RESC(alX); ++pos; } while (0)
        for (int t = 0; t < NT; t += 2) {
            STEP(pA0, pA1, mnA, alA, pB0, pB1, alB, t, (t > 0), false);
            STEP(pB0, pB1, mnB, alB, pA0, pA1, alA, t + 1, true, (t + 2 >= NT));
        }
        finishSM(pB0, pB1, alB, l_reg, pa0, pa1, pa2, pa3); SBAR();
        pv_s(o, vb0 + ((pos - 1) & 3) * SHM_V, pa0, pa1, pa2, pa3, ACT(NT - 1));
        int Le = L; asm volatile("" : "+s"(Le));
        const BlockRef ce = att_ref(a, Le); const int ors = 1024 * ce.dil, sst = 8 * ce.dil;
        if (hi == 0) { li_l[r32] = l_reg; ce.ST[(size_t)(wid * QBLK + r32) * sst] = (f32x2){m_reg, l_reg}; }
        asm volatile("s_waitcnt lgkmcnt(0)" ::: "memory");
        float rli[16];
#pragma unroll
        for (int r = 0; r < 16; ++r) rli[r] = __builtin_amdgcn_rcpf(li_l[crow(r, hi)]);
        unsigned char* Ow = (unsigned char*)ce.O + (size_t)(wid * QBLK) * ors;
        char* osc = lds + STREAM_LDS + wid * 1536;
#pragma unroll
        for (int d0 = 0; d0 < 4; ++d0) {
#pragma unroll
            for (int r = 0; r < 16; ++r) *(unsigned char*)(osc + crow(r, hi) * 48 + r32) = (unsigned char)__builtin_amdgcn_cvt_pk_fp8_f32(o[d0][r] * (rli[r] * A8_SCALE), 0.f, 0, false);
            asm volatile("s_waitcnt lgkmcnt(0)" ::: "memory");
            const u32x4 tv = *(const u32x4*)(osc + (lane >> 1) * 48 + (lane & 1) * 16);
            *(u32x4*)(Ow + (size_t)(lane >> 1) * ors + d0 * 32 + (lane & 1) * 16) = tv;
        }
#undef STEP
#undef MASKT
#undef ACT
#undef KBASE
#undef RESC
        if (!more) break;
        L += G;
    }
#undef QLOAD
#undef ISS_SET
#undef ISSUE_NEXT
    asm volatile("s_waitcnt vmcnt(0)" ::: "memory");
    __syncthreads();
}
__device__ __forceinline__ void merge_phase(const Args& a, int vcu, int G) {
    unsigned char* ws = a.ws;
    const int gt = vcu * NTHR + threadIdx.x, NGT = G * NTHR;
    const f32x2* st = (const f32x2*)(ws + WS_ASTAT); const unsigned char* op8 = (const unsigned char*)a.out; unsigned char* att8 = ws + WS_MIX + 32 * MiB;
    constexpr float C2 = 1.4426950408889634f * att::SCALE;
    for (int i = gt; i < NTOK * 8 * 16; i += NGT) {
        const int c = i & 15, th = i >> 4, t = th >> 3, h = th & 7;
        const f32x2 s0 = st[th], s1 = st[(size_t)NTOK * 8 + th], s2 = st[(size_t)2 * NTOK * 8 + th];
        const float mx = fmaxf(s0.x, fmaxf(s1.x, s2.x));
        const float w0 = s0.y * __builtin_amdgcn_exp2f((s0.x - mx) * C2), w1 = s1.y * __builtin_amdgcn_exp2f((s1.x - mx) * C2), w2 = s2.y * __builtin_amdgcn_exp2f((s2.x - mx) * C2);
        const float inv = 1.f / (w0 + w1 + w2);
        const size_t off = (size_t)t * 1024 + h * 128 + c * 8;
        const u32x2 a0 = *(const u32x2*)(op8 + off), a1 = *(const u32x2*)(op8 + (size_t)NTOK * 1024 + off), a2 = *(const u32x2*)(op8 + (size_t)2 * NTOK * 1024 + off);
        u32x2 o;
#define MRG2(f, sel) ({ const f32x2 q0 = __builtin_amdgcn_cvt_pk_f32_fp8((int)a0.f, sel), q1 = __builtin_amdgcn_cvt_pk_f32_fp8((int)a1.f, sel), q2 = __builtin_amdgcn_cvt_pk_f32_fp8((int)a2.f, sel); (f32x2){(w0 * q0.x + w1 * q1.x + w2 * q2.x) * inv, (w0 * q0.y + w1 * q1.y + w2 * q2.y) * inv}; })
        { const f32x2 lo = MRG2(x, false), hi2 = MRG2(x, true); int t0 = __builtin_amdgcn_cvt_pk_fp8_f32(lo.x, lo.y, 0, false); t0 = __builtin_amdgcn_cvt_pk_fp8_f32(hi2.x, hi2.y, t0, true); o.x = (unsigned)t0; }
        { const f32x2 lo = MRG2(y, false), hi2 = MRG2(y, true); int t1 = __builtin_amdgcn_cvt_pk_fp8_f32(lo.x, lo.y, 0, false); t1 = __builtin_amdgcn_cvt_pk_fp8_f32(hi2.x, hi2.y, t1, true); o.y = (unsigned)t1; }
#undef MRG2
        *(u32x2*)(att8 + (size_t)t * DM + h * 128 + c * 8) = o;
    }
}

constexpr int P4_ROWB = 272, P4_AH = 0, P4_AL = 64 * P4_ROWB, P4_WH = 2 * 64 * P4_ROWB, P4_WL = 3 * 64 * P4_ROWB, P4_RED = 4 * 64 * P4_ROWB, P4_STAT = P4_RED + 2 * 64 * 65 * 4, P4_LCNT = P4_STAT + 512, P4_BASE = P4_LCNT + 256, P4_REC = P4_BASE + 256;
__device__ __forceinline__ float grp8_max(float v) { v = fmaxf(v, __shfl_xor(v, 1)); v = fmaxf(v, __shfl_xor(v, 2)); v = fmaxf(v, __shfl_xor(v, 4)); return v; }
__device__ __forceinline__ float wave_max(float v) {
#pragma unroll
    for (int o = 1; o < 64; o <<= 1) v = fmaxf(v, __shfl_xor(v, o));
    return v;
}
__device__ __forceinline__ void p4_phase(const Args& a, char* lds, int vcu, int G) {
    const int tid = threadIdx.x, lane = tid & 63, wave = __builtin_amdgcn_readfirstlane(tid >> 6), r32 = lane & 31, hi = lane >> 5;
    unsigned char* ws = a.ws;
    const float* Y = a.out; bf16_t* X1 = (bf16_t*)(ws + WS_X1); unsigned char* X8 = ws + WS_X8; const float* rpart = (const float*)(ws + WS_RPART);
    const bf16_t* WRh = (const bf16_t*)(ws + WS_WR); const bf16_t* WRl = WRh + (size_t)NEXP * DM;
    float* RED = (float*)(lds + P4_RED); f32x2* STAT = (f32x2*)(lds + P4_STAT);
    unsigned* cnt = (unsigned*)(ws + WS_CTL) + CW_CNT;
    int* slot_tok = (int*)(ws + WS_SLOT); float* slot_gate = (float*)(ws + WS_SLOT + SLOT_ARR); int* TS = (int*)(ws + WS_SLOT + 2 * SLOT_ARR);
    const int mt = wave & 1, nt = (wave >> 1) & 1, kh = wave >> 2;
    const int yc = 4 * (lane & 31), yr0 = 2 * wave + (lane >> 5);
    const int we = tid >> 4, wk8 = (tid & 15) * 8;
    const float bias = a.router_bias[lane];
    for (int tile = vcu; tile < NTOK / 64; tile += G) {
        const int t0 = tile * 64;
        __syncthreads();
        unsigned* LCNT = (unsigned*)(lds + P4_LCNT); unsigned* BASE = (unsigned*)(lds + P4_BASE); u32x4* REC = (u32x4*)(lds + P4_REC);
        if (tid < 64) { LCNT[tid] = 0u; const f32x4* rp = (const f32x4*)(rpart + (size_t)(t0 + tid) * 64); float s1 = 0.f, s2 = 0.f;
#pragma unroll
            for (int i = 0; i < 16; ++i) { const f32x4 v = rp[i]; s1 += v[0] + v[2]; s2 += v[1] + v[3]; }
            const float mean = s1 * (1.f / DM), var = s2 * (1.f / DM) - mean * mean; STAT[tid] = (f32x2){mean, 1.f / sqrtf(var + LN_EPS)}; }
        f32x4 yv[4], gv, bv; u32x4 wh[2], wl[2];
#define P4_LOAD(k0) do { _Pragma("unroll") for (int i = 0; i < 4; ++i) yv[i] = __builtin_nontemporal_load((const f32x4*)(Y + (size_t)(t0 + yr0 + 16 * i) * DM + (k0) + yc)); \
        gv = *(const f32x4*)(a.ln1_g + (k0) + yc); bv = *(const f32x4*)(a.ln1_b + (k0) + yc); \
        _Pragma("unroll") for (int j = 0; j < 2; ++j) { wh[j] = *(const u32x4*)(WRh + (size_t)(we + 32 * j) * DM + (k0) + wk8); wl[j] = *(const u32x4*)(WRl + (size_t)(we + 32 * j) * DM + (k0) + wk8); } } while (0)
        P4_LOAD(0);
        f32x16 acc = {};
        for (int ch = 0; ch < 16; ++ch) {
            const int k0 = ch * 128;
            __syncthreads();
#pragma unroll
            for (int i = 0; i < 4; ++i) { const int row = yr0 + 16 * i; const f32x2 st = STAT[row];
                const f32x4 x = (yv[i] - st.x) * st.y * gv + bv;
                u32x2 hw, lw; hw.x = cvt_pk_bf16(x[0], x[1]); hw.y = cvt_pk_bf16(x[2], x[3]);
                lw.x = cvt_pk_bf16(x[0] - bflo(hw.x), x[1] - bfhi(hw.x)); lw.y = cvt_pk_bf16(x[2] - bflo(hw.y), x[3] - bfhi(hw.y));
                *(u32x2*)(lds + P4_AH + row * P4_ROWB + yc * 2) = hw; *(u32x2*)(lds + P4_AL + row * P4_ROWB + yc * 2) = lw;
                __builtin_nontemporal_store(hw, (u32x2*)(X1 + (size_t)(t0 + row) * DM + k0 + yc));
                { int t8 = __builtin_amdgcn_cvt_pk_fp8_f32(x[0], x[1], 0, false); t8 = __builtin_amdgcn_cvt_pk_fp8_f32(x[2], x[3], t8, true); *(int*)(X8 + (size_t)(t0 + row) * DM + k0 + yc) = t8; } }
#pragma unroll
            for (int j = 0; j < 2; ++j) { *(u32x4*)(lds + P4_WH + (we + 32 * j) * P4_ROWB + wk8 * 2) = wh[j]; *(u32x4*)(lds + P4_WL + (we + 32 * j) * P4_ROWB + wk8 * 2) = wl[j]; }
            __syncthreads();
            if (ch + 1 < 16) P4_LOAD(k0 + 128);
#pragma unroll
            for (int kk = 0; kk < 4; ++kk) { const int ko = ((kh * 4 + kk) * 16 + 8 * hi) * 2;
                const bf16x8 Ah = *(const bf16x8*)(lds + P4_AH + (32 * mt + r32) * P4_ROWB + ko), Al = *(const bf16x8*)(lds + P4_AL + (32 * mt + r32) * P4_ROWB + ko);
                const bf16x8 Bh = *(const bf16x8*)(lds + P4_WH + (32 * nt + r32) * P4_ROWB + ko), Bl = *(const bf16x8*)(lds + P4_WL + (32 * nt + r32) * P4_ROWB + ko);
                acc = __builtin_amdgcn_mfma_f32_32x32x16_bf16(Ah, Bh, acc, 0, 0, 0); acc = __builtin_amdgcn_mfma_f32_32x32x16_bf16(Ah, Bl, acc, 0, 0, 0); acc = __builtin_amdgcn_mfma_f32_32x32x16_bf16(Al, Bh, acc, 0, 0, 0); }
        }
#undef P4_LOAD
#pragma unroll
        for (int r = 0; r < 16; ++r) RED[(kh * 64 + 32 * mt + att::crow(r, hi)) * 65 + 32 * nt + r32] = acc[r];
        __syncthreads();
        const float NEG = -__builtin_inff(); const int grp = lane >> 3;
        for (int rr = 0; rr < 8; ++rr) {
            const int row = 8 * wave + rr;
            const float lg = RED[row * 65 + lane] + RED[(64 + row) * 65 + lane];
            const float sc = __builtin_amdgcn_rcpf(1.f + __expf(-lg)), sel = sc + bias;
            const float m1 = grp8_max(sel);
            const unsigned long long eq = __ballot(sel == m1);
            const int first = __builtin_ctz((unsigned)((eq >> (8 * grp)) & 0xffull));
            const float m2 = grp8_max((lane & 7) == first ? NEG : sel);
            const float gs = m1 + m2;
            int rank = 0;
#pragma unroll
            for (int g = 0; g < 8; ++g) { const float o = __shfl(gs, 8 * g); rank += (o > gs || (o == gs && g < grp)) ? 1 : 0; }
            float msel = rank < 4 ? sel : NEG;
            int myk = -1;
#pragma unroll
            for (int k = 0; k < 8; ++k) { const float mx = wave_max(msel); const unsigned long long b = __ballot(msel == mx); const int win = __builtin_ctzll(b);
                if (lane == win) { myk = k; msel = NEG; } }
            const float gsum = wave_sum(myk >= 0 ? sc : 0.f);
            if (myk >= 0) { const unsigned lpos = atomicAdd(LCNT + lane, 1u);
                REC[row * 8 + myk] = (u32x4){(unsigned)lane, lpos, __float_as_uint(sc * (2.5f / gsum)), 0u}; }
        }
        __syncthreads();
        if (tid < 64) BASE[tid] = atomicAdd(cnt + tid * CNT_STRIDE, LCNT[tid]);
        __syncthreads();
        { const u32x4 rc = REC[tid]; const int e = (int)rc.x; const unsigned pos = BASE[e] + rc.y; const int t = t0 + (tid >> 3);
          slot_tok[(size_t)e * CAP + pos] = t; slot_gate[t * 8 + (tid & 7)] = __uint_as_float(rc.z); TS[t * 8 + (tid & 7)] = e * CAP + (int)pos; }
    }
    __syncthreads();
}

__device__ __forceinline__ void p8_phase(const Args& a, const LAS int* pre, int vcu, int G) {
    const int tid = threadIdx.x, lane = tid & 63, wave = __builtin_amdgcn_readfirstlane(tid >> 6);
    unsigned char* ws = a.ws;
    const unsigned char* Y8 = (const unsigned char*)(ws + WS_BIG); const bf16_t* X1 = (const bf16_t*)(ws + WS_X1); const int* TS = (const int*)(ws + WS_SLOT + 2 * SLOT_ARR); const float* TG = (const float*)(ws + WS_SLOT + SLOT_ARR);
    const int gw = vcu * NWAVES + wave, NGW = G * NWAVES;
    const int ncol = 128 * ((lane >> 3) & 1) + 32 * (lane >> 4) + 4 * (lane & 7);
    const int shared0 = pre[NEXP] * 256;
    for (int row = gw; row < NTOK; row += NGW) {
        u32x2 xr[8]; unsigned yr[NPAIR][8]; float gk[NPAIR];
#pragma unroll
        for (int p = 0; p < NPAIR; ++p) gk[p] = p < 8 ? __uint_as_float(__builtin_amdgcn_readfirstlane(__float_as_uint(TG[row * 8 + p]))) * (1.f / Y8_SCALE) : (1.f / Y8_SCALE);
        { const bf16_t* xp = X1 + (size_t)row * DM + ncol;
#pragma unroll
          for (int k = 0; k < 8; ++k) xr[k] = *(const u32x2*)(xp + 256 * k); }
#pragma unroll
        for (int p = 0; p < NPAIR; ++p) {
            int srow;
            if (p < 8) { const int ts = __builtin_amdgcn_readfirstlane(TS[row * 8 + p]); srow = pre[ts >> 14] * 256 + (ts & (CAP - 1)); } else srow = shared0 + row;
            const unsigned char* yp = Y8 + (size_t)srow * DM + 4 * lane;
#pragma unroll
            for (int k = 0; k < 8; ++k) yr[p][k] = __builtin_nontemporal_load((const unsigned*)(yp + 256 * k)); }
        f32x4 v[8];
#pragma unroll
        for (int k = 0; k < 8; ++k) { f32x4 sacc = (f32x4){0.f, 0.f, 0.f, 0.f};
#pragma unroll
            for (int p = 0; p < NPAIR; ++p) { const f32x2 lo = __builtin_amdgcn_cvt_pk_f32_fp8((int)yr[p][k], false), hi = __builtin_amdgcn_cvt_pk_f32_fp8((int)yr[p][k], true); sacc += (f32x4){lo.x, lo.y, hi.x, hi.y} * gk[p]; }
            v[k] = (f32x4){bflo(xr[k].x), bfhi(xr[k].x), bflo(xr[k].y), bfhi(xr[k].y)} * DN_ALPHA + sacc; }
        float s = 0.f;
#pragma unroll
        for (int k = 0; k < 8; ++k) s += (v[k][0] + v[k][1]) + (v[k][2] + v[k][3]);
        const float mean = wave_sum(s) * (1.f / DM); float q = 0.f;
#pragma unroll
        for (int k = 0; k < 8; ++k) { v[k] = v[k] - mean; q += (v[k][0] * v[k][0] + v[k][1] * v[k][1]) + (v[k][2] * v[k][2] + v[k][3] * v[k][3]); }
        const float rstd = 1.f / sqrtf(wave_sum(q) * (1.f / DM) + LN_EPS);
        float* orow = a.out + (size_t)row * DM + ncol;
        asm volatile("" ::: "memory");
#pragma unroll
        for (int k = 0; k < 8; ++k) { const f32x4 g2 = *(const f32x4*)(a.ln2_g + 256 * k + ncol), b2 = *(const f32x4*)(a.ln2_b + 256 * k + ncol); __builtin_nontemporal_store(v[k] * rstd * g2 + b2, (f32x4*)(orow + 256 * k)); }
    }
}

#define XB_TMO      128
#define XB_XCNT(j)  (256  + 64 * (j))
#define XB_XSUB(j)  (1280 + 64 * (j))
#define XB_XGEN(j)  (2304 + 64 * (j))
#define XB_TOP      3328
#define XB_TOPGEN   3392
#define XCD_BAR_WORDS 3456
#define XB_SPIN_CAP (1u << 22)
__device__ __forceinline__ unsigned xb_xcc_id() { return (unsigned)__builtin_amdgcn_s_getreg((3 << 11) | 20) & 0xFu; }
#define XB_SPIN(cond, bar) do { unsigned _sp = 0; while (cond) { __builtin_amdgcn_s_sleep(1); \
    if ((++_sp & 255u) == 0u) { if (xb_ld(&(bar)[XB_TMO])) break; if (_sp > XB_SPIN_CAP) { atomicAdd(&(bar)[XB_TMO], 1u); break; } } } } while (0)
struct XcdBarrier { unsigned* bar; unsigned x; volatile LAS unsigned* st; };
__device__ __forceinline__ XcdBarrier xcd_barrier_post(unsigned* bar, volatile LAS unsigned* st) {
    XcdBarrier b; b.bar = bar; b.x = xb_xcc_id(); b.st = st;
    if (threadIdx.x == 0) (void)xb_add(&bar[XB_XCNT(b.x)], 1u);
    return b;
}
__device__ __forceinline__ void xcd_barrier_complete(unsigned* bar, unsigned x, unsigned& nloc, unsigned& nx) {
    const unsigned G = gridDim.x;
    unsigned sum, cnt, mine, sp = 0u;
    for (;;) {
        sum = 0u; cnt = 0u; mine = 0u;
#pragma unroll
        for (unsigned j = 0; j < 16; ++j) { const unsigned c = xb_ld(&bar[XB_XCNT(j)]); sum += c; cnt += (c > 0u) ? 1u : 0u; mine = (j == x) ? c : mine; }
        if (sum == G) break;
        __builtin_amdgcn_s_sleep(1);
        if ((++sp & 255u) == 0u) { if (xb_ld(&bar[XB_TMO])) break; if (sp > XB_SPIN_CAP) { atomicAdd(&bar[XB_TMO], 1u); break; } }
    }
    nloc = mine > 0u ? mine : 1u; nx = cnt > 0u ? cnt : 1u;
}
__device__ __forceinline__ void xcd_barrier(const XcdBarrier& b) {
    asm volatile("s_waitcnt vmcnt(0)" ::: "memory");
    __syncthreads();
    if (threadIdx.x == 0) {
        unsigned* bar = b.bar;
        __builtin_amdgcn_s_waitcnt(0);
        unsigned nloc = b.st[0], nx = b.st[1];
        if (nloc == 0u) { xcd_barrier_complete(bar, b.x, nloc, nx); b.st[0] = nloc; b.st[1] = nx; }
        const unsigned old = xb_add(&bar[XB_XSUB(b.x)], 1u);
        const unsigned gen = old / nloc;
        if (old + 1u == (gen + 1u) * nloc) {
            __builtin_amdgcn_fence(__ATOMIC_RELEASE, "agent");
            asm volatile("s_waitcnt vmcnt(0)" ::: "memory");
            const unsigned og = xb_add(&bar[XB_TOP], 1u);
            const unsigned tg = og / nx;
            if (og + 1u == (tg + 1u) * nx) xb_add(&bar[XB_TOPGEN], 1u);
            else XB_SPIN(xb_ld(&bar[XB_TOPGEN]) == tg, bar);
            __builtin_amdgcn_fence(__ATOMIC_ACQUIRE, "agent");
            xb_add(&bar[XB_XGEN(b.x)], 1u);
            asm volatile("s_waitcnt vmcnt(0)" ::: "memory");
        } else {
            XB_SPIN(xb_ld(&bar[XB_XGEN(b.x)]) == gen, bar);
            __builtin_amdgcn_fence(__ATOMIC_ACQUIRE, "agent");
            asm volatile("s_waitcnt vmcnt(0)" ::: "memory");
        }
    }
    __syncthreads();
}

constexpr int N_PHASES = 9;
constexpr int LDS_PRE = 131072;
constexpr int LDS_MISC = LDS_BYTES - 256;
__global__ void __launch_bounds__(NTHR, 2) hymba_fwd(Args args) {
    extern __shared__ __attribute__((aligned(16))) unsigned char lds_raw[];
    LAS unsigned char* lds = (LAS unsigned char*)lds_raw;
    const int G = gridDim.x, bx = blockIdx.x, tid = threadIdx.x;
    const int vcu = (G % 8 == 0) ? (bx % 8) * (G / 8) + bx / 8 : bx;
    unsigned char* ws = args.ws;
    const int lo = args.ph_lo, hi = args.ph_hi;
    const bool part = args.coop && G == 256;
    const bool is_conv = part && bx >= BG_GC;
    const int cidx = bx;
#ifndef PHASE_MASK
#define PHASE_MASK 0x1ff
#endif
#define IN(k) ((((PHASE_MASK) >> (k)) & 1) && lo <= (k) && (k) < hi)
#ifndef REP_MASK
#define REP_MASK 0
#endif
#define REPS(k) for (int rep_ = 0; rep_ < 1 + (((REP_MASK) >> (k)) & 1); ++rep_)
#define REPBAR(k) do { if ((((REP_MASK) >> (k)) & 1) && rep_ == 0 && args.coop) xcd_barrier(bar); } while (0)
#define SEAM(k) do { if (IN(k) && IN((k) + 1)) { xcd_barrier(bar); } } while (0)
    XcdBarrier bar; bar.bar = (unsigned*)(ws + WS_CTL) + CW_BAR; bar.x = 0; bar.st = (volatile LAS unsigned*)(lds + LDS_MISC);
    if (args.coop) {
        if (tid < 2) ((LAS unsigned*)(lds + LDS_MISC))[tid] = 0u;
        __syncthreads();
        bar = xcd_barrier_post((unsigned*)(ws + WS_CTL) + CW_BAR, (volatile LAS unsigned*)(lds + LDS_MISC));
    }
    if (IN(0)) { p0_phase(args, lds, vcu, G, part ? 15 : 7);
#ifdef DUP_P0
        if (args.coop) xcd_barrier(bar);
        p0_phase(args, lds, vcu, G, DUP_P0);
#endif
    }
    SEAM(0);
    if (IN(1)) {
        unsigned* ctl = (unsigned*)(ws + WS_CTL);
        if (is_conv) {
            const int cw = (bx - BG_GC) * NWAVES + __builtin_amdgcn_readfirstlane(tid >> 6);
            const int n = p0_items<1, true>(args, lds, cw, BG_NS, ctl + CW_DONE);
            if ((tid & 63) == 0) ctl[CW_PROG + cw] = (unsigned)n;
        } else {
            int g1 = G, c1 = bx, g2 = G, c2 = bx, b2 = 0, im2 = 1 << 20;
            if (part) { g1 = BG_GC; c1 = cidx; if (cidx < BG_X) { g2 = BG_X; c2 = cidx; b2 = 0; im2 = BG_F3; } else { g2 = BG_GC - BG_X; c2 = cidx - BG_X; b2 = BG_X * BG_F3; } }
            { pg8::DenseOrder S; S.init(NTOK, 2048, DM, g1, c1);
              EpiProj E{(bf16_t*)(ws + WS_PROJ), (const float*)(ws + WS_TAB), lds, 0, 1.f};
              pg8::gemm_phase<EpiProj, pg8::DenseOrder>(lds, (const bf16_t*)(ws + WS_XB), (const bf16_t*)(ws + WS_WIN), DM, S, E); }
            { pg8::DenseOrder S; S.init(NTOK, 3072, DM / 2, g2, c2, b2, im2);
              EpiProj E{(bf16_t*)(ws + WS_PROJ), (const float*)(ws + WS_TAB), lds, 8, 1.f / W8_SCALE};
              pg8::gemm_phase<EpiProj, pg8::DenseOrder, true>(lds, (const bf16_t*)(ws + WS_XIN8), (const bf16_t*)(ws + WS_WIN8), DM / 2, S, E); }
            if (part && cidx < BG_X && tid == 0) (void)xb_add(ctl + CW_DONE, 1u);
        }
    }
    SEAM(1);
    if (IN(2)) {
#ifndef NO_LRU
        for (int item = vcu; item < 256; item += G) lru_item(args, (char*)lds_raw, item);
#endif
#ifdef DUP_LRU
        if (args.coop) xcd_barrier(bar);
        for (int item = vcu; item < 256; item += G) lru_item(args, (char*)lds_raw, item);
#endif
        att_phase(args, (char*)lds_raw, lds, bx, G);
#ifdef DUP_ATT
        if (args.coop) xcd_barrier(bar);
        att_phase(args, (char*)lds_raw, lds, bx, G);
#endif
    }
    SEAM(2);
    if (IN(3)) REPS(3) { merge_phase(args, vcu, G); REPBAR(3); }
    SEAM(3);
    if (IN(4)) {
        pg8::DenseOrder S; S.init(NTOK, DM, 1024, G, bx);
        EpiY E{(const bf16_t*)(ws + WS_XB), args.out, (float*)(ws + WS_RPART), lds};
        pg8::gemm_phase<EpiY, pg8::DenseOrder, false, 16, 8>(lds, (const bf16_t*)(ws + WS_MIX), (const bf16_t*)(ws + WS_WOUT), 1024, S, E, ws + WS_MIX + 32 * MiB, ws + WS_WOUT + 4 * MiB);
    }
    SEAM(4);
    if (IN(5)) { p4_phase(args, (char*)lds_raw, vcu, G);
        if (part) {
            __syncthreads();
            const int gw = vcu * NWAVES + __builtin_amdgcn_readfirstlane(tid >> 6), cw = gw % BG_NS, hs = gw / BG_NS, nh = (256 * NWAVES - cw + BG_NS - 1) / BG_NS;
            const int k0 = (int)((const unsigned*)(ws + WS_CTL))[CW_PROG + cw] + hs;
            (void)p0_items<1, false>(args, lds, k0 * BG_NS + cw, nh * BG_NS);
        }
#ifdef DUP_P4
        if (args.coop) { xcd_barrier(bar); if (bx == 0 && tid < NEXP) ((unsigned*)(ws + WS_CTL))[CW_CNT + tid * CNT_STRIDE] = 0u; xcd_barrier(bar); }
        p4_phase(args, (char*)lds_raw, vcu, G);
#endif
    }
    SEAM(5);
    if (IN(6) || IN(7) || IN(8)) {
        LAS int* pre = (LAS int*)(lds + LDS_PRE);
        if (tid == 0) { const unsigned* cnt = (const unsigned*)(ws + WS_CTL) + CW_CNT; int s = 0;
            for (int e = 0; e < NE1; ++e) { pre[e] = s; s += (int)((cnt[e * CNT_STRIDE] + 255u) >> 8); } pre[NE1] = s; }
        __syncthreads();
    }
    if (IN(6)) {
        pg8::GroupOrder<4, true> S{(const LAS int*)(lds + LDS_PRE), (const int*)(ws + WS_CTL) + CW_CNT, (const int*)(ws + WS_SLOT), G, vcu, (size_t)1024 * DM, (size_t)256 * DM, (LAS v4i_t*)(lds + LDS_PRE + 512)}; S.build();
        EpiH E{(unsigned char*)(ws + WS_H), nullptr};
        pg8::gemm_phase<EpiH, pg8::GroupOrder<4, true>, true>(lds, (const bf16_t*)(ws + WS_X8), (const bf16_t*)(ws + WS_WGU), DM / 2, S, E);
    }
    SEAM(6);
    if (IN(7)) {
#ifdef STAG7
        { const unsigned long long t0 = __builtin_amdgcn_s_memrealtime(), dl = (unsigned long long)((vcu & 15) * STAG7);
          while (__builtin_amdgcn_s_memrealtime() - t0 < dl) __builtin_amdgcn_s_sleep(8); }
#endif
        pg8::GroupOrder<8, false> S{(const LAS int*)(lds + LDS_PRE), (const int*)(ws + WS_CTL) + CW_CNT, (const int*)(ws + WS_SLOT), G, vcu, (size_t)DM * DEXP, (size_t)256 * DEXP, (LAS v4i_t*)(lds + LDS_PRE + 512)}; S.build();
        EpiPair E{(unsigned char*)(ws + WS_BIG), lds, 0};
#ifdef PRE_P7
        { EpiPair E2{(unsigned char*)(ws + WS_BIG), lds, 1}; pg8::gemm_phase<EpiPair, pg8::GroupOrder<8, false>, true, 0, 0, PRE_P7 - 1>(lds, (const bf16_t*)(ws + WS_H), (const bf16_t*)(ws + WS_WD), DEXP / 2, S, E2); }
        if (args.coop) xcd_barrier(bar);
#endif
        pg8::gemm_phase<EpiPair, pg8::GroupOrder<8, false>, true>(lds, (const bf16_t*)(ws + WS_H), (const bf16_t*)(ws + WS_WD), DEXP / 2, S, E);
#ifdef DUP_P7
        if (args.coop) xcd_barrier(bar);
        pg8::gemm_phase<EpiPair, pg8::GroupOrder<8, false>, true>(lds, (const bf16_t*)(ws + WS_H), (const bf16_t*)(ws + WS_WD), DEXP / 2, S, E);
#endif
    }
    SEAM(7);
    if (IN(8)) { p8_phase(args, (const LAS int*)(lds + LDS_PRE), vcu, G);
#ifdef DUP_P8
        if (args.coop) xcd_barrier(bar);
        p8_phase(args, (const LAS int*)(lds + LDS_PRE), vcu, G);
#endif
    }
#undef IN
#undef SEAM
}

extern "C" void kernel_launch(void* const* d_in, const int* in_sizes, int n_in, void* d_out, int out_size, void* d_ws, size_t ws_size, hipStream_t stream) {
    static int grid = 0;
    if (grid == 0) {
        if (n_in != 22 || out_size != NTOK * DM || ws_size < WS_END) { fprintf(stderr, "kernel_launch: unexpected problem: n_in %d out %d ws %zu (need %zu)\n", n_in, out_size, ws_size, (size_t)WS_END); grid = -1; return; }
        int dev = 0, cus = 0, per_cu = 0;
        (void)hipGetDevice(&dev); (void)hipDeviceGetAttribute(&cus, hipDeviceAttributeMultiprocessorCount, dev);
        if (hipFuncSetAttribute((const void*)hymba_fwd, hipFuncAttributeMaxDynamicSharedMemorySize, LDS_BYTES) != hipSuccess) { fprintf(stderr, "kernel_launch: hipFuncSetAttribute failed\n"); grid = -1; return; }
        if (hipOccupancyMaxActiveBlocksPerMultiprocessor(&per_cu, (const void*)hymba_fwd, NTHR, LDS_BYTES) != hipSuccess || per_cu < 1 || cus < 1) {
            fprintf(stderr, "kernel_launch: the occupancy query admits %d workgroups per CU on %d CUs for %d threads + %d B LDS: the grid barrier needs every workgroup resident; nothing launched\n", per_cu, cus, NTHR, LDS_BYTES); (void)hipGetLastError(); grid = -1; return; }
        (void)hipGetLastError();
        grid = cus;
    }
    if (grid < 0) return;
    Args a{};
    const float** f = (const float**)&a;
    for (int i = 0; i < 22; ++i) f[i] = (const float*)d_in[i];
    a.out = (float*)d_out; a.ws = (unsigned char*)d_ws; a.coop = 0; a.pad = 0;
#ifndef ONE_LAUNCH
    for (int p = 0; p < N_PHASES; ++p) { a.ph_lo = p; a.ph_hi = p + 1; hipLaunchKernelGGL(hymba_fwd, dim3(grid), dim3(NTHR), LDS_BYTES, stream, a); }
#else
    a.ph_lo = 0; a.ph_hi = N_PHASES; a.coop = 1;
    (void)hipMemsetAsync((char*)d_ws + WS_CTL + (size_t)CW_BAR * 4, 0, (size_t)XCD_BAR_WORDS * 4, stream);
    hipLaunchKernelGGL(hymba_fwd, dim3(grid), dim3(NTHR), LDS_BYTES, stream, a);
#endif
}
```

```cpp
#include <hip/hip_runtime.h>
#ifndef MULTI_LAUNCH
#define ONE_LAUNCH 1
#endif
#include <cstdio>
#include <cstdint>

#define LAS __attribute__((address_space(3)))
typedef unsigned short bf16_t;
typedef short bf16x8 __attribute__((ext_vector_type(8)));
typedef short s16x4 __attribute__((ext_vector_type(4)));
typedef float f32x2 __attribute__((ext_vector_type(2)));
typedef float f32x4 __attribute__((ext_vector_type(4)));
typedef float f32x16 __attribute__((ext_vector_type(16)));
typedef unsigned u32x2 __attribute__((ext_vector_type(2)));
typedef unsigned u32x4 __attribute__((ext_vector_type(4)));
typedef int v4i_t __attribute__((ext_vector_type(4)));
typedef int v8i_t __attribute__((ext_vector_type(8)));

constexpr int NB = 8, SEQ = 2048, DM = 2048, NTOK = NB * SEQ;
constexpr int NPROJ = 5120, NGRP = 40;
constexpr int NEXP = 64, NE1 = 65, DEXP = 512, TOPK = 8, NPAIR = 9;
constexpr int CAP = NTOK;
constexpr float DN_ALPHA = 1.189207115002721f;
constexpr float LN_EPS = 1e-5f;
constexpr int NWAVES = 8, NTHR = 512;
constexpr int LDS_BYTES = 163840;
constexpr int LDS_EPI = 131072 + 1024, EPI_ROWB = 144, EPI_WAVEB = 16 * EPI_ROWB;

constexpr size_t MiB = 1u << 20;
constexpr size_t WS_CTL = 0;
constexpr size_t WS_TAB = 1 * MiB;
constexpr size_t WS_WRG = 2 * MiB;
constexpr size_t WS_WR = 3 * MiB;
constexpr size_t WS_SLOT = 4 * MiB;
constexpr size_t SLOT_ARR = (size_t)NE1 * CAP * 4;
constexpr size_t WS_RPART = 17 * MiB;
constexpr size_t WS_ASTAT = 21 * MiB;
constexpr size_t WS_WD = 24 * MiB;
constexpr size_t WS_X1 = 154 * MiB;
constexpr size_t WS_H = 218 * MiB;
constexpr size_t WS_BIG = 380 * MiB;
constexpr size_t WS_WGU = WS_BIG;
constexpr size_t WS_XIN8 = WS_BIG + 168 * MiB;
constexpr size_t WS_WIN8 = WS_BIG + 200 * MiB;
constexpr size_t WS_X8 = WS_BIG + 132 * MiB;
constexpr size_t WS_WIN = WS_BIG + 260 * MiB;
constexpr size_t WS_WOUT = WS_BIG + 280 * MiB;
constexpr size_t WS_XB = WS_BIG + 288 * MiB;
constexpr size_t WS_PROJ = WS_BIG + 352 * MiB;
constexpr size_t WS_MIX = WS_BIG + 512 * MiB;
constexpr size_t WS_END = WS_BIG + 576 * MiB;

constexpr float Y8_SCALE = 32.f, W8_SCALE = 64.f, H8_SCALE = 8.f, A8_SCALE = 16.f;
constexpr int CW_CNT = 64, CNT_STRIDE = 32;
constexpr int CW_BAR = 4096;

__device__ __forceinline__ unsigned cvt_pk_bf16(float lo, float hi) { unsigned r; asm volatile("v_cvt_pk_bf16_f32 %0, %1, %2" : "=v"(r) : "v"(lo), "v"(hi)); return r; }
__device__ __forceinline__ float bf2f(unsigned short b) { return __uint_as_float(((unsigned)b) << 16); }
__device__ __forceinline__ float bflo(unsigned w) { return __uint_as_float(w << 16); }
__device__ __forceinline__ float bfhi(unsigned w) { return __uint_as_float(w & 0xffff0000u); }
__device__ __forceinline__ float wave_sum(float v) {
#pragma unroll
    for (int o = 1; o < 64; o <<= 1) v += __shfl_xor(v, o);
    return v;
}
#define LDS_WAIT() asm volatile("s_waitcnt lgkmcnt(0)" ::: "memory")
#define VM_WAIT() asm volatile("s_waitcnt vmcnt(0)" ::: "memory")

namespace pg8 {
constexpr int BM = 256, BK = 64, HALF = 128, HTB = HALF * BK * 2, STAGE_BYTES = 8 * HTB, NXCD = 8, WGM = 8;
__host__ __device__ __forceinline__ int lds_byte(int r, int c) { const int st = (r >> 4) * 2 + (c >> 5), rr = r & 15, cc = c & 31, ob = rr * 64 + cc * 2; return st * 1024 + (ob ^ (((ob >> 9) & 1) << 5)); }
__host__ __device__ __forceinline__ void stage_rc(int b, int& R, int& C) { const int st = b / 1024, sb = b % 1024, swz = sb ^ (((sb >> 9) & 1) << 5); R = (st >> 1) * 16 + swz / 64; C = (st & 1) * 32 + (swz % 64) / 2; }
__host__ __device__ __forceinline__ int perm32(int rho) { const int n = rho >> 4, i = rho & 15; return 8 * (i >> 2) + 4 * n + (i & 3); }

struct Unit { int pm, pn, e, cnt, row0; };

struct DenseOrder {
    int nM, nN, nwg, G, c, base, imax; size_t bstride;
    __device__ void init(int M, int N, int K, int G_, int c_, int base_ = 0, int imax_ = 1 << 20) { nM = M / BM; nN = N / BM; nwg = nM * nN; G = G_; c = c_; base = base_; imax = imax_; bstride = (size_t)BM * K * 2; }
    __device__ __forceinline__ bool next(int i, Unit& u) const {
        if (i >= imax) return false;
        const long L = (long)base + (long)i * G + c; if (L >= nwg) return false;
        int wgid = (int)L; { const int q = nwg / NXCD, r = nwg % NXCD, xcd = wgid % NXCD, off = wgid / NXCD; wgid = (xcd < r ? xcd * (q + 1) : r * (q + 1) + (xcd - r) * q) + off; }
        const int nig = WGM * nN, gid = wgid / nig, fm = gid * WGM, gsz = (nM - fm) < WGM ? (nM - fm) : WGM;
        u.pm = fm + ((wgid % nig) % gsz); u.pn = (wgid % nig) / gsz; u.e = 0; u.cnt = 0; u.row0 = 0; return true;
    }
    __device__ __forceinline__ int arow(const Unit& u, int r) const { return u.pm * BM + r; }
    __device__ __forceinline__ size_t boff(const Unit& u) const { return (size_t)u.pn * bstride; }
};
template <int NPN, bool GATHER> struct GroupOrder {
    const LAS int* pre; const int* cnt; const int* slot_tok; int G, vcu; size_t estride, pstride;
    LAS v4i_t* list;
    static constexpr int MAXU = 32;
    __device__ __forceinline__ void build() const {
        if (threadIdx.x < MAXU) { const int i = threadIdx.x; const int L = i * G + vcu; const int total = pre[NE1] * NPN; v4i_t r = (v4i_t){-1, 0, 0, 0};
            if (L < total) { const int T = L / NPN, pn = L - T * NPN; int lo = 0, hi = NE1;
                while (hi - lo > 1) { const int mid = (lo + hi) >> 1; if (pre[mid] <= T) lo = mid; else hi = mid; }
                r = (v4i_t){lo, (T - pre[lo]) | (pn << 16), cnt[lo * CNT_STRIDE], pre[lo] * BM}; }
            list[i] = r; }
        __syncthreads();
    }
    __device__ __forceinline__ bool next(int i, Unit& u) const {
        if (i >= MAXU) return false;
        const v4i_t r = list[i]; if (r.x < 0) return false;
        u.e = r.x; u.pm = r.y & 0xffff; u.pn = r.y >> 16; u.cnt = r.z; u.row0 = r.w; return true;
    }
    __device__ __forceinline__ int arow(const Unit& u, int r) const {
        const int s = u.pm * BM + r;
        if (GATHER) { return s < u.cnt ? slot_tok[(size_t)u.e * CAP + s] : 0; }
        else return u.row0 + s;
    }
    __device__ __forceinline__ size_t boff(const Unit& u) const { return (size_t)u.e * estride + (size_t)u.pn * pstride; }
};

template <class Epi, class Sched, bool F8 = false, int MIX1 = 0, int MIX2 = 0, int PROBE = 0>
__device__ __forceinline__ void gemm_phase(LAS unsigned char* lds, const bf16_t* Abase, const bf16_t* Bbase, const int K, const Sched& S, const Epi& E, const void* Abase2 = nullptr, const void* Bbase2 = nullptr) {
    const int tid = threadIdx.x, wid = __builtin_amdgcn_readfirstlane(tid >> 6), lane = tid & 63, wr = wid >> 2, wc = wid & 3, fr = lane & 15, fq = lane >> 4;
    const int nt = MIX1 ? (MIX1 + MIX2) : K / BK;
    constexpr int SCW = MIX1 ? 0x79797979 : 0x7f7f7f7f, SCX = MIX1 ? 0x7b7b7b7b : 0x7f7f7f7f;
    int Rr[2], Cc[2]; unsigned voffB[2];
#pragma unroll
    for (int i = 0; i < 2; ++i) { int R, C; stage_rc(tid * 16 + i * 8192, R, C); Rr[i] = R; Cc[i] = C; int Rb = Epi::PERM ? ((R & ~31) + perm32(R & 31)) : R;
        if constexpr (Epi::RELABEL) Rb = 64 * (R >> 5) + (Epi::PERM ? perm32(R & 31) : (R & 31));
        voffB[i] = (unsigned)(Rb * K + C) * 2u; }
    const size_t kstep = (size_t)(BK * 2);
    const size_t hstep = (size_t)(Epi::RELABEL ? 32 : HALF) * K * 2;
    const unsigned ldsw = (unsigned)wid * 1024u;
    const int aoff = lds_byte(wr * 64 + fr, fq * 8), boff = lds_byte(wc * 32 + fr, fq * 8);
#define PG8_SA(b, h) (((b) * 2 + (h)) * HTB)
#define PG8_SB(b, h) ((4 + (b) * 2 + (h)) * HTB)
#define PG8_STAGE(bufoff, gbase, voff) do { _Pragma("unroll") for (int _i = 0; _i < 2; ++_i) \
        __builtin_amdgcn_global_load_lds((const unsigned*)((const char*)(gbase) + (voff)[_i]), (LAS unsigned*)(lds + (bufoff) + ldsw + _i * 8192), 16, 0, 0); } while (0)
#define PG8_LDA(dst, b, h) do { _Pragma("unroll") for (int m = 0; m < 4; ++m) { const v4i_t lo_ = *(const LAS v4i_t*)(lds + PG8_SA(b, h) + aoff + m * 2048), hi_ = *(const LAS v4i_t*)(lds + PG8_SA(b, h) + aoff + m * 2048 + 1024); \
        dst[m] = __builtin_shufflevector(lo_, hi_, 0, 1, 2, 3, 4, 5, 6, 7); } } while (0)
#define PG8_LDB(dst, b, h) do { _Pragma("unroll") for (int n = 0; n < 2; ++n) { const v4i_t lo_ = *(const LAS v4i_t*)(lds + PG8_SB(b, h) + boff + n * 2048), hi_ = *(const LAS v4i_t*)(lds + PG8_SB(b, h) + boff + n * 2048 + 1024); \
        dst[n] = __builtin_shufflevector(lo_, hi_, 0, 1, 2, 3, 4, 5, 6, 7); } } while (0)
#define PG8_LO(x) __builtin_bit_cast(bf16x8, __builtin_shufflevector(x, x, 0, 1, 2, 3))
#define PG8_HI(x) __builtin_bit_cast(bf16x8, __builtin_shufflevector(x, x, 4, 5, 6, 7))
#define PG8_MMA(ai, bj, At, Bt) do { __builtin_amdgcn_s_setprio(1); _Pragma("unroll") for (int m = 0; m < 4; ++m) _Pragma("unroll") for (int n = 0; n < 2; ++n) { \
        if (f8t) { acc[ai][bj][m][n] = __builtin_amdgcn_mfma_scale_f32_16x16x128_f8f6f4(Bt[n], At[m], acc[ai][bj][m][n], 0, 0, 0, SCW, 0, SCX); } \
        else { acc[ai][bj][m][n] = __builtin_amdgcn_mfma_f32_16x16x32_bf16(PG8_LO(Bt[n]), PG8_LO(At[m]), acc[ai][bj][m][n], 0, 0, 0); \
               acc[ai][bj][m][n] = __builtin_amdgcn_mfma_f32_16x16x32_bf16(PG8_HI(Bt[n]), PG8_HI(At[m]), acc[ai][bj][m][n], 0, 0, 0); } } \
        __builtin_amdgcn_s_setprio(0); } while (0)
#define PG8_WAIT_V(n) asm volatile("s_waitcnt vmcnt(" #n ")" ::: "memory")
#define PG8_WAIT_L(n) asm volatile("s_waitcnt lgkmcnt(" #n ")" ::: "memory")
#define PG8_BAR __builtin_amdgcn_s_barrier()
#define PG8_SCHED __builtin_amdgcn_sched_barrier(0)
#define PG8_AOFFS(u, v0, v1) do { _Pragma("unroll") for (int _i = 0; _i < 2; ++_i) { \
        v0[_i] = (unsigned)(((size_t)S.arow(u, Rr[_i]) * K + Cc[_i]) * 2u); v1[_i] = (unsigned)(((size_t)S.arow(u, HALF + Rr[_i]) * K + Cc[_i]) * 2u); } } while (0)
    Unit cur, nxt; int ui = 0;
    if (!S.next(0, cur)) return;
    f32x4 acc[2][2][4][2];
#pragma unroll
    for (int a = 0; a < 2; ++a)
#pragma unroll
        for (int b = 0; b < 2; ++b)
#pragma unroll
            for (int m = 0; m < 4; ++m)
#pragma unroll
                for (int n = 0; n < 2; ++n) acc[a][b][m][n] = (f32x4){0.f, 0.f, 0.f, 0.f};
    v8i_t At[4], B0[2], B1[2];
    unsigned vA0[2], vA1[2], nA0[2], nA1[2];
    PG8_AOFFS(cur, vA0, vA1);
    bool has_next = S.next(1, nxt);
    if (has_next) { PG8_AOFFS(nxt, nA0, nA1); } else { nA0[0] = vA0[0]; nA0[1] = vA0[1]; nA1[0] = vA1[0]; nA1[1] = vA1[1]; }
    asm volatile("" : "+v"(vA0[0]), "+v"(vA0[1]), "+v"(vA1[0]), "+v"(vA1[1]), "+v"(nA0[0]), "+v"(nA0[1]), "+v"(nA1[0]), "+v"(nA1[1]));
    const char* cA = (const char*)Abase; const char* cB = (const char*)Bbase + S.boff(cur);
    const char* cA2 = (const char*)Abase2; const char* cB2 = MIX1 ? (const char*)Bbase2 + S.boff(cur) : nullptr;
#define PG8_A_AT(tau) ((MIX1 && (tau) >= MIX1) ? cA2 + (size_t)((tau) - MIX1) * kstep : cA + (size_t)(tau) * kstep)
#define PG8_B_AT(tau) ((MIX1 && (tau) >= MIX1) ? cB2 + (size_t)((tau) - MIX1) * kstep : cB + (size_t)(tau) * kstep)
    PG8_STAGE(PG8_SB(0, 0), cB, voffB); PG8_STAGE(PG8_SB(0, 1), cB + hstep, voffB); PG8_STAGE(PG8_SA(0, 0), cA, vA0); PG8_STAGE(PG8_SA(0, 1), cA, vA1);
    if (wr == 1) PG8_BAR;
    PG8_WAIT_V(2); PG8_BAR;
    PG8_STAGE(PG8_SB(1, 0), cB + kstep, voffB); PG8_STAGE(PG8_SA(1, 0), cA + kstep, vA0); PG8_STAGE(PG8_SB(1, 1), cB + hstep + kstep, voffB);
    PG8_WAIT_V(6); PG8_BAR;
    for (;;) {
        const char* nB = has_next ? (const char*)Bbase + S.boff(nxt) : cB;
        const char* nB2 = (MIX1 && has_next) ? (const char*)Bbase2 + S.boff(nxt) : cB2;
#define PG8_KBODY(F8T_) do { \
            constexpr bool f8t = (F8T_); const bool last = (t == nt - 2); \
            const char* a1 = PG8_A_AT(t + 1); \
            const char* b2 = last ? nB : PG8_B_AT(t + 2); \
            const char* a2 = last ? cA : PG8_A_AT(t + 2); \
            const char* a3 = last ? cA + kstep : PG8_A_AT(t + 3); const char* b3 = last ? nB + kstep : PG8_B_AT(t + 3); \
              \
            PG8_LDB(B0, 0, 0); PG8_LDB(B1, 0, 1); PG8_SCHED; PG8_LDA(At, 0, 0); PG8_STAGE(PG8_SA(1, 1), a1, vA1); \
            if (last) { vA0[0] = nA0[0]; vA0[1] = nA0[1]; vA1[0] = nA1[0]; vA1[1] = nA1[1]; } \
            PG8_WAIT_V(8); PG8_WAIT_L(0); PG8_BAR; PG8_SCHED; PG8_MMA(0, 0, At, B0); PG8_MMA(0, 1, At, B1); PG8_SCHED; PG8_BAR; PG8_SCHED; \
              \
            PG8_LDA(At, 0, 1); PG8_STAGE(PG8_SB(0, 0), b2, voffB); PG8_STAGE(PG8_SB(0, 1), b2 + hstep, voffB); PG8_STAGE(PG8_SA(0, 0), a2, vA0); \
            PG8_WAIT_V(8); PG8_WAIT_L(0); PG8_BAR; PG8_SCHED; if constexpr (PROBE == 0) { PG8_MMA(1, 0, At, B0); PG8_MMA(1, 1, At, B1); } PG8_SCHED; PG8_BAR; PG8_SCHED; \
              \
            PG8_LDB(B0, 1, 0); PG8_LDB(B1, 1, 1); PG8_SCHED; PG8_LDA(At, 1, 0); PG8_STAGE(PG8_SA(0, 1), a2, vA1); \
            PG8_WAIT_V(8); PG8_WAIT_L(0); PG8_BAR; PG8_SCHED; PG8_MMA(0, 0, At, B0); PG8_MMA(0, 1, At, B1); PG8_SCHED; PG8_BAR; PG8_SCHED; \
              \
            PG8_LDA(At, 1, 1); PG8_STAGE(PG8_SB(1, 0), b3, voffB); PG8_STAGE(PG8_SB(1, 1), b3 + hstep, voffB); PG8_STAGE(PG8_SA(1, 0), a3, vA0); \
            PG8_WAIT_V(8); PG8_WAIT_L(0); PG8_BAR; PG8_SCHED; if constexpr (PROBE == 0) { PG8_MMA(1, 0, At, B0); PG8_MMA(1, 1, At, B1); } PG8_SCHED; PG8_BAR; PG8_SCHED; \
        } while (0)
        if constexpr (MIX1 > 0) {
            int t = 0;
#pragma unroll 1
            for (; t < MIX1; t += 2) PG8_KBODY(false);
#pragma unroll 1
            for (; t < nt; t += 2) PG8_KBODY(true);
        } else {
#pragma unroll 1
            for (int t = 0; t < nt; t += 2) PG8_KBODY(F8);
        }
#undef PG8_KBODY
        if (wr == 0) PG8_BAR;
        E(acc, cur, wr, wc, fr, fq);
        if (!has_next) break;
#pragma unroll
        for (int a = 0; a < 2; ++a)
#pragma unroll
            for (int b = 0; b < 2; ++b)
#pragma unroll
                for (int m = 0; m < 4; ++m)
#pragma unroll
                    for (int n = 0; n < 2; ++n) acc[a][b][m][n] = (f32x4){0.f, 0.f, 0.f, 0.f};
        cur = nxt; cB = nB; cB2 = nB2; ++ui;
        has_next = S.next(ui + 1, nxt);
        if (has_next) { PG8_AOFFS(nxt, nA0, nA1); }
        asm volatile("" : "+v"(nA0[0]), "+v"(nA0[1]), "+v"(nA1[0]), "+v"(nA1[1]));
        if (wr == 1) PG8_BAR;
    }
    PG8_WAIT_V(0);
    PG8_BAR;
#undef PG8_SA
#undef PG8_SB
#undef PG8_STAGE
#undef PG8_LDA
#undef PG8_LDB
#undef PG8_MMA
#undef PG8_WAIT_V
#undef PG8_WAIT_L
#undef PG8_BAR
#undef PG8_SCHED
#undef PG8_AOFFS
#undef PG8_A_AT
#undef PG8_B_AT
}
}

struct EpiProj {
    static constexpr bool RELABEL = true, PERM = true;
    bf16_t* proj; const float* rope; LAS unsigned char* lds; int pn_off; float scale;
    __device__ __forceinline__ void operator()(const f32x4 (&acc)[2][2][4][2], const pg8::Unit& u, int wr, int wc, int fr, int fq) const {
        const int pnl = u.pn + pn_off, type = pnl >> 2;
        const int lane = 16 * fq + fr, wid = wr * 4 + wc;
        LAS unsigned char* scr = lds + LDS_EPI + wid * EPI_WAVEB;
        const int row0 = u.pm * 256 + wr * 64, b = row0 >> 11;
        const bool rot = (type == 2 || type == 3) && (wc & 1) == 0;
        const float sgn = fq < 2 ? -1.f : 1.f;
        const int g = 2 * pnl + (wc >> 1);
        bf16_t* gbase = proj + ((size_t)(b * NGRP + g) * SEQ) * 128 + 64 * (wc & 1) + 8 * (lane & 7);
#pragma unroll
        for (int ai = 0; ai < 2; ++ai)
#pragma unroll
            for (int m = 0; m < 4; ++m) {
                const int sb = (row0 + ai * 128 + m * 16) & 2047, s = sb + fr;
                u32x4 x[2];
#pragma unroll
                for (int bj = 0; bj < 2; ++bj) {
                    f32x4 v0 = acc[ai][bj][m][0] * scale, v1 = acc[ai][bj][m][1] * scale;
                    if (type == 1) {
#pragma unroll
                        for (int j = 0; j < 4; ++j) {
                            { const float xx = v0[j]; const float e = __builtin_amdgcn_exp2f(-2.302208198f * (xx + 0.044715f * xx * xx * xx)); v0[j] = xx * __builtin_amdgcn_rcpf(1.f + e); }
                            { const float xx = v1[j]; const float e = __builtin_amdgcn_exp2f(-2.302208198f * (xx + 0.044715f * xx * xx * xx)); v1[j] = xx * __builtin_amdgcn_rcpf(1.f + e); }
                        }
                    }
                    if (rot && bj == 0) {
                        const float* cp = rope + s * 16 + 8 * (fq & 1);
                        const f32x4 c0 = *(const f32x4*)cp, c1 = *(const f32x4*)(cp + 4), s0 = *(const f32x4*)(cp + 32768), s1 = *(const f32x4*)(cp + 32768 + 4);
                        f32x4 p0, p1;
#pragma unroll
                        for (int j = 0; j < 4; ++j) { p0[j] = __shfl_xor(v0[j], 32); p1[j] = __shfl_xor(v1[j], 32); }
                        v0 = v0 * c0 + sgn * (p0 * s0); v1 = v1 * c1 + sgn * (p1 * s1);
                    }
                    x[bj].x = cvt_pk_bf16(v0[0], v0[1]); x[bj].y = cvt_pk_bf16(v0[2], v0[3]); x[bj].z = cvt_pk_bf16(v1[0], v1[1]); x[bj].w = cvt_pk_bf16(v1[2], v1[3]);
                }
                *(LAS u32x4*)(scr + fr * EPI_ROWB + fq * 16) = x[0]; *(LAS u32x4*)(scr + fr * EPI_ROWB + 64 + fq * 16) = x[1];
                const u32x4 ta = *(const LAS u32x4*)(scr + (lane >> 3) * EPI_ROWB + (lane & 7) * 16), tb = *(const LAS u32x4*)(scr + (8 + (lane >> 3)) * EPI_ROWB + (lane & 7) * 16);
                *(u32x4*)(gbase + (size_t)(sb + (lane >> 3)) * 128) = ta; *(u32x4*)(gbase + (size_t)(sb + 8 + (lane >> 3)) * 128) = tb;
            }
    }
};
struct EpiY {
    static constexpr bool RELABEL = false, PERM = false;
    const bf16_t* xbf; float* y; float* rpart; LAS unsigned char* lds;
    __device__ __forceinline__ void operator()(const f32x4 (&acc)[2][2][4][2], const pg8::Unit& u, int wr, int wc, int fr, int fq) const {
        const int lane = 16 * fq + fr, wid = wr * 4 + wc;
        LAS unsigned char* scr = lds + LDS_EPI + wid * EPI_WAVEB;
        const int rA = lane >> 3, ch = lane & 7;
        const int rowb = u.pm * 256 + wr * 64 + rA, colb = u.pn * 256 + wc * 32 + 4 * ch;
        u32x2 xa[4], xb[4], xc[4];
#define EPIY_LOAD(dst, g) do { const size_t off_ = (size_t)(rowb + ((g) >> 2) * 128 + ((g) & 3) * 16) * DM + colb; \
        _Pragma("unroll") for (int bj = 0; bj < 2; ++bj) { dst[bj * 2] = __builtin_nontemporal_load((const u32x2*)(xbf + off_ + bj * 128)); dst[bj * 2 + 1] = __builtin_nontemporal_load((const u32x2*)(xbf + off_ + 8 * DM + bj * 128)); } } while (0)
        EPIY_LOAD(xa, 0); EPIY_LOAD(xb, 1);
#pragma unroll
        for (int g = 0; g < 8; ++g) {
            const int ai = g >> 2, m = g & 3;
            if (g + 2 < 8) EPIY_LOAD(xc, g + 2);
            const int r0 = rowb + ai * 128 + m * 16;
            float sA1 = 0.f, sA2 = 0.f, sB1 = 0.f, sB2 = 0.f;
#pragma unroll
            for (int bj = 0; bj < 2; ++bj) {
                *(LAS f32x4*)(scr + fr * EPI_ROWB + fq * 16) = acc[ai][bj][m][0]; *(LAS f32x4*)(scr + fr * EPI_ROWB + 64 + fq * 16) = acc[ai][bj][m][1];
                const f32x4 ta = *(const LAS f32x4*)(scr + rA * EPI_ROWB + ch * 16), tb = *(const LAS f32x4*)(scr + (8 + rA) * EPI_ROWB + ch * 16);
                const u32x2 wa = xa[bj * 2], wb = xa[bj * 2 + 1];
                const f32x4 oa = (f32x4){bflo(wa.x), bfhi(wa.x), bflo(wa.y), bfhi(wa.y)} * DN_ALPHA + ta, ob = (f32x4){bflo(wb.x), bfhi(wb.x), bflo(wb.y), bfhi(wb.y)} * DN_ALPHA + tb;
                *(f32x4*)(y + (size_t)r0 * DM + colb + bj * 128) = oa; *(f32x4*)(y + (size_t)(r0 + 8) * DM + colb + bj * 128) = ob;
                sA1 += (oa[0] + oa[1]) + (oa[2] + oa[3]); sA2 += (oa[0] * oa[0] + oa[1] * oa[1]) + (oa[2] * oa[2] + oa[3] * oa[3]);
                sB1 += (ob[0] + ob[1]) + (ob[2] + ob[3]); sB2 += (ob[0] * ob[0] + ob[1] * ob[1]) + (ob[2] * ob[2] + ob[3] * ob[3]);
            }
#pragma unroll
            for (int o = 1; o < 8; o <<= 1) { sA1 += __shfl_xor(sA1, o); sA2 += __shfl_xor(sA2, o); sB1 += __shfl_xor(sB1, o); sB2 += __shfl_xor(sB2, o); }
            if (ch == 0) { *(f32x2*)(rpart + ((size_t)r0 * 32 + u.pn * 4 + wc) * 2) = (f32x2){sA1, sA2}; *(f32x2*)(rpart + ((size_t)(r0 + 8) * 32 + u.pn * 4 + wc) * 2) = (f32x2){sB1, sB2}; }
#pragma unroll
            for (int i = 0; i < 4; ++i) { xa[i] = xb[i]; xb[i] = xc[i]; }
        }
#undef EPIY_LOAD
    }
};
struct EpiH {
    static constexpr bool RELABEL = false, PERM = true;
    unsigned char* h8; const float* slot_gate;
    __device__ __forceinline__ void operator()(const f32x4 (&acc)[2][2][4][2], const pg8::Unit& u, int wr, int wc, int fr, int fq) const {
        const int s0 = u.pm * 256 + wr * 64 + fr, row0 = u.row0 + s0, col0 = u.pn * 128 + wc * 32 + 8 * fq;
#pragma unroll
        for (int ai = 0; ai < 2; ++ai)
#pragma unroll
            for (int m = 0; m < 4; ++m) {
                const float rg = H8_SCALE;
                f32x4 o[2];
#pragma unroll
                for (int n = 0; n < 2; ++n)
#pragma unroll
                    for (int j = 0; j < 4; ++j) { const float g = acc[ai][0][m][n][j] * (1.f / W8_SCALE), up = acc[ai][1][m][n][j] * (1.f / W8_SCALE);
                        const float e = __builtin_amdgcn_exp2f(-1.4426950408889634f * g); o[n][j] = g * __builtin_amdgcn_rcpf(1.f + e) * (up * rg); }
                u32x2 w; int t = __builtin_amdgcn_cvt_pk_fp8_f32(o[0][0], o[0][1], 0, false); t = __builtin_amdgcn_cvt_pk_fp8_f32(o[0][2], o[0][3], t, true); w.x = (unsigned)t;
                t = __builtin_amdgcn_cvt_pk_fp8_f32(o[1][0], o[1][1], 0, false); t = __builtin_amdgcn_cvt_pk_fp8_f32(o[1][2], o[1][3], t, true); w.y = (unsigned)t;
                *(u32x2*)(h8 + (size_t)(row0 + ai * 128 + m * 16) * DEXP + col0) = w;
            }
    }
};
struct EpiPair {
    static constexpr bool RELABEL = false, PERM = true;
    unsigned char* y8; LAS unsigned char* lds; int dry;
    __device__ __forceinline__ void operator()(const f32x4 (&acc)[2][2][4][2], const pg8::Unit& u, int wr, int wc, int fr, int fq) const {
        const int lane = 16 * fq + fr, wid = wr * 4 + wc;
        LAS unsigned char* scr = lds + LDS_EPI + wid * EPI_WAVEB;
        const size_t row0 = (size_t)u.row0 + u.pm * 256 + wr * 64 + (lane >> 2); const int col0 = u.pn * 256 + wc * 64 + 16 * (lane & 3);
#pragma unroll
        for (int ai = 0; ai < 2; ++ai)
#pragma unroll
            for (int m = 0; m < 4; ++m) {
#pragma unroll
                for (int bj = 0; bj < 2; ++bj) { const f32x4 v0 = acc[ai][bj][m][0] * (Y8_SCALE / (H8_SCALE * W8_SCALE)), v1 = acc[ai][bj][m][1] * (Y8_SCALE / (H8_SCALE * W8_SCALE));
                    u32x2 w; int t = __builtin_amdgcn_cvt_pk_fp8_f32(v0[0], v0[1], 0, false); t = __builtin_amdgcn_cvt_pk_fp8_f32(v0[2], v0[3], t, true); w.x = (unsigned)t;
                    t = __builtin_amdgcn_cvt_pk_fp8_f32(v1[0], v1[1], 0, false); t = __builtin_amdgcn_cvt_pk_fp8_f32(v1[2], v1[3], t, true); w.y = (unsigned)t;
                    *(LAS u32x2*)(scr + fr * 80 + bj * 32 + fq * 8) = w; }
                const u32x4 o = *(const LAS u32x4*)(scr + (lane >> 2) * 80 + (lane & 3) * 16);
                if (dry) { asm volatile("" :: "v"(o)); } else *(u32x4*)(y8 + (row0 + ai * 128 + m * 16) * DM + col0) = o;
            }
    }
};
namespace att {
constexpr float SCALE = 0.08838834764831845f;
constexpr float THR = 8.f;
constexpr int D = 128, NW = 8, QBLK = 32, KVBLK = 64, QB = NW * QBLK;
constexpr int SHM_V = KVBLK * D * 2, SHM_K = KVBLK * D * 2;
constexpr int LDS_BYTES = 2 * SHM_V + 2 * SHM_K + NW * 64 * 4;
#define KSWZ(row, colB) ((row) * 256 + ((colB) ^ (((row) & 7) << 4)))
#define SBAR() __builtin_amdgcn_sched_barrier(0)
__device__ __forceinline__ int v_st(int k, int c) { const int kk = (k & ~0xC) | ((k & 4) << 1) | ((k & 8) >> 1); return ((kk >> 3) * 4 + (c >> 5)) * 512 + ((kk & 7) * 32 + (c & 31)) * 2; }
__device__ __forceinline__ int v_rd_base(int lane) { return ((lane & 3) << 3) | (((lane >> 2) & 3) << 6) | (((lane >> 4) & 1) << 5) | (((lane >> 5) & 1) << 8); }
constexpr int v_rd_off(int d0, int ks, int half) { return d0 * 512 + ks * 4096 + half * 2048; }
__device__ __forceinline__ int crow(int r, int hi) { return (r & 3) + 8 * (r >> 2) + 4 * hi; }
__device__ __forceinline__ unsigned cvtpk(float lo, float hi) { unsigned r; asm volatile("v_cvt_pk_bf16_f32 %0, %1, %2" : "=v"(r) : "v"(lo), "v"(hi)); return r; }
__device__ __forceinline__ bf16x8 load8(const bf16_t* p) { return *reinterpret_cast<const bf16x8*>(p); }
__device__ __forceinline__ void mask_tile(f32x16& p0, f32x16& p1, int dq, unsigned W, unsigned par) {
    const float NEG = -__builtin_inff();
#pragma unroll
    for (int r = 0; r < 16; ++r) {
        const int c = (r & 3) + 8 * (r >> 2);
        const unsigned x0 = (unsigned)(dq - c), x1 = (unsigned)(dq - c - 32);
        if (x0 >= W || (x0 & par)) p0[r] = NEG;
        if (x1 >= W || (x1 & par)) p1[r] = NEG;
    }
}
__device__ __forceinline__ void partialSM(f32x16& p0, f32x16& p1, float& m_reg, float& mn, float& alpha) {
    float pmax = p0[0]; for (int r = 1; r < 16; ++r) pmax = fmaxf(pmax, p0[r]); for (int r = 0; r < 16; ++r) pmax = fmaxf(pmax, p1[r]);
    { auto rr = __builtin_amdgcn_permlane32_swap(__float_as_uint(pmax), __float_as_uint(pmax), false, false);
      pmax = fmaxf(__uint_as_float(rr[0]), __uint_as_float(rr[1])); }
    constexpr float C2 = 1.4426950408889634f * SCALE;
    if (__builtin_expect(__all((pmax - m_reg) * SCALE <= THR), 1)) { mn = m_reg; alpha = 1.f; }
    else { mn = fmaxf(m_reg, pmax); alpha = __builtin_amdgcn_exp2f((m_reg - mn) * C2); m_reg = mn; }
    const float mnL = -mn * C2;
    for (int r = 0; r < 16; ++r) p0[r] = fmaf(p0[r], C2, mnL); for (int r = 0; r < 16; ++r) p1[r] = fmaf(p1[r], C2, mnL);
    for (int r = 0; r < 16; ++r) p0[r] = __builtin_amdgcn_exp2f(p0[r]);
}
__device__ __forceinline__ void finishSM(f32x16& p0, f32x16& p1, float alpha, float& l_reg, bf16x8& pa0, bf16x8& pa1, bf16x8& pa2, bf16x8& pa3) {
    for (int r = 0; r < 16; ++r) p1[r] = __builtin_amdgcn_exp2f(p1[r]);
    float ps = 0; for (int r = 0; r < 16; ++r) ps += p0[r]; for (int r = 0; r < 16; ++r) ps += p1[r];
    { auto rr = __builtin_amdgcn_permlane32_swap(__float_as_uint(ps), __float_as_uint(ps), false, false);
      ps = __uint_as_float(rr[0]) + __uint_as_float(rr[1]); }
    l_reg = l_reg * alpha + ps;
#define PK4(P, B_, OUT) do { unsigned a0 = cvtpk(P[B_+0], P[B_+1]), a1 = cvtpk(P[B_+2], P[B_+3]);                          \
        unsigned b0 = cvtpk(P[B_+4], P[B_+5]), b1 = cvtpk(P[B_+6], P[B_+7]);                                             \
        auto r0 = __builtin_amdgcn_permlane32_swap(a0, b0, false, false); auto r1 = __builtin_amdgcn_permlane32_swap(a1, b1, false, false); \
        u32x4 w = {r0[0], r1[0], r0[1], r1[1]}; OUT = *reinterpret_cast<bf16x8*>(&w); } while (0)
    PK4(p0, 0, pa0); PK4(p0, 8, pa1); PK4(p1, 0, pa2); PK4(p1, 8, pa3);
#undef PK4
}
template <int KB>
__device__ __forceinline__ void qkt(f32x16& p0, f32x16& p1, const char* K_lds, int r32, int hi, const bf16x8* qr, bool act) {
    if (!act) { const float NEG = -__builtin_inff();
#pragma unroll
        for (int r = 0; r < 16; ++r) { p0[r] = NEG; p1[r] = NEG; } return; }
    p0 = f32x16{}; p1 = f32x16{};
    const char* kb[4];
#pragma unroll
    for (int dd = 0; dd < 4; ++dd) kb[dd] = K_lds + KB * SHM_K + KSWZ(r32, (dd * 16 + hi * 8) * 2);
#pragma unroll
    for (int d0 = 0; d0 < 8; ++d0) { const char* a = kb[d0 & 3] + (d0 >> 2) * 128;
        bf16x8 b0 = *reinterpret_cast<const bf16x8*>(a);
        bf16x8 b1 = *reinterpret_cast<const bf16x8*>(a + 32 * 256);
        p0 = __builtin_amdgcn_mfma_f32_32x32x16_bf16(b0, qr[d0], p0, 0, 0, 0);
        p1 = __builtin_amdgcn_mfma_f32_32x32x16_bf16(b1, qr[d0], p1, 0, 0, 0); }
}
template <int VB>
__device__ __forceinline__ void pv_tile(f32x16* o, int vb0, bf16x8 pa0, bf16x8 pa1, bf16x8 pa2, bf16x8 pa3, bool act) {
    if (!act) return;
#define TRRD(dst, off) asm volatile("ds_read_b64_tr_b16 %0, %1 offset:%2" : "=&v"(dst) : "v"(vb0), "i"(off) : "memory")
#define PV_D0(d0) do { s16x4 l0, l1, l2, l3, h0, h1, h2, h3; constexpr int b_ = VB * SHM_V + v_rd_off(d0, 0, 0); \
        TRRD(l0, b_); TRRD(h0, b_ + 2048); TRRD(l1, b_ + 4096); TRRD(h1, b_ + 6144); TRRD(l2, b_ + 8192); TRRD(h2, b_ + 10240); TRRD(l3, b_ + 12288); TRRD(h3, b_ + 14336); \
        asm volatile("s_waitcnt lgkmcnt(0)" ::: "memory"); SBAR(); \
        o[d0] = __builtin_amdgcn_mfma_f32_32x32x16_bf16(pa0, (bf16x8){l0[0], l0[1], l0[2], l0[3], h0[0], h0[1], h0[2], h0[3]}, o[d0], 0, 0, 0);   \
        o[d0] = __builtin_amdgcn_mfma_f32_32x32x16_bf16(pa1, (bf16x8){l1[0], l1[1], l1[2], l1[3], h1[0], h1[1], h1[2], h1[3]}, o[d0], 0, 0, 0);   \
        o[d0] = __builtin_amdgcn_mfma_f32_32x32x16_bf16(pa2, (bf16x8){l2[0], l2[1], l2[2], l2[3], h2[0], h2[1], h2[2], h2[3]}, o[d0], 0, 0, 0);   \
        o[d0] = __builtin_amdgcn_mfma_f32_32x32x16_bf16(pa3, (bf16x8){l3[0], l3[1], l3[2], l3[3], h3[0], h3[1], h3[2], h3[3]}, o[d0], 0, 0, 0); } while (0)
    PV_D0(0); PV_D0(1); PV_D0(2); PV_D0(3);
#undef PV_D0
#undef TRRD
}
struct BlockRef { const bf16_t* H; bf16_t* O; f32x2* ST; int P0, dil, W; };
constexpr size_t KOFF = (size_t)8 * SEQ * 128, VOFF = (size_t)16 * SEQ * 128;
struct Seam { bf16x8 qr[8]; bf16x8 st_v0, st_v1, st_k0, st_k1; };
__device__ __forceinline__ int swa_jlo(int P0, int W) { const int lowk = P0 - W + 1; return lowk > 0 ? lowk / KVBLK : 0; }
#define ROWP(p, rs_, k0, rr) ((p) + (size_t)((k0) + (rr)) * (rs_) + sc)
#define VMW() asm volatile("s_waitcnt vmcnt(0)" ::: "memory")
#define VMWN(n) asm volatile("s_waitcnt vmcnt(%0)" :: "i"(n) : "memory")
#define SLOAD_H(Kp, Vp, rs_, k0) do { S.st_v0 = load8(ROWP(Vp, rs_, k0, sr)); S.st_v1 = load8(ROWP(Vp, rs_, k0, 32 + sr));              \
                         S.st_k0 = load8(ROWP(Kp, rs_, k0, sr)); S.st_k1 = load8(ROWP(Kp, rs_, k0, 32 + sr)); } while (0)
#define SWRITE_HK(bf) do { *(bf16x8*)(K_lds + (bf) * SHM_K + kws) = S.st_k0; *(bf16x8*)(K_lds + (bf) * SHM_K + kws + 32 * 256) = S.st_k1; } while (0)
#define SWRITE_HV(bf) do { *(bf16x8*)(V_lds + (bf) * SHM_V + vst0) = S.st_v0; *(bf16x8*)(V_lds + (bf) * SHM_V + vst1) = S.st_v1; } while (0)
#define SWRITE_H(bf) do { SWRITE_HV(bf); SWRITE_HK(bf); } while (0)
__device__ __forceinline__ void swa_prime(const BlockRef& cur, char* lds, Seam& S) {
    const int tid = threadIdx.x, wid = __builtin_amdgcn_readfirstlane(tid >> 6), lane = tid & 63, r32 = lane & 31, hi = lane >> 5;
    const int sr = tid >> 4, sc = (tid & 15) * 8, kws = KSWZ(sr, sc * 2); char* K_lds = lds + 2 * SHM_V;
    const int kb0 = swa_jlo(cur.P0, cur.W) * KVBLK; const int rs0 = 128 * cur.dil;
    for (int d0 = 0; d0 < 8; ++d0) S.qr[d0] = load8(cur.H + (size_t)(cur.P0 + wid * QBLK + r32) * rs0 + d0 * 16 + hi * 8);
    SLOAD_H(cur.H + KOFF, cur.H + VOFF, rs0, kb0); VMW(); SWRITE_HK(0);
    __syncthreads();
}
__device__ __forceinline__ void swa_block(const BlockRef& cur, const BlockRef& nxt, char* lds, Seam& S) {
    const int tid = threadIdx.x, wid = __builtin_amdgcn_readfirstlane(tid >> 6), lane = tid & 63, r32 = lane & 31, hi = lane >> 5;
    const int W = cur.W; const unsigned par = (W == 256) ? 1u : 0u; const int rs = 128 * cur.dil, ors = 1024 * cur.dil, sst = 8 * cur.dil, skv = SEQ / cur.dil, nrs = 128 * nxt.dil;
    const int j_lo = swa_jlo(cur.P0, W);
    int j_hi = (cur.P0 + QB - 1) / KVBLK + 1; if (j_hi > skv / KVBLK) j_hi = skv / KVBLK;
    const int NT = j_hi - j_lo;
    const int kbn = swa_jlo(nxt.P0, nxt.W) * KVBLK;
    const int qlo = cur.P0 + wid * QBLK, qm = qlo + r32 - 4 * hi;
    char* V_lds = lds; char* K_lds = lds + 2 * SHM_V;
    float* ws = (float*)(lds + 2 * SHM_V + 2 * SHM_K) + wid * 64; float* li_l = ws, * al_l = ws + 32;
    float m_reg = -1e30f, l_reg = 0; f32x16 o[4] = {};
    const int sr = tid >> 4, sc = (tid & 15) * 8, vst0 = v_st(sr, sc), vst1 = v_st(32 + sr, sc), kws = KSWZ(sr, sc * 2);
    const int vb0 = (int)(uintptr_t)V_lds + v_rd_base(lane);
    const bf16_t* Kh = cur.H + KOFF; const bf16_t* Vh = cur.H + VOFF;
#define RESC(a) do { if (__any((a) < 1.f)) { if (hi == 0) al_l[r32] = (a); asm volatile("s_waitcnt lgkmcnt(0)" ::: "memory");              \
                     for (int d_ = 0; d_ < 4; ++d_) for (int r = 0; r < 16; ++r) o[d_][r] *= al_l[crow(r, hi)]; } } while (0)
#define KBASE(t) ((j_lo + (t)) * KVBLK)
#define ACT(t) (KBASE(t) <= qlo + QBLK - 1 && KBASE(t) + KVBLK - 1 >= qlo - W + 1)
#define MASKT(P0_, P1_, t) do { const int kb_ = KBASE(t); if (ACT(t) && (par != 0u || kb_ + KVBLK - 1 > qlo || kb_ <= qlo + QBLK - 1 - W)) mask_tile(P0_, P1_, qm - kb_, (unsigned)W, par); } while (0)
    constexpr int NQL = 8;
#define SEAM_K0() do { VMWN(NQL); SWRITE_HK(0); SBAR(); } while (0)
    f32x16 pA0, pA1, pB0, pB1; float mnA, mnB, alA, alB; bf16x8 pa0, pa1, pa2, pa3;
    SWRITE_HV(0); SBAR();
    if (NT > 1) { SLOAD_H(Kh, Vh, rs, KBASE(1)); }
    SBAR(); qkt<0>(pA0, pA1, K_lds, r32, hi, S.qr, ACT(0));
    MASKT(pA0, pA1, 0); partialSM(pA0, pA1, m_reg, mnA, alA);
    if (NT > 1) { VMW(); SWRITE_H(1); }
    __syncthreads();
#define HALF_STEP(PX0, PX1, mnX, alX, PY0, PY1, alY, t, KB, VB, SB) do {                                                      \
        SBAR(); if ((t) + 1 < NT) { SLOAD_H(Kh, Vh, rs, KBASE((t) + 1)); SBAR(); }     \
        qkt<KB>(PX0, PX1, K_lds, r32, hi, S.qr, ACT(t));                                                                     \
        finishSM(PY0, PY1, alY, l_reg, pa0, pa1, pa2, pa3); SBAR();                                                           \
        pv_tile<VB>(o, vb0, pa0, pa1, pa2, pa3, ACT((t) - 1)); MASKT(PX0, PX1, (t)); partialSM(PX0, PX1, m_reg, mnX, alX);    \
        __syncthreads();                                                                                                      \
        if ((t) + 1 < NT) { VMW(); SWRITE_H(SB); }                                                                            \
        RESC(alX); __syncthreads(); } while (0)
    for (int t = 1; t + 1 < NT; t += 2) {
        HALF_STEP(pB0, pB1, mnB, alB, pA0, pA1, alA, t, 1, 0, 0);
        HALF_STEP(pA0, pA1, mnA, alA, pB0, pB1, alB, t + 1, 0, 1, 1);
    }
    const bool even = (NT & 1) == 0;
    if (even) { SBAR(); qkt<1>(pB0, pB1, K_lds, r32, hi, S.qr, ACT(NT - 1)); SBAR(); }
    SLOAD_H(nxt.H + KOFF, nxt.H + VOFF, nrs, kbn); SBAR();
#pragma unroll
    for (int d0 = 0; d0 < 8; ++d0) S.qr[d0] = load8(nxt.H + (size_t)(nxt.P0 + wid * QBLK + r32) * nrs + d0 * 16 + hi * 8);
    SBAR();
    finishSM(pA0, pA1, alA, l_reg, pa0, pa1, pa2, pa3); SBAR();
    pv_tile<0>(o, vb0, pa0, pa1, pa2, pa3, ACT(even ? NT - 2 : NT - 1));
    if (even) { MASKT(pB0, pB1, NT - 1); partialSM(pB0, pB1, m_reg, mnB, alB); __syncthreads(); RESC(alB);
        finishSM(pB0, pB1, alB, l_reg, pa0, pa1, pa2, pa3); SBAR(); pv_tile<1>(o, vb0, pa0, pa1, pa2, pa3, ACT(NT - 1)); }
    SBAR(); SEAM_K0();
    if (hi == 0) { li_l[r32] = l_reg; cur.ST[(size_t)(wid * QBLK + r32) * sst] = (f32x2){m_reg, l_reg}; }
    asm volatile("s_waitcnt lgkmcnt(0)" ::: "memory");
    float rli[16];
#pragma unroll
    for (int r = 0; r < 16; ++r) rli[r] = __builtin_amdgcn_rcpf(li_l[crow(r, hi)]);
    bf16_t* Ow = cur.O + (size_t)(wid * QBLK) * ors;
#pragma unroll
    for (int r = 0; r < 16; ++r) { const int orow = crow(r, hi);
#pragma unroll
        for (int d0 = 0; d0 < 4; ++d0) { const float v = o[d0][r] * rli[r];
            const float vn = __shfl_xor(v, 1);
            if ((r32 & 1) == 0) *(unsigned*)(Ow + (size_t)orow * ors + d0 * 32 + r32) = cvtpk(v, vn); } }
    __syncthreads();
#undef RESC
#undef KBASE
#undef ACT
#undef MASKT
#undef SEAM_K0
#undef HALF_STEP
}
#undef ROWP
#undef VMW
#undef VMWN
#undef SLOAD_H
#undef SWRITE_HK
#undef SWRITE_HV
#undef SWRITE_H
}


namespace att {
constexpr int RING = 4, R_V = 0, R_K = RING * SHM_V, R_WS = R_K + RING * SHM_K, STREAM_LDS = R_WS + NW * 64 * 4;
struct DmaMap { int krow[2], kcol[2], vrow[2], vcol[2]; };
__device__ __forceinline__ DmaMap dma_map(int wid, int lane) {
    DmaMap m;
#pragma unroll
    for (int j = 0; j < 2; ++j) { const int p = (2 * wid + j) * 64 + lane;
        const int row = p >> 4, cpos = p & 15; m.krow[j] = row; m.kcol[j] = (cpos ^ (row & 7)) * 8;
        const int sub = p >> 5, kk = (sub >> 2) * 8 + ((p & 31) >> 2); m.vrow[j] = (kk & ~0xC) | ((kk & 4) << 1) | ((kk & 8) >> 1); m.vcol[j] = (sub & 3) * 32 + (p & 3) * 8; }
    return m;
}
__device__ __forceinline__ void dma_tile(const bf16_t* H, int rs, int kb0, LAS unsigned char* ldsl, int slot, int wid, const DmaMap& m) {
#pragma unroll
    for (int j = 0; j < 2; ++j) {
        __builtin_amdgcn_global_load_lds((const unsigned*)(H + KOFF + (size_t)(kb0 + m.krow[j]) * rs + m.kcol[j]), (LAS unsigned*)(ldsl + R_K + slot * SHM_K + (2 * wid + j) * 1024), 16, 0, 0);
        __builtin_amdgcn_global_load_lds((const unsigned*)(H + VOFF + (size_t)(kb0 + m.vrow[j]) * rs + m.vcol[j]), (LAS unsigned*)(ldsl + R_V + slot * SHM_V + (2 * wid + j) * 1024), 16, 0, 0); }
}
__device__ __forceinline__ void qkt_s(f32x16& p0, f32x16& p1, const char* Kslot, int r32, int hi, const bf16x8* qr, bool act) {
    if (!act) { const float NEG = -__builtin_inff();
#pragma unroll
        for (int r = 0; r < 16; ++r) { p0[r] = NEG; p1[r] = NEG; } return; }
    p0 = f32x16{}; p1 = f32x16{};
    asm volatile("" : "+v"(r32), "+v"(hi));
    const char* kb[4];
#pragma unroll
    for (int dd = 0; dd < 4; ++dd) kb[dd] = Kslot + KSWZ(r32, (dd * 16 + hi * 8) * 2);
#pragma unroll
    for (int d0 = 0; d0 < 8; ++d0) { const char* a = kb[d0 & 3] + (d0 >> 2) * 128;
        bf16x8 b0 = *reinterpret_cast<const bf16x8*>(a);
        bf16x8 b1 = *reinterpret_cast<const bf16x8*>(a + 32 * 256);
        p0 = __builtin_amdgcn_mfma_f32_32x32x16_bf16(b0, qr[d0], p0, 0, 0, 0);
        p1 = __builtin_amdgcn_mfma_f32_32x32x16_bf16(b1, qr[d0], p1, 0, 0, 0); }
}
__device__ __forceinline__ void pv_s(f32x16* o, int vb, bf16x8 pa0, bf16x8 pa1, bf16x8 pa2, bf16x8 pa3, bool act) {
    if (!act) return;
#define TRRD(dst, off) asm volatile("ds_read_b64_tr_b16 %0, %1 offset:%2" : "=&v"(dst) : "v"(vb), "i"(off) : "memory")
#define PV_D0(d0) do { s16x4 l0, l1, l2, l3, h0, h1, h2, h3; constexpr int b_ = v_rd_off(d0, 0, 0); \
        TRRD(l0, b_); TRRD(h0, b_ + 2048); TRRD(l1, b_ + 4096); TRRD(h1, b_ + 6144); TRRD(l2, b_ + 8192); TRRD(h2, b_ + 10240); TRRD(l3, b_ + 12288); TRRD(h3, b_ + 14336); \
        asm volatile("s_waitcnt lgkmcnt(0)" ::: "memory"); SBAR(); \
        o[d0] = __builtin_amdgcn_mfma_f32_32x32x16_bf16(pa0, (bf16x8){l0[0], l0[1], l0[2], l0[3], h0[0], h0[1], h0[2], h0[3]}, o[d0], 0, 0, 0);   \
        o[d0] = __builtin_amdgcn_mfma_f32_32x32x16_bf16(pa1, (bf16x8){l1[0], l1[1], l1[2], l1[3], h1[0], h1[1], h1[2], h1[3]}, o[d0], 0, 0, 0);   \
        o[d0] = __builtin_amdgcn_mfma_f32_32x32x16_bf16(pa2, (bf16x8){l2[0], l2[1], l2[2], l2[3], h2[0], h2[1], h2[2], h2[3]}, o[d0], 0, 0, 0);   \
        o[d0] = __builtin_amdgcn_mfma_f32_32x32x16_bf16(pa3, (bf16x8){l3[0], l3[1], l3[2], l3[3], h3[0], h3[1], h3[2], h3[3]}, o[d0], 0, 0, 0); } while (0)
    PV_D0(0); PV_D0(1); PV_D0(2); PV_D0(3);
#undef PV_D0
#undef TRRD
}
}

struct Args {
    const float* x; const float* w_in; const float* conv_w; const float* conv_b; const float* w_rg_a; const float* b_rg_a; const float* w_rg_x; const float* b_rg_x;
    const float* lru_lambda; const float* w_out; const float* ln1_g; const float* ln1_b; const float* w_router; const float* router_bias;
    const float* w_gate; const float* w_up; const float* w_down; const float* ws_gate; const float* ws_up; const float* ws_down; const float* ln2_g; const float* ln2_b;
    float* out; unsigned char* ws; int ph_lo, ph_hi, coop, pad;
};

__device__ __forceinline__ unsigned xb_ld(unsigned* p)              { return __hip_atomic_load(p, __ATOMIC_RELAXED, __HIP_MEMORY_SCOPE_AGENT); }
__device__ __forceinline__ unsigned xb_add(unsigned* p, unsigned v) { return __hip_atomic_fetch_add(p, v, __ATOMIC_RELAXED, __HIP_MEMORY_SCOPE_AGENT); }
struct TrItem { const float* src; bf16_t* dst; int ld, ldd, k0, n0, dst_row0; };
__device__ __forceinline__ void tr_load8(const TrItem& it, int lane, f32x4 (&v)[16]) {
    const float* p = it.src + (size_t)(it.k0 + 4 * (lane >> 3)) * it.ld + it.n0 + (lane & 7) * 4;
#pragma unroll
    for (int t = 0; t < 4; ++t)
#pragma unroll
        for (int j = 0; j < 4; ++j) v[4 * t + j] = __builtin_nontemporal_load((const f32x4*)(p + (size_t)(32 * t + j) * it.ld));
}
__device__ __forceinline__ void tr_store8(const TrItem& it, int lane, const f32x4 (&v)[16], LAS float* scr) {
    LAS unsigned char* T = (LAS unsigned char*)scr;
    const int kg = lane >> 3, n4 = (lane & 7) * 4;
#pragma unroll
    for (int t = 0; t < 4; ++t)
#pragma unroll
        for (int nn = 0; nn < 4; ++nn) {
            int w = __builtin_amdgcn_cvt_pk_fp8_f32(v[4 * t + 0][nn] * W8_SCALE, v[4 * t + 1][nn] * W8_SCALE, 0, false);
            w = __builtin_amdgcn_cvt_pk_fp8_f32(v[4 * t + 2][nn] * W8_SCALE, v[4 * t + 3][nn] * W8_SCALE, w, true);
            *(LAS int*)(T + (n4 + nn) * 136 + 32 * t + 4 * kg) = w; }
    LDS_WAIT(); asm volatile("" ::: "memory");
    const int kc = lane & 7;
#pragma unroll
    for (int p = 0; p < 4; ++p) {
        const int n = (lane >> 3) + 8 * p;
        const u32x2 lo = *(const LAS u32x2*)(T + n * 136 + 16 * kc), hi = *(const LAS u32x2*)(T + n * 136 + 16 * kc + 8);
        __builtin_nontemporal_store((u32x4){lo.x, lo.y, hi.x, hi.y}, (u32x4*)((unsigned char*)it.dst + (size_t)(it.dst_row0 + n) * it.ldd + it.k0 + 16 * kc));
    }
    LDS_WAIT(); asm volatile("" ::: "memory");
}
__device__ __forceinline__ void tr_load(const TrItem& it, int lane, f32x4 (&v)[16]) {
    const float* p = it.src + (size_t)(it.k0 + (lane >> 4)) * it.ld + it.n0 + (lane & 15) * 4;
#pragma unroll
    for (int i = 0; i < 16; ++i) v[i] = __builtin_nontemporal_load((const f32x4*)(p + (size_t)(4 * i) * it.ld));
}
__device__ __forceinline__ void tr_store(const TrItem& it, int lane, const f32x4 (&v)[16], LAS float* scr, int mode, size_t lo_off) {
    const int r = lane >> 4, c4 = (lane & 15) * 4;
#pragma unroll
    for (int i = 0; i < 16; ++i)
#pragma unroll
        for (int j = 0; j < 4; ++j) scr[(c4 + j) * 65 + 4 * i + r] = v[i][j];
    LDS_WAIT(); asm volatile("" ::: "memory");
    const int kc = lane & 7;
#pragma unroll
    for (int p = 0; p < 8; ++p) {
        const int n = (lane >> 3) + 8 * p; const LAS float* s = scr + n * 65 + 8 * kc;
        float f[8];
#pragma unroll
        for (int j = 0; j < 8; ++j) f[j] = s[j];
        u32x4 o; o.x = cvt_pk_bf16(f[0], f[1]); o.y = cvt_pk_bf16(f[2], f[3]); o.z = cvt_pk_bf16(f[4], f[5]); o.w = cvt_pk_bf16(f[6], f[7]);
        bf16_t* d = it.dst + (size_t)(it.dst_row0 + n) * it.ldd + it.k0 + 8 * kc;
        *(u32x4*)d = o;
        if (mode == 1) {
            u32x4 l; l.x = cvt_pk_bf16(f[0] - bflo(o.x), f[1] - bfhi(o.x)); l.y = cvt_pk_bf16(f[2] - bflo(o.y), f[3] - bfhi(o.y));
            l.z = cvt_pk_bf16(f[4] - bflo(o.z), f[5] - bfhi(o.z)); l.w = cvt_pk_bf16(f[6] - bflo(o.w), f[7] - bfhi(o.w));
            *(u32x4*)(d + lo_off) = l;
        }
    }
    LDS_WAIT(); asm volatile("" ::: "memory");
}
constexpr int IT_WIN = 32 * 80, IT_WOUT = 32 * 32, IT_GU1 = 32 * 8, IT_GU = NE1 * 2 * IT_GU1, IT_D1 = 8 * 32, IT_D = NE1 * IT_D1, IT_RG = 8 * 2 * 4, IT_RT = 32;
constexpr int IT_TOTAL = IT_WIN + IT_WOUT + IT_GU + IT_D + IT_RG + IT_RT;
__device__ __forceinline__ int tr_decode(const Args& a, int it, TrItem& t) {
    unsigned char* ws = a.ws;
    if (it < IT_WIN) { t.src = a.w_in; t.ld = NPROJ;
        if (it < 1024) { t.k0 = (it / 32) * 64; t.n0 = (it % 32) * 64; t.dst = (bf16_t*)(ws + WS_WIN); t.ldd = DM; t.dst_row0 = t.n0; return 0; }
        const int i2 = it - 1024; t.k0 = (i2 / 96) * 128; t.n0 = 2048 + (i2 % 96) * 32; t.dst = (bf16_t*)(ws + WS_WIN8); t.ldd = DM; t.dst_row0 = t.n0 - 2048; return 2; }
    it -= IT_WIN;
    if (it < IT_WOUT) { t.src = a.w_out; t.ld = DM;
        if (it < 512) { t.k0 = (it / 32) * 64; t.n0 = (it % 32) * 64; t.dst = (bf16_t*)(ws + WS_WOUT); t.ldd = 1024; t.dst_row0 = t.n0; return 0; }
        const int i2 = it - 512; t.k0 = 1024 + (i2 / 64) * 128; t.n0 = (i2 % 64) * 32; t.dst = (bf16_t*)(ws + WS_WOUT + 4 * MiB - 1024); t.ldd = DM; t.dst_row0 = t.n0; return 2; }
    it -= IT_WOUT;
    if (it < IT_GU) { const int e = it / (2 * IT_GU1), r = it % (2 * IT_GU1), up = r / IT_GU1, q = r % IT_GU1;
        const float* src = e < NEXP ? (up ? a.w_up : a.w_gate) + (size_t)e * DM * DEXP : (up ? a.ws_up : a.ws_gate);
        t.src = src; t.ld = DEXP; t.k0 = (q / 16) * 128; t.n0 = (q % 16) * 32; t.dst = (bf16_t*)(ws + WS_WGU + (size_t)e * 1024 * DM); t.ldd = DM;
        t.dst_row0 = (t.n0 >> 7) * 256 + up * 128 + (t.n0 & 127); return 2; }
    it -= IT_GU;
    if (it < IT_D) { const int e = it / IT_D1, q = it % IT_D1;
        t.src = e < NEXP ? a.w_down + (size_t)e * DEXP * DM : a.ws_down; t.ld = DM; t.k0 = (q / 64) * 128; t.n0 = (q % 64) * 32;
        t.dst = (bf16_t*)(ws + WS_WD + (size_t)e * DM * DEXP); t.ldd = DEXP; t.dst_row0 = t.n0; return 2; }
    it -= IT_D;
    if (it < IT_RG) { const int n = it / 8, r = it % 8, mat = r / 4, q = r % 4;
        t.src = (mat ? a.w_rg_x : a.w_rg_a) + (size_t)n * 128 * 128; t.ld = 128; t.k0 = (q / 2) * 64; t.n0 = (q % 2) * 64;
        t.dst = (bf16_t*)(ws + WS_WRG) + (size_t)n * 256 * 128; t.ldd = 128; t.dst_row0 = mat * 128 + t.n0; return 0; }
    it -= IT_RG;
    t.src = a.w_router; t.ld = NEXP; t.k0 = it * 64; t.n0 = 0; t.dst = (bf16_t*)(ws + WS_WR); t.ldd = DM; t.dst_row0 = 0; return 1;
}
#ifndef BG_NC
#define BG_NC 72
#endif
constexpr int CW_DONE = 2304, CW_PROG = 2560, BG_GC = 256 - BG_NC, BG_NS = BG_NC * NWAVES;
constexpr int BG_Q = (1792 + BG_GC - 1) / BG_GC, BG_X = 512 - 2 * BG_GC, BG_F3 = BG_Q - 6;
static_assert(BG_NC % 8 == 0 && CW_PROG + BG_NS <= CW_BAR && BG_X >= 0 && BG_X <= BG_GC && BG_X % 8 == 0 && BG_F3 >= 0 && BG_X * BG_F3 <= 768 && BG_X * BG_F3 + (BG_GC - BG_X) * (BG_Q - 4) >= 768, "background streams / projection split");
template <int MAP, bool STOP> __device__ __forceinline__ int p0_items(const Args& a, LAS unsigned char* lds, int first, int stride, unsigned* done = nullptr, int limit = 1 << 30) {
    const int COUNT = min(limit, MAP == 0 ? IT_WIN + IT_WOUT + IT_RG + IT_RT : IT_GU + IT_D);
    const int lane = threadIdx.x & 63, wave = __builtin_amdgcn_readfirstlane(threadIdx.x >> 6);
    LAS float* scr = (LAS float*)(lds + wave * 16640);
#define P0_MAP(i) (MAP == 0 ? ((i) < IT_WIN + IT_WOUT ? (i) : (i) + IT_GU + IT_D) : (i) + IT_WIN + IT_WOUT)
    int it = first, n = 0; if (it >= COUNT) return 0;
    TrItem cur; int mode = tr_decode(a, P0_MAP(it), cur); f32x4 v[16]; if (MAP == 1 || mode == 2) tr_load8(cur, lane, v); else tr_load(cur, lane, v);
    for (;;) {
        unsigned d = 0u; if (STOP) d = xb_ld(done);
        const int itn = it + stride; const bool more = itn < COUNT;
        TrItem nxt = cur; int moden = mode; f32x4 vn[16];
        if (more) { moden = tr_decode(a, P0_MAP(itn), nxt); if (MAP == 1 || moden == 2) tr_load8(nxt, lane, vn); else tr_load(nxt, lane, vn); }
        if (MAP == 1 || mode == 2) tr_store8(cur, lane, v, scr); else tr_store(cur, lane, v, scr, mode, (size_t)NEXP * DM);
        ++n;
        if (!more) break;
        cur = nxt; mode = moden; it = itn;
#pragma unroll
        for (int i = 0; i < 16; ++i) v[i] = vn[i];
        if (STOP && __builtin_amdgcn_readfirstlane((int)d) != 0) { tr_store8(cur, lane, v, scr); ++n; break; }
    }
#undef P0_MAP
    return n;
}
__device__ __forceinline__ void p0_phase(const Args& a, LAS unsigned char* lds, int vcu, int G, int parts = 7) {
    const int tid = threadIdx.x, lane = tid & 63, wave = __builtin_amdgcn_readfirstlane(tid >> 6);
    unsigned char* ws = a.ws;
    const int gt = vcu * NTHR + tid, NGT = G * NTHR;
    if (parts & 1) { unsigned* ctl = (unsigned*)(ws + WS_CTL);
      for (int i = gt; i < CW_BAR; i += NGT) ctl[i] = (i == CW_CNT + NEXP * CNT_STRIDE) ? (unsigned)NTOK : 0u;
      int* st = (int*)(ws + WS_SLOT) + (size_t)NEXP * CAP;
      for (int i = gt; i < NTOK; i += NGT) { st[i] = i; }
      float* tab = (float*)(ws + WS_TAB);
      for (int i = gt; i < 2048 * 16; i += NGT) { const int pos = i >> 4, j = i & 15;
          const double inv = pow(500000.0, -(double)j / 16.0), ang = (double)pos * inv; tab[i] = (float)cos(ang); tab[32768 + i] = (float)sin(ang); }
      for (int i = gt; i < 1024; i += NGT) { const float lam = a.lru_lambda[i]; tab[65536 + i] = 8.0f * log1pf(expf(-lam)); }
    }
    if (parts & 2) { const f32x4* xs = (const f32x4*)a.x; u32x4* xd = (u32x4*)(ws + WS_XB); u32x2* x8d = (u32x2*)(ws + WS_XIN8);
      constexpr int NCH = NTOK * DM / 8;
      for (int i = gt; i < NCH; i += NGT) { const f32x4 v0 = __builtin_nontemporal_load(xs + 2 * i), v1 = __builtin_nontemporal_load(xs + 2 * i + 1);
          u32x4 o; o.x = cvt_pk_bf16(v0[0], v0[1]); o.y = cvt_pk_bf16(v0[2], v0[3]); o.z = cvt_pk_bf16(v1[0], v1[1]); o.w = cvt_pk_bf16(v1[2], v1[3]); xd[i] = o;
          u32x2 o8; int t8 = __builtin_amdgcn_cvt_pk_fp8_f32(v0[0], v0[1], 0, false); t8 = __builtin_amdgcn_cvt_pk_fp8_f32(v0[2], v0[3], t8, true); o8.x = (unsigned)t8;
          t8 = __builtin_amdgcn_cvt_pk_fp8_f32(v1[0], v1[1], 0, false); t8 = __builtin_amdgcn_cvt_pk_fp8_f32(v1[2], v1[3], t8, true); o8.y = (unsigned)t8; x8d[i] = o8; }
    }
    const int gw = vcu * NWAVES + wave, NGW = G * NWAVES;
    if (parts & 4) {
        p0_items<0, false>(a, lds, gw, NGW);
        if (!(parts & 8)) p0_items<1, false>(a, lds, gw, NGW);
    }
}

constexpr int LRU_XC = 0, LRU_XCP = 272, LRU_AA = 69632, LRU_UU = LRU_AA + 32768, LRU_SA = LRU_UU + 32768, LRU_SH = LRU_SA + 2048, LRU_CARRY = LRU_SH + 2048, LRU_WB = LRU_CARRY + 256;
static_assert(LRU_WB + 64 * LRU_XCP <= LDS_BYTES - 256, "LRU LDS map");
__device__ __forceinline__ void lru_item(const Args& a, char* lds, int item) {
    const int tid = threadIdx.x, lane = tid & 63, wave = __builtin_amdgcn_readfirstlane(tid >> 6), r32 = lane & 31, hi = lane >> 5;
    const int b = item >> 5, n = (item >> 2) & 7, cq = item & 3;
    unsigned char* ws = a.ws;
    const bf16_t* proj = (const bf16_t*)(ws + WS_PROJ);
    const bf16_t* xl = proj + (size_t)(b * NGRP + n) * SEQ * 128;
    const bf16_t* gl = proj + (size_t)(b * NGRP + 8 + n) * SEQ * 128;
    bf16_t* mix = (bf16_t*)(ws + WS_MIX) + (size_t)b * SEQ * 1024 + n * 128 + cq * 32;
    const float* tab = (const float*)(ws + WS_TAB);
    char* XC = lds + LRU_XC; float* AA = (float*)(lds + LRU_AA); float* UU = (float*)(lds + LRU_UU); float* SA = (float*)(lds + LRU_SA); float* SH = (float*)(lds + LRU_SH); float* CARRY = (float*)(lds + LRU_CARRY);
    char* WB = lds + LRU_WB;
    { const bf16_t* wt = (const bf16_t*)(ws + WS_WRG) + (size_t)n * 256 * 128;
#pragma unroll
      for (int i = 0; i < 2; ++i) { const int q = tid + 512 * i, row = q >> 4, c16 = q & 15; const int srow = (row < 32 ? cq * 32 + row : 128 + cq * 32 + (row - 32));
          *(u32x4*)(WB + row * LRU_XCP + c16 * 16) = *(const u32x4*)(wt + (size_t)srow * 128 + c16 * 8); } }
    const int chd = n * 128 + cq * 32 + r32;
    const float ba = a.b_rg_a[chd], bx = a.b_rg_x[chd], sp8 = tab[65536 + chd];
    const int cg8 = tid & 15, tg = tid >> 4;
    float cw[4][8], cb[8];
#pragma unroll
    for (int j = 0; j < 4; ++j)
#pragma unroll
        for (int c = 0; c < 8; ++c) cw[j][c] = a.conv_w[j * 1024 + n * 128 + cg8 * 8 + c];
#pragma unroll
    for (int c = 0; c < 8; ++c) cb[c] = a.conv_b[n * 128 + cg8 * 8 + c];
    if (tid < 32) CARRY[tid] = 0.f;
    const int sd = tid & 31, seg = tid >> 5;
    u32x4 xr[11];
#define LRU_XLOAD(s0_) do { const bf16_t* pb_ = xl + ((s0_) + tg * 8 - 3) * 128 + cg8 * 8; const int sneg_ = 3 - ((s0_) + tg * 8); \
        _Pragma("unroll") for (int i = 0; i < 11; ++i) { xr[i] = *(const u32x4*)(pb_ + i * 128); if (i < 3 && i < sneg_) xr[i] = (u32x4){0u, 0u, 0u, 0u}; } } while (0)
    LRU_XLOAD(0);
    for (int ch = 0; ch < 8; ++ch) {
        const int s0 = ch * 256;
#pragma unroll
        for (int i = 0; i < 8; ++i) { float o[8];
#pragma unroll
            for (int c = 0; c < 8; ++c) o[c] = cb[c];
#pragma unroll
            for (int j = 0; j < 4; ++j) { const u32x4 w = xr[i + j];
                o[0] += cw[j][0] * bflo(w.x); o[1] += cw[j][1] * bfhi(w.x); o[2] += cw[j][2] * bflo(w.y); o[3] += cw[j][3] * bfhi(w.y);
                o[4] += cw[j][4] * bflo(w.z); o[5] += cw[j][5] * bfhi(w.z); o[6] += cw[j][6] * bflo(w.w); o[7] += cw[j][7] * bfhi(w.w); }
            u32x4 w; w.x = cvt_pk_bf16(o[0], o[1]); w.y = cvt_pk_bf16(o[2], o[3]); w.z = cvt_pk_bf16(o[4], o[5]); w.w = cvt_pk_bf16(o[6], o[7]);
            *(u32x4*)(XC + (tg * 8 + i) * LRU_XCP + cg8 * 16) = w; }
        if (ch + 1 < 8) LRU_XLOAD(s0 + 256);
        __syncthreads();
        { f32x16 ga = {}, gx = {};
#pragma unroll
          for (int ks = 0; ks < 8; ++ks) { const bf16x8 af = *(const bf16x8*)(XC + (wave * 32 + r32) * LRU_XCP + (ks * 16 + hi * 8) * 2);
              const bf16x8 Bak = *(const bf16x8*)(WB + r32 * LRU_XCP + (ks * 16 + hi * 8) * 2), Bxk = *(const bf16x8*)(WB + (32 + r32) * LRU_XCP + (ks * 16 + hi * 8) * 2);
              ga = __builtin_amdgcn_mfma_f32_32x32x16_bf16(af, Bak, ga, 0, 0, 0); gx = __builtin_amdgcn_mfma_f32_32x32x16_bf16(af, Bxk, gx, 0, 0, 0); }
#pragma unroll
          for (int r = 0; r < 16; ++r) { const int tok = wave * 32 + att::crow(r, hi);
              const float ra = __builtin_amdgcn_rcpf(1.f + __expf(-(ga[r] + ba))), ix = __builtin_amdgcn_rcpf(1.f + __expf(-(gx[r] + bx)));
              const float la = -ra * sp8, av = __expf(la), x2 = 2.f * la;
              float pz = fmaf(x2, 1.f / 7.f, 1.f); pz = fmaf(x2 * (1.f / 6.f), pz, 1.f); pz = fmaf(x2 * (1.f / 5.f), pz, 1.f); pz = fmaf(x2 * 0.25f, pz, 1.f); pz = fmaf(x2 * (1.f / 3.f), pz, 1.f); pz = fmaf(x2 * 0.5f, pz, 1.f);
              const float mult = sqrtf(-x2 * pz);
              const float xcv = bf2f(*(const unsigned short*)(XC + tok * LRU_XCP + (cq * 32 + r32) * 2));
              AA[tok * 32 + r32] = av; UU[tok * 32 + r32] = mult * ix * xcv; } }
        __syncthreads();
        { float av[16], uv[16]; float Ap = 1.f, Hp = 0.f;
          unsigned short glv[16];
#pragma unroll
          for (int i = 0; i < 16; ++i) glv[i] = gl[(size_t)(s0 + seg * 16 + i) * 128 + cq * 32 + sd];
#pragma unroll
          for (int i = 0; i < 16; ++i) { av[i] = AA[(seg * 16 + i) * 32 + sd]; uv[i] = UU[(seg * 16 + i) * 32 + sd]; Hp = av[i] * Hp + uv[i]; Ap *= av[i]; }
          SA[seg * 32 + sd] = Ap; SH[seg * 32 + sd] = Hp;
          __syncthreads();
          float carry = CARRY[(ch & 1) * 32 + sd];
          for (int s2 = 0; s2 < seg; ++s2) carry = SA[s2 * 32 + sd] * carry + SH[s2 * 32 + sd];
#pragma unroll
          for (int i = 0; i < 16; ++i) { carry = av[i] * carry + uv[i];
              mix[(size_t)(s0 + seg * 16 + i) * 1024 + sd] = (bf16_t)(cvt_pk_bf16(carry * bf2f(glv[i]), 0.f) & 0xffffu); }
          if (seg == 15) CARRY[((ch + 1) & 1) * 32 + sd] = carry; }
    }
    __syncthreads();
}

__device__ __forceinline__ att::BlockRef att_ref(const Args& a, int L) {
    unsigned char* ws = a.ws;
    const int p = L >> 9, q = L & 511, bh = q >> 3, sub = q & 7, b = bh >> 3, h = bh & 7;
    int dil, cls, qb;
    if (p == 0) { dil = 1; cls = 0; qb = sub; } else if (p == 1) { dil = 4; cls = sub >> 1; qb = sub & 1; } else { dil = 8; cls = sub; qb = 0; }
    const bf16_t* proj = (const bf16_t*)(ws + WS_PROJ);
    att::BlockRef r;
    r.H = proj + (size_t)(b * NGRP + 16 + h) * SEQ * 128 + cls * 128;
    r.dil = dil; r.W = (p == 2) ? 256 : 129; r.P0 = qb * 256;
    const size_t tok0 = (size_t)b * SEQ + cls + (size_t)qb * 256 * dil;
    r.O = (bf16_t*)((unsigned char*)a.out + (size_t)p * NTOK * 1024 + tok0 * 1024 + h * 128);
    r.ST = (f32x2*)(ws + WS_ASTAT) + (size_t)p * NTOK * 8 + tok0 * 8 + h;
    return r;
}
__device__ __forceinline__ void att_phase_v1(const Args& a, char* lds, int c, int G) {
    constexpr int TOTAL = 3 * 512;
    int L = c; if (L >= TOTAL) return;
    att::BlockRef cur = att_ref(a, L);
    att::Seam S;
    att::swa_prime(cur, lds, S);
    for (;;) {
        const bool more = L + G < TOTAL;
        const att::BlockRef nxt = more ? att_ref(a, L + G) : cur;
        att::swa_block(cur, nxt, lds, S);
        if (!more) break;
        cur = nxt; L += G;
    }
}
__device__ __forceinline__ void att_phase(const Args& a, char* lds, LAS unsigned char* ldsl, int c, int G) {
    using namespace att;
    constexpr int TOTAL = 3 * 512;
    int L = c; if (L >= TOTAL) return;
    const int tid = threadIdx.x, wid = __builtin_amdgcn_readfirstlane(tid >> 6), lane = tid & 63, r32 = lane & 31, hi = lane >> 5;
    char* V_lds = lds + R_V; char* K_lds = lds + R_K;
    float* wsf = (float*)(lds + R_WS) + wid * 64; float* li_l = wsf, * al_l = wsf + 32;
    const int vb0 = (int)(uintptr_t)V_lds + v_rd_base(lane);
    bf16x8 qr[8];
#define QLOAD(ref) do { _Pragma("unroll") for (int d0 = 0; d0 < 8; ++d0) qr[d0] = load8((ref).H + (size_t)((ref).P0 + wid * QBLK + r32) * (128 * (ref).dil) + d0 * 16 + hi * 8); } while (0)
    const bf16_t* iH; int irs, ikb, irem, iss_L = L, pos_iss = 0; bool iss_ok = true;
#define ISS_SET(ref) do { const int jl_ = swa_jlo((ref).P0, (ref).W); int jh_ = ((ref).P0 + QB - 1) / KVBLK + 1; const int skv_ = SEQ / (ref).dil; if (jh_ > skv_ / KVBLK) jh_ = skv_ / KVBLK; \
        iH = (ref).H; irs = 128 * (ref).dil; ikb = jl_ * KVBLK; irem = jh_ - jl_; } while (0)
#define ISSUE_NEXT() do { if (iss_ok) { { int lo_ = lane; asm volatile("" : "+v"(lo_)); dma_tile(iH, irs, ikb, ldsl, pos_iss & 3, wid, dma_map(wid, lo_)); } ++pos_iss;     ikb += KVBLK; \
        if (--irem == 0) { iss_L += G; if (iss_L < TOTAL) { const BlockRef nr_ = att_ref(a, iss_L); ISS_SET(nr_); } else iss_ok = false; } } } while (0)
    { const BlockRef c0 = att_ref(a, L); ISS_SET(c0); QLOAD(c0); }
    ISSUE_NEXT(); ISSUE_NEXT();
    asm volatile("s_waitcnt vmcnt(4)" ::: "memory");
    __syncthreads();
    int pos = 0;
    for (;;) {
        int W, NT, j_lo, P0c;
        { const BlockRef cr = att_ref(a, L); W = cr.W; P0c = cr.P0; const int skv = SEQ / cr.dil; j_lo = swa_jlo(cr.P0, W);
          int j_hi = (cr.P0 + QB - 1) / KVBLK + 1; if (j_hi > skv / KVBLK) j_hi = skv / KVBLK; NT = j_hi - j_lo; }
        const unsigned par = (W == 256) ? 1u : 0u;
        const int qlo = P0c + wid * QBLK, qm = qlo + r32 - 4 * hi;
        const bool more = L + G < TOTAL;
        float m_reg = -1e30f, l_reg = 0; f32x16 o[4] = {};
        f32x16 pA0, pA1, pB0, pB1; float mnA, mnB, alA, alB; bf16x8 pa0, pa1, pa2, pa3;
#define RESC(a_) do { if (__any((a_) < 1.f)) { if (hi == 0) al_l[r32] = (a_); asm volatile("s_waitcnt lgkmcnt(0)" ::: "memory");              \
                     for (int d_ = 0; d_ < 4; ++d_) for (int r = 0; r < 16; ++r) o[d_][r] *= al_l[crow(r, hi)]; } } while (0)
#define KBASE(t) ((j_lo + (t)) * KVBLK)
#define ACT(t) (KBASE(t) <= qlo + QBLK - 1 && KBASE(t) + KVBLK - 1 >= qlo - W + 1)
#define MASKT(P0_, P1_, t) do { const int kb_ = KBASE(t); if (ACT(t) && (par != 0u || kb_ + KVBLK - 1 > qlo || kb_ <= qlo + QBLK - 1 - W)) mask_tile(P0_, P1_, qm - kb_, (unsigned)W, par); } while (0)
#define STEP(PX0, PX1, mnX, alX, PY0, PY1, alY, t, HAVEPREV, LASTQ) do {                                                                 \
            const bool issued_ = iss_ok; ISSUE_NEXT(); SBAR();                                                                              \
            qkt_s(PX0, PX1, K_lds + (pos & 3) * SHM_K, r32, hi, qr, ACT(t)); SBAR();                                                       \
            const bool qn_ = (LASTQ) && more; if (qn_) { const BlockRef nq_ = att_ref(a, L + G); QLOAD(nq_); SBAR(); }        \
            if (HAVEPREV) { finishSM(PY0, PY1, alY, l_reg, pa0, pa1, pa2, pa3); SBAR();                                                    \
                            pv_s(o, vb0 + ((pos - 1) & 3) * SHM_V, pa0, pa1, pa2, pa3, ACT((t) - 1)); }                                    \
            MASKT(PX0, PX1, (t)); partialSM(PX0, PX1, m_reg, mnX, alX);                                                                    \
            if (issued_) { if (qn_) asm volatile("s_waitcnt vmcnt(12)" ::: "memory"); else asm volatile("s_waitcnt vmcnt(4)" ::: "memory"); } \
            else { if (qn_) asm volatile("s_waitcnt vmcnt(8)" ::: "memory"); else asm volatile("s_waitcnt vmcnt(0)" ::: "memory"); }        \
            __syncthreads();                                                                                                                \
            RESC(alX); ++pos; } while (0)
        for (int t = 0; t < NT; t += 2) {
            STEP(pA0, pA1, mnA, alA, pB0, pB1, alB, t, (t > 0), false);
            STEP(pB0, pB1, mnB, alB, pA0, pA1, alA, t + 1, true, (t + 2 >= NT));
        }
        finishSM(pB0, pB1, alB, l_reg, pa0, pa1, pa2, pa3); SBAR();
        pv_s(o, vb0 + ((pos - 1) & 3) * SHM_V, pa0, pa1, pa2, pa3, ACT(NT - 1));
        int Le = L; asm volatile("" : "+s"(Le));
        const BlockRef ce = att_ref(a, Le); const int ors = 1024 * ce.dil, sst = 8 * ce.dil;
        if (hi == 0) { li_l[r32] = l_reg; ce.ST[(size_t)(wid * QBLK + r32) * sst] = (f32x2){m_reg, l_reg}; }
        asm volatile("s_waitcnt lgkmcnt(0)" ::: "memory");
        float rli[16];
#pragma unroll
        for (int r = 0; r < 16; ++r) rli[r] = __builtin_amdgcn_rcpf(li_l[crow(r, hi)]);
        unsigned char* Ow = (unsigned char*)ce.O + (size_t)(wid * QBLK) * ors;
        char* osc = lds + STREAM_LDS + wid * 1536;
#pragma unroll
        for (int d0 = 0; d0 < 4; ++d0) {
#pragma unroll
            for (int r = 0; r < 16; ++r) *(unsigned char*)(osc + crow(r, hi) * 48 + r32) = (unsigned char)__builtin_amdgcn_cvt_pk_fp8_f32(o[d0][r] * (rli[r] * A8_SCALE), 0.f, 0, false);
            asm volatile("s_waitcnt lgkmcnt(0)" ::: "memory");
            const u32x4 tv = *(const u32x4*)(osc + (lane >> 1) * 48 + (lane & 1) * 16);
            *(u32x4*)(Ow + (size_t)(lane >> 1) * ors + d0 * 32 + (lane & 1) * 16) = tv;
        }
#undef STEP
#undef MASKT
#undef ACT
#undef KBASE
#undef RESC
        if (!more) break;
        L += G;
    }
#undef QLOAD
#undef ISS_SET
#undef ISSUE_NEXT
    asm volatile("s_waitcnt vmcnt(0)" ::: "memory");
    __syncthreads();
}
__device__ __forceinline__ void merge_phase(const Args& a, int vcu, int G) {
    unsigned char* ws = a.ws;
    const int gt = vcu * NTHR + threadIdx.x, NGT = G * NTHR;
    const f32x2* st = (const f32x2*)(ws + WS_ASTAT); const unsigned char* op8 = (const unsigned char*)a.out; unsigned char* att8 = ws + WS_MIX + 32 * MiB;
    constexpr float C2 = 1.4426950408889634f * att::SCALE;
    for (int i = gt; i < NTOK * 8 * 16; i += NGT) {
        const int c = i & 15, th = i >> 4, t = th >> 3, h = th & 7;
        const f32x2 s0 = st[th], s1 = st[(size_t)NTOK * 8 + th], s2 = st[(size_t)2 * NTOK * 8 + th];
        const float mx = fmaxf(s0.x, fmaxf(s1.x, s2.x));
        const float w0 = s0.y * __builtin_amdgcn_exp2f((s0.x - mx) * C2), w1 = s1.y * __builtin_amdgcn_exp2f((s1.x - mx) * C2), w2 = s2.y * __builtin_amdgcn_exp2f((s2.x - mx) * C2);
        const float inv = 1.f / (w0 + w1 + w2);
        const size_t off = (size_t)t * 1024 + h * 128 + c * 8;
        const u32x2 a0 = *(const u32x2*)(op8 + off), a1 = *(const u32x2*)(op8 + (size_t)NTOK * 1024 + off), a2 = *(const u32x2*)(op8 + (size_t)2 * NTOK * 1024 + off);
        u32x2 o;
#define MRG2(f, sel) ({ const f32x2 q0 = __builtin_amdgcn_cvt_pk_f32_fp8((int)a0.f, sel), q1 = __builtin_amdgcn_cvt_pk_f32_fp8((int)a1.f, sel), q2 = __builtin_amdgcn_cvt_pk_f32_fp8((int)a2.f, sel); (f32x2){(w0 * q0.x + w1 * q1.x + w2 * q2.x) * inv, (w0 * q0.y + w1 * q1.y + w2 * q2.y) * inv}; })
        { const f32x2 lo = MRG2(x, false), hi2 = MRG2(x, true); int t0 = __builtin_amdgcn_cvt_pk_fp8_f32(lo.x, lo.y, 0, false); t0 = __builtin_amdgcn_cvt_pk_fp8_f32(hi2.x, hi2.y, t0, true); o.x = (unsigned)t0; }
        { const f32x2 lo = MRG2(y, false), hi2 = MRG2(y, true); int t1 = __builtin_amdgcn_cvt_pk_fp8_f32(lo.x, lo.y, 0, false); t1 = __builtin_amdgcn_cvt_pk_fp8_f32(hi2.x, hi2.y, t1, true); o.y = (unsigned)t1; }
#undef MRG2
        *(u32x2*)(att8 + (size_t)t * DM + h * 128 + c * 8) = o;
    }
}

constexpr int P4_ROWB = 272, P4_AH = 0, P4_AL = 64 * P4_ROWB, P4_WH = 2 * 64 * P4_ROWB, P4_WL = 3 * 64 * P4_ROWB, P4_RED = 4 * 64 * P4_ROWB, P4_STAT = P4_RED + 2 * 64 * 65 * 4, P4_LCNT = P4_STAT + 512, P4_BASE = P4_LCNT + 256, P4_REC = P4_BASE + 256;
__device__ __forceinline__ float grp8_max(float v) { v = fmaxf(v, __shfl_xor(v, 1)); v = fmaxf(v, __shfl_xor(v, 2)); v = fmaxf(v, __shfl_xor(v, 4)); return v; }
__device__ __forceinline__ float wave_max(float v) {
#pragma unroll
    for (int o = 1; o < 64; o <<= 1) v = fmaxf(v, __shfl_xor(v, o));
    return v;
}
__device__ __forceinline__ void p4_phase(const Args& a, char* lds, int vcu, int G) {
    const int tid = threadIdx.x, lane = tid & 63, wave = __builtin_amdgcn_readfirstlane(tid >> 6), r32 = lane & 31, hi = lane >> 5;
    unsigned char* ws = a.ws;
    const float* Y = a.out; bf16_t* X1 = (bf16_t*)(ws + WS_X1); unsigned char* X8 = ws + WS_X8; const float* rpart = (const float*)(ws + WS_RPART);
    const bf16_t* WRh = (const bf16_t*)(ws + WS_WR); const bf16_t* WRl = WRh + (size_t)NEXP * DM;
    float* RED = (float*)(lds + P4_RED); f32x2* STAT = (f32x2*)(lds + P4_STAT);
    unsigned* cnt = (unsigned*)(ws + WS_CTL) + CW_CNT;
    int* slot_tok = (int*)(ws + WS_SLOT); float* slot_gate = (float*)(ws + WS_SLOT + SLOT_ARR); int* TS = (int*)(ws + WS_SLOT + 2 * SLOT_ARR);
    const int mt = wave & 1, nt = (wave >> 1) & 1, kh = wave >> 2;
    const int yc = 4 * (lane & 31), yr0 = 2 * wave + (lane >> 5);
    const int we = tid >> 4, wk8 = (tid & 15) * 8;
    const float bias = a.router_bias[lane];
    for (int tile = vcu; tile < NTOK / 64; tile += G) {
        const int t0 = tile * 64;
        __syncthreads();
        unsigned* LCNT = (unsigned*)(lds + P4_LCNT); unsigned* BASE = (unsigned*)(lds + P4_BASE); u32x4* REC = (u32x4*)(lds + P4_REC);
        if (tid < 64) { LCNT[tid] = 0u; const f32x4* rp = (const f32x4*)(rpart + (size_t)(t0 + tid) * 64); float s1 = 0.f, s2 = 0.f;
#pragma unroll
            for (int i = 0; i < 16; ++i) { const f32x4 v = rp[i]; s1 += v[0] + v[2]; s2 += v[1] + v[3]; }
            const float mean = s1 * (1.f / DM), var = s2 * (1.f / DM) - mean * mean; STAT[tid] = (f32x2){mean, 1.f / sqrtf(var + LN_EPS)}; }
        f32x4 yv[4], gv, bv; u32x4 wh[2], wl[2];
#define P4_LOAD(k0) do { _Pragma("unroll") for (int i = 0; i < 4; ++i) yv[i] = __builtin_nontemporal_load((const f32x4*)(Y + (size_t)(t0 + yr0 + 16 * i) * DM + (k0) + yc)); \
        gv = *(const f32x4*)(a.ln1_g + (k0) + yc); bv = *(const f32x4*)(a.ln1_b + (k0) + yc); \
        _Pragma("unroll") for (int j = 0; j < 2; ++j) { wh[j] = *(const u32x4*)(WRh + (size_t)(we + 32 * j) * DM + (k0) + wk8); wl[j] = *(const u32x4*)(WRl + (size_t)(we + 32 * j) * DM + (k0) + wk8); } } while (0)
        P4_LOAD(0);
        f32x16 acc = {};
        for (int ch = 0; ch < 16; ++ch) {
            const int k0 = ch * 128;
            __syncthreads();
#pragma unroll
            for (int i = 0; i < 4; ++i) { const int row = yr0 + 16 * i; const f32x2 st = STAT[row];
                const f32x4 x = (yv[i] - st.x) * st.y * gv + bv;
                u32x2 hw, lw; hw.x = cvt_pk_bf16(x[0], x[1]); hw.y = cvt_pk_bf16(x[2], x[3]);
                lw.x = cvt_pk_bf16(x[0] - bflo(hw.x), x[1] - bfhi(hw.x)); lw.y = cvt_pk_bf16(x[2] - bflo(hw.y), x[3] - bfhi(hw.y));
                *(u32x2*)(lds + P4_AH + row * P4_ROWB + yc * 2) = hw; *(u32x2*)(lds + P4_AL + row * P4_ROWB + yc * 2) = lw;
                __builtin_nontemporal_store(hw, (u32x2*)(X1 + (size_t)(t0 + row) * DM + k0 + yc));
                { int t8 = __builtin_amdgcn_cvt_pk_fp8_f32(x[0], x[1], 0, false); t8 = __builtin_amdgcn_cvt_pk_fp8_f32(x[2], x[3], t8, true); *(int*)(X8 + (size_t)(t0 + row) * DM + k0 + yc) = t8; } }
#pragma unroll
            for (int j = 0; j < 2; ++j) { *(u32x4*)(lds + P4_WH + (we + 32 * j) * P4_ROWB + wk8 * 2) = wh[j]; *(u32x4*)(lds + P4_WL + (we + 32 * j) * P4_ROWB + wk8 * 2) = wl[j]; }
            __syncthreads();
            if (ch + 1 < 16) P4_LOAD(k0 + 128);
#pragma unroll
            for (int kk = 0; kk < 4; ++kk) { const int ko = ((kh * 4 + kk) * 16 + 8 * hi) * 2;
                const bf16x8 Ah = *(const bf16x8*)(lds + P4_AH + (32 * mt + r32) * P4_ROWB + ko), Al = *(const bf16x8*)(lds + P4_AL + (32 * mt + r32) * P4_ROWB + ko);
                const bf16x8 Bh = *(const bf16x8*)(lds + P4_WH + (32 * nt + r32) * P4_ROWB + ko), Bl = *(const bf16x8*)(lds + P4_WL + (32 * nt + r32) * P4_ROWB + ko);
                acc = __builtin_amdgcn_mfma_f32_32x32x16_bf16(Ah, Bh, acc, 0, 0, 0); acc = __builtin_amdgcn_mfma_f32_32x32x16_bf16(Ah, Bl, acc, 0, 0, 0); acc = __builtin_amdgcn_mfma_f32_32x32x16_bf16(Al, Bh, acc, 0, 0, 0); }
        }
#undef P4_LOAD
#pragma unroll
        for (int r = 0; r < 16; ++r) RED[(kh * 64 + 32 * mt + att::crow(r, hi)) * 65 + 32 * nt + r32] = acc[r];
        __syncthreads();
        const float NEG = -__builtin_inff(); const int grp = lane >> 3;
        for (int rr = 0; rr < 8; ++rr) {
            const int row = 8 * wave + rr;
            const float lg = RED[row * 65 + lane] + RED[(64 + row) * 65 + lane];
            const float sc = __builtin_amdgcn_rcpf(1.f + __expf(-lg)), sel = sc + bias;
            const float m1 = grp8_max(sel);
            const unsigned long long eq = __ballot(sel == m1);
            const int first = __builtin_ctz((unsigned)((eq >> (8 * grp)) & 0xffull));
            const float m2 = grp8_max((lane & 7) == first ? NEG : sel);
            const float gs = m1 + m2;
            int rank = 0;
#pragma unroll
            for (int g = 0; g < 8; ++g) { const float o = __shfl(gs, 8 * g); rank += (o > gs || (o == gs && g < grp)) ? 1 : 0; }
            float msel = rank < 4 ? sel : NEG;
            int myk = -1;
#pragma unroll
            for (int k = 0; k < 8; ++k) { const float mx = wave_max(msel); const unsigned long long b = __ballot(msel == mx); const int win = __builtin_ctzll(b);
                if (lane == win) { myk = k; msel = NEG; } }
            const float gsum = wave_sum(myk >= 0 ? sc : 0.f);
            if (myk >= 0) { const unsigned lpos = atomicAdd(LCNT + lane, 1u);
                REC[row * 8 + myk] = (u32x4){(unsigned)lane, lpos, __float_as_uint(sc * (2.5f / gsum)), 0u}; }
        }
        __syncthreads();
        if (tid < 64) BASE[tid] = atomicAdd(cnt + tid * CNT_STRIDE, LCNT[tid]);
        __syncthreads();
        { const u32x4 rc = REC[tid]; const int e = (int)rc.x; const unsigned pos = BASE[e] + rc.y; const int t = t0 + (tid >> 3);
          slot_tok[(size_t)e * CAP + pos] = t; slot_gate[t * 8 + (tid & 7)] = __uint_as_float(rc.z); TS[t * 8 + (tid & 7)] = e * CAP + (int)pos; }
    }
    __syncthreads();
}

__device__ __forceinline__ void p8_phase(const Args& a, const LAS int* pre, int vcu, int G) {
    const int tid = threadIdx.x, lane = tid & 63, wave = __builtin_amdgcn_readfirstlane(tid >> 6);
    unsigned char* ws = a.ws;
    const unsigned char* Y8 = (const unsigned char*)(ws + WS_BIG); const bf16_t* X1 = (const bf16_t*)(ws + WS_X1); const int* TS = (const int*)(ws + WS_SLOT + 2 * SLOT_ARR); const float* TG = (const float*)(ws + WS_SLOT + SLOT_ARR);
    const int gw = vcu * NWAVES + wave, NGW = G * NWAVES;
    const int ncol = 128 * ((lane >> 3) & 1) + 32 * (lane >> 4) + 4 * (lane & 7);
    const int shared0 = pre[NEXP] * 256;
    for (int row = gw; row < NTOK; row += NGW) {
        u32x2 xr[8]; unsigned yr[NPAIR][8]; float gk[NPAIR];
#pragma unroll
        for (int p = 0; p < NPAIR; ++p) gk[p] = p < 8 ? __uint_as_float(__builtin_amdgcn_readfirstlane(__float_as_uint(TG[row * 8 + p]))) * (1.f / Y8_SCALE) : (1.f / Y8_SCALE);
        { const bf16_t* xp = X1 + (size_t)row * DM + ncol;
#pragma unroll
          for (int k = 0; k < 8; ++k) xr[k] = *(const u32x2*)(xp + 256 * k); }
#pragma unroll
        for (int p = 0; p < NPAIR; ++p) {
            int srow;
            if (p < 8) { const int ts = __builtin_amdgcn_readfirstlane(TS[row * 8 + p]); srow = pre[ts >> 14] * 256 + (ts & (CAP - 1)); } else srow = shared0 + row;
            const unsigned char* yp = Y8 + (size_t)srow * DM + 4 * lane;
#pragma unroll
            for (int k = 0; k < 8; ++k) yr[p][k] = __builtin_nontemporal_load((const unsigned*)(yp + 256 * k)); }
        f32x4 v[8];
#pragma unroll
        for (int k = 0; k < 8; ++k) { f32x4 sacc = (f32x4){0.f, 0.f, 0.f, 0.f};
#pragma unroll
            for (int p = 0; p < NPAIR; ++p) { const f32x2 lo = __builtin_amdgcn_cvt_pk_f32_fp8((int)yr[p][k], false), hi = __builtin_amdgcn_cvt_pk_f32_fp8((int)yr[p][k], true); sacc += (f32x4){lo.x, lo.y, hi.x, hi.y} * gk[p]; }
            v[k] = (f32x4){bflo(xr[k].x), bfhi(xr[k].x), bflo(xr[k].y), bfhi(xr[k].y)} * DN_ALPHA + sacc; }
        float s = 0.f;
#pragma unroll
        for (int k = 0; k < 8; ++k) s += (v[k][0] + v[k][1]) + (v[k][2] + v[k][3]);
        const float mean = wave_sum(s) * (1.f / DM); float q = 0.f;
#pragma unroll
        for (int k = 0; k < 8; ++k) { v[k] = v[k] - mean; q += (v[k][0] * v[k][0] + v[k][1] * v[k][1]) + (v[k][2] * v[k][2] + v[k][3] * v[k][3]); }
        const float rstd = 1.f / sqrtf(wave_sum(q) * (1.f / DM) + LN_EPS);
        float* orow = a.out + (size_t)row * DM + ncol;
        asm volatile("" ::: "memory");
#pragma unroll
        for (int k = 0; k < 8; ++k) { const f32x4 g2 = *(const f32x4*)(a.ln2_g + 256 * k + ncol), b2 = *(const f32x4*)(a.ln2_b + 256 * k + ncol); __builtin_nontemporal_store(v[k] * rstd * g2 + b2, (f32x4*)(orow + 256 * k)); }
    }
}

#define XB_TMO      128
#define XB_XCNT(j)  (256  + 64 * (j))
#define XB_XSUB(j)  (1280 + 64 * (j))
#define XB_XGEN(j)  (2304 + 64 * (j))
#define XB_TOP      3328
#define XB_TOPGEN   3392
#define XCD_BAR_WORDS 3456
#define XB_SPIN_CAP (1u << 22)
__device__ __forceinline__ unsigned xb_xcc_id() { return (unsigned)__builtin_amdgcn_s_getreg((3 << 11) | 20) & 0xFu; }
#define XB_SPIN(cond, bar) do { unsigned _sp = 0; while (cond) { __builtin_amdgcn_s_sleep(1); \
    if ((++_sp & 255u) == 0u) { if (xb_ld(&(bar)[XB_TMO])) break; if (_sp > XB_SPIN_CAP) { atomicAdd(&(bar)[XB_TMO], 1u); break; } } } } while (0)
struct XcdBarrier { unsigned* bar; unsigned x; volatile LAS unsigned* st; };
__device__ __forceinline__ XcdBarrier xcd_barrier_post(unsigned* bar, volatile LAS unsigned* st) {
    XcdBarrier b; b.bar = bar; b.x = xb_xcc_id(); b.st = st;
    if (threadIdx.x == 0) (void)xb_add(&bar[XB_XCNT(b.x)], 1u);
    return b;
}
__device__ __forceinline__ void xcd_barrier_complete(unsigned* bar, unsigned x, unsigned& nloc, unsigned& nx) {
    const unsigned G = gridDim.x;
    unsigned sum, cnt, mine, sp = 0u;
    for (;;) {
        sum = 0u; cnt = 0u; mine = 0u;
#pragma unroll
        for (unsigned j = 0; j < 16; ++j) { const unsigned c = xb_ld(&bar[XB_XCNT(j)]); sum += c; cnt += (c > 0u) ? 1u : 0u; mine = (j == x) ? c : mine; }
        if (sum == G) break;
        __builtin_amdgcn_s_sleep(1);
        if ((++sp & 255u) == 0u) { if (xb_ld(&bar[XB_TMO])) break; if (sp > XB_SPIN_CAP) { atomicAdd(&bar[XB_TMO], 1u); break; } }
    }
    nloc = mine > 0u ? mine : 1u; nx = cnt > 0u ? cnt : 1u;
}
__device__ __forceinline__ void xcd_barrier(const XcdBarrier& b) {
    asm volatile("s_waitcnt vmcnt(0)" ::: "memory");
    __syncthreads();
    if (threadIdx.x == 0) {
        unsigned* bar = b.bar;
        __builtin_amdgcn_s_waitcnt(0);
        unsigned nloc = b.st[0], nx = b.st[1];
        if (nloc == 0u) { xcd_barrier_complete(bar, b.x, nloc, nx); b.st[0] = nloc; b.st[1] = nx; }
        const unsigned old = xb_add(&bar[XB_XSUB(b.x)], 1u);
        const unsigned gen = old / nloc;
        if (old + 1u == (gen + 1u) * nloc) {
            __builtin_amdgcn_fence(__ATOMIC_RELEASE, "agent");
            asm volatile("s_waitcnt vmcnt(0)" ::: "memory");
            const unsigned og = xb_add(&bar[XB_TOP], 1u);
            const unsigned tg = og / nx;
            if (og + 1u == (tg + 1u) * nx) xb_add(&bar[XB_TOPGEN], 1u);
            else XB_SPIN(xb_ld(&bar[XB_TOPGEN]) == tg, bar);
            __builtin_amdgcn_fence(__ATOMIC_ACQUIRE, "agent");
            xb_add(&bar[XB_XGEN(b.x)], 1u);
            asm volatile("s_waitcnt vmcnt(0)" ::: "memory");
        } else {
            XB_SPIN(xb_ld(&bar[XB_XGEN(b.x)]) == gen, bar);
            __builtin_amdgcn_fence(__ATOMIC_ACQUIRE, "agent");
            asm volatile("s_waitcnt vmcnt(0)" ::: "memory");
        }
    }
    __syncthreads();
}

constexpr int N_PHASES = 9;
constexpr int LDS_PRE = 131072;
constexpr int LDS_MISC = LDS_BYTES - 256;
__global__ void __launch_bounds__(NTHR, 2) hymba_fwd(Args args) {
    extern __shared__ __attribute__((aligned(16))) unsigned char lds_raw[];
    LAS unsigned char* lds = (LAS unsigned char*)lds_raw;
    const int G = gridDim.x, bx = blockIdx.x, tid = threadIdx.x;
    const int vcu = (G % 8 == 0) ? (bx % 8) * (G / 8) + bx / 8 : bx;
    unsigned char* ws = args.ws;
    const int lo = args.ph_lo, hi = args.ph_hi;
    const bool part = args.coop && G == 256;
    const bool is_conv = part && bx >= BG_GC;
    const int cidx = bx;
#ifndef PHASE_MASK
#define PHASE_MASK 0x1ff
#endif
#define IN(k) ((((PHASE_MASK) >> (k)) & 1) && lo <= (k) && (k) < hi)
#ifndef REP_MASK
#define REP_MASK 0
#endif
#define REPS(k) for (int rep_ = 0; rep_ < 1 + (((REP_MASK) >> (k)) & 1); ++rep_)
#define REPBAR(k) do { if ((((REP_MASK) >> (k)) & 1) && rep_ == 0 && args.coop) xcd_barrier(bar); } while (0)
#define SEAM(k) do { if (IN(k) && IN((k) + 1)) { xcd_barrier(bar); } } while (0)
    XcdBarrier bar; bar.bar = (unsigned*)(ws + WS_CTL) + CW_BAR; bar.x = 0; bar.st = (volatile LAS unsigned*)(lds + LDS_MISC);
    if (args.coop) {
        if (tid < 2) ((LAS unsigned*)(lds + LDS_MISC))[tid] = 0u;
        __syncthreads();
        bar = xcd_barrier_post((unsigned*)(ws + WS_CTL) + CW_BAR, (volatile LAS unsigned*)(lds + LDS_MISC));
    }
    if (IN(0)) { p0_phase(args, lds, vcu, G, part ? 15 : 7);
#ifdef DUP_P0
        if (args.coop) xcd_barrier(bar);
        p0_phase(args, lds, vcu, G, DUP_P0);
#endif
    }
    SEAM(0);
    if (IN(1)) {
        unsigned* ctl = (unsigned*)(ws + WS_CTL);
        if (is_conv) {
            const int cw = (bx - BG_GC) * NWAVES + __builtin_amdgcn_readfirstlane(tid >> 6);
            const int n = p0_items<1, true>(args, lds, cw, BG_NS, ctl + CW_DONE);
            if ((tid & 63) == 0) ctl[CW_PROG + cw] = (unsigned)n;
        } else {
            int g1 = G, c1 = bx, g2 = G, c2 = bx, b2 = 0, im2 = 1 << 20;
            if (part) { g1 = BG_GC; c1 = cidx; if (cidx < BG_X) { g2 = BG_X; c2 = cidx; b2 = 0; im2 = BG_F3; } else { g2 = BG_GC - BG_X; c2 = cidx - BG_X; b2 = BG_X * BG_F3; } }
            { pg8::DenseOrder S; S.init(NTOK, 2048, DM, g1, c1);
              EpiProj E{(bf16_t*)(ws + WS_PROJ), (const float*)(ws + WS_TAB), lds, 0, 1.f};
              pg8::gemm_phase<EpiProj, pg8::DenseOrder>(lds, (const bf16_t*)(ws + WS_XB), (const bf16_t*)(ws + WS_WIN), DM, S, E); }
            { pg8::DenseOrder S; S.init(NTOK, 3072, DM / 2, g2, c2, b2, im2);
              EpiProj E{(bf16_t*)(ws + WS_PROJ), (const float*)(ws + WS_TAB), lds, 8, 1.f / W8_SCALE};
              pg8::gemm_phase<EpiProj, pg8::DenseOrder, true>(lds, (const bf16_t*)(ws + WS_XIN8), (const bf16_t*)(ws + WS_WIN8), DM / 2, S, E); }
            if (part && cidx < BG_X && tid == 0) (void)xb_add(ctl + CW_DONE, 1u);
        }
    }
    SEAM(1);
    if (IN(2)) {
#ifndef NO_LRU
        for (int item = vcu; item < 256; item += G) lru_item(args, (char*)lds_raw, item);
#endif
#ifdef DUP_LRU
        if (args.coop) xcd_barrier(bar);
        for (int item = vcu; item < 256; item += G) lru_item(args, (char*)lds_raw, item);
#endif
        att_phase(args, (char*)lds_raw, lds, bx, G);
#ifdef DUP_ATT
        if (args.coop) xcd_barrier(bar);
        att_phase(args, (char*)lds_raw, lds, bx, G);
#endif
    }
    SEAM(2);
    if (IN(3)) REPS(3) { merge_phase(args, vcu, G); REPBAR(3); }
    SEAM(3);
    if (IN(4)) {
        pg8::DenseOrder S; S.init(NTOK, DM, 1024, G, bx);
        EpiY E{(const bf16_t*)(ws + WS_XB), args.out, (float*)(ws + WS_RPART), lds};
        pg8::gemm_phase<EpiY, pg8::DenseOrder, false, 16, 8>(lds, (const bf16_t*)(ws + WS_MIX), (const bf16_t*)(ws + WS_WOUT), 1024, S, E, ws + WS_MIX + 32 * MiB, ws + WS_WOUT + 4 * MiB);
    }
    SEAM(4);
    if (IN(5)) { p4_phase(args, (char*)lds_raw, vcu, G);
        if (part) {
            __syncthreads();
            const int gw = vcu * NWAVES + __builtin_amdgcn_readfirstlane(tid >> 6), cw = gw % BG_NS, hs = gw / BG_NS, nh = (256 * NWAVES - cw + BG_NS - 1) / BG_NS;
            const int k0 = (int)((const unsigned*)(ws + WS_CTL))[CW_PROG + cw] + hs;
            (void)p0_items<1, false>(args, lds, k0 * BG_NS + cw, nh * BG_NS, nullptr, IT_GU);
        }
#ifdef DUP_P4
        if (args.coop) { xcd_barrier(bar); if (bx == 0 && tid < NEXP) ((unsigned*)(ws + WS_CTL))[CW_CNT + tid * CNT_STRIDE] = 0u; xcd_barrier(bar); }
        p4_phase(args, (char*)lds_raw, vcu, G);
#endif
    }
    SEAM(5);
    if (IN(6) || IN(7) || IN(8)) {
        LAS int* pre = (LAS int*)(lds + LDS_PRE);
        if (tid == 0) { const unsigned* cnt = (const unsigned*)(ws + WS_CTL) + CW_CNT; int s = 0;
            for (int e = 0; e < NE1; ++e) { pre[e] = s; s += (int)((cnt[e * CNT_STRIDE] + 255u) >> 8); } pre[NE1] = s; }
        __syncthreads();
    }
    if (IN(6)) {
        pg8::GroupOrder<4, true> S{(const LAS int*)(lds + LDS_PRE), (const int*)(ws + WS_CTL) + CW_CNT, (const int*)(ws + WS_SLOT), G, vcu, (size_t)1024 * DM, (size_t)256 * DM, (LAS v4i_t*)(lds + LDS_PRE + 512)}; S.build();
        EpiH E{(unsigned char*)(ws + WS_H), nullptr};
        pg8::gemm_phase<EpiH, pg8::GroupOrder<4, true>, true>(lds, (const bf16_t*)(ws + WS_X8), (const bf16_t*)(ws + WS_WGU), DM / 2, S, E);
        if (part) {
            const int gw = vcu * NWAVES + __builtin_amdgcn_readfirstlane(tid >> 6), cw = gw % BG_NS, hs = gw / BG_NS, nh = (256 * NWAVES - cw + BG_NS - 1) / BG_NS;
            int k0 = (int)((const unsigned*)(ws + WS_CTL))[CW_PROG + cw] + hs;
            const int kd = (IT_GU - cw + BG_NS - 1) / BG_NS;
            if (k0 < kd) k0 += (kd - k0 + nh - 1) / nh * nh;
            (void)p0_items<1, false>(args, lds, k0 * BG_NS + cw, nh * BG_NS);
        }
    }
    SEAM(6);
    if (IN(7)) {
#ifdef STAG7
        { const unsigned long long t0 = __builtin_amdgcn_s_memrealtime(), dl = (unsigned long long)((vcu & 15) * STAG7);
          while (__builtin_amdgcn_s_memrealtime() - t0 < dl) __builtin_amdgcn_s_sleep(8); }
#endif
        pg8::GroupOrder<8, false> S{(const LAS int*)(lds + LDS_PRE), (const int*)(ws + WS_CTL) + CW_CNT, (const int*)(ws + WS_SLOT), G, vcu, (size_t)DM * DEXP, (size_t)256 * DEXP, (LAS v4i_t*)(lds + LDS_PRE + 512)}; S.build();
        EpiPair E{(unsigned char*)(ws + WS_BIG), lds, 0};
#ifdef PRE_P7
        { EpiPair E2{(unsigned char*)(ws + WS_BIG), lds, 1}; pg8::gemm_phase<EpiPair, pg8::GroupOrder<8, false>, true, 0, 0, PRE_P7 - 1>(lds, (const bf16_t*)(ws + WS_H), (const bf16_t*)(ws + WS_WD), DEXP / 2, S, E2); }
        if (args.coop) xcd_barrier(bar);
#endif
        pg8::gemm_phase<EpiPair, pg8::GroupOrder<8, false>, true>(lds, (const bf16_t*)(ws + WS_H), (const bf16_t*)(ws + WS_WD), DEXP / 2, S, E);
#ifdef DUP_P7
        if (args.coop) xcd_barrier(bar);
        pg8::gemm_phase<EpiPair, pg8::GroupOrder<8, false>, true>(lds, (const bf16_t*)(ws + WS_H), (const bf16_t*)(ws + WS_WD), DEXP / 2, S, E);
#endif
    }
    SEAM(7);
    if (IN(8)) { p8_phase(args, (const LAS int*)(lds + LDS_PRE), vcu, G);
#ifdef DUP_P8
        if (args.coop) xcd_barrier(bar);
        p8_phase(args, (const LAS int*)(lds + LDS_PRE), vcu, G);
#endif
    }
#undef IN
#undef SEAM
}

extern "C" void kernel_launch(void* const* d_in, const int* in_sizes, int n_in, void* d_out, int out_size, void* d_ws, size_t ws_size, hipStream_t stream) {
    static int grid = 0;
    if (grid == 0) {
        if (n_in != 22 || out_size != NTOK * DM || ws_size < WS_END) { fprintf(stderr, "kernel_launch: unexpected problem: n_in %d out %d ws %zu (need %zu)\n", n_in, out_size, ws_size, (size_t)WS_END); grid = -1; return; }
        int dev = 0, cus = 0, per_cu = 0;
        (void)hipGetDevice(&dev); (void)hipDeviceGetAttribute(&cus, hipDeviceAttributeMultiprocessorCount, dev);
        if (hipFuncSetAttribute((const void*)hymba_fwd, hipFuncAttributeMaxDynamicSharedMemorySize, LDS_BYTES) != hipSuccess) { fprintf(stderr, "kernel_launch: hipFuncSetAttribute failed\n"); grid = -1; return; }
        if (hipOccupancyMaxActiveBlocksPerMultiprocessor(&per_cu, (const void*)hymba_fwd, NTHR, LDS_BYTES) != hipSuccess || per_cu < 1 || cus < 1) {
            fprintf(stderr, "kernel_launch: the occupancy query admits %d workgroups per CU on %d CUs for %d threads + %d B LDS: the grid barrier needs every workgroup resident; nothing launched\n", per_cu, cus, NTHR, LDS_BYTES); (void)hipGetLastError(); grid = -1; return; }
        (void)hipGetLastError();
        grid = cus;
    }
    if (grid < 0) return;
    Args a{};
    const float** f = (const float**)&a;
    for (int i = 0; i < 22; ++i) f[i] = (const float*)d_in[i];
    a.out = (float*)d_out; a.ws = (unsigned char*)d_ws; a.coop = 0; a.pad = 0;
#ifndef ONE_LAUNCH
    for (int p = 0; p < N_PHASES; ++p) { a.ph_lo = p; a.ph_hi = p + 1; hipLaunchKernelGGL(hymba_fwd, dim3(grid), dim3(NTHR), LDS_BYTES, stream, a); }
#else
    a.ph_lo = 0; a.ph_hi = N_PHASES; a.coop = 1;
    (void)hipMemsetAsync((char*)d_ws + WS_CTL + (size_t)CW_BAR * 4, 0, (size_t)XCD_BAR_WORDS * 4, stream);
    hipLaunchKernelGGL(hymba_fwd, dim3(grid), dim3(NTHR), LDS_BYTES, stream, a);
#endif
}
```

```cpp
#include <hip/hip_runtime.h>
#ifndef MULTI_LAUNCH
#define ONE_LAUNCH 1
#endif
#include <cstdio>
#include <cstdint>

#define LAS __attribute__((address_space(3)))
typedef unsigned short bf16_t;
typedef short bf16x8 __attribute__((ext_vector_type(8)));
typedef short s16x4 __attribute__((ext_vector_type(4)));
typedef float f32x2 __attribute__((ext_vector_type(2)));
typedef float f32x4 __attribute__((ext_vector_type(4)));
typedef float f32x16 __attribute__((ext_vector_type(16)));
typedef unsigned u32x2 __attribute__((ext_vector_type(2)));
typedef unsigned u32x4 __attribute__((ext_vector_type(4)));
typedef int v4i_t __attribute__((ext_vector_type(4)));
typedef int v8i_t __attribute__((ext_vector_type(8)));

constexpr int NB = 8, SEQ = 2048, DM = 2048, NTOK = NB * SEQ;
constexpr int NPROJ = 5120, NGRP = 40;
constexpr int NEXP = 64, NE1 = 65, DEXP = 512, TOPK = 8, NPAIR = 9;
constexpr int CAP = NTOK;
constexpr float DN_ALPHA = 1.189207115002721f;
constexpr float LN_EPS = 1e-5f;
constexpr int NWAVES = 8, NTHR = 512;
constexpr int LDS_BYTES = 163840;
constexpr int LDS_EPI = 131072 + 1024, EPI_ROWB = 144, EPI_WAVEB = 16 * EPI_ROWB;

constexpr size_t MiB = 1u << 20;
constexpr size_t WS_CTL = 0;
constexpr size_t WS_TAB = 1 * MiB;
constexpr size_t WS_WRG = 2 * MiB;
constexpr size_t WS_WR = 3 * MiB;
constexpr size_t WS_SLOT = 4 * MiB;
constexpr size_t SLOT_ARR = (size_t)NE1 * CAP * 4;
constexpr size_t WS_RPART = 17 * MiB;
constexpr size_t WS_ASTAT = 21 * MiB;
constexpr size_t WS_WD = 24 * MiB;
constexpr size_t WS_X1 = 154 * MiB;
constexpr size_t WS_H = 218 * MiB;
constexpr size_t WS_BIG = 380 * MiB;
constexpr size_t WS_WGU = WS_BIG;
constexpr size_t WS_XIN8 = WS_BIG + 168 * MiB;
constexpr size_t WS_WIN8 = WS_BIG + 200 * MiB;
constexpr size_t WS_X8 = WS_BIG + 132 * MiB;
constexpr size_t WS_WIN = WS_BIG + 260 * MiB;
constexpr size_t WS_WOUT = WS_BIG + 280 * MiB;
constexpr size_t WS_XB = WS_BIG + 288 * MiB;
constexpr size_t WS_PROJ = WS_BIG + 352 * MiB;
constexpr size_t WS_MIX = WS_BIG + 512 * MiB;
constexpr size_t WS_END = WS_BIG + 576 * MiB;

constexpr float Y8_SCALE = 32.f, W8_SCALE = 64.f, H8_SCALE = 8.f, A8_SCALE = 16.f;
constexpr int CW_CNT = 64, CNT_STRIDE = 32;
constexpr int CW_BAR = 4096;

__device__ __forceinline__ unsigned cvt_pk_bf16(float lo, float hi) { unsigned r; asm volatile("v_cvt_pk_bf16_f32 %0, %1, %2" : "=v"(r) : "v"(lo), "v"(hi)); return r; }
__device__ __forceinline__ float bf2f(unsigned short b) { return __uint_as_float(((unsigned)b) << 16); }
__device__ __forceinline__ float bflo(unsigned w) { return __uint_as_float(w << 16); }
__device__ __forceinline__ float bfhi(unsigned w) { return __uint_as_float(w & 0xffff0000u); }
__device__ __forceinline__ float wave_sum(float v) {
#pragma unroll
    for (int o = 1; o < 64; o <<= 1) v += __shfl_xor(v, o);
    return v;
}
#define LDS_WAIT() asm volatile("s_waitcnt lgkmcnt(0)" ::: "memory")
#define VM_WAIT() asm volatile("s_waitcnt vmcnt(0)" ::: "memory")

namespace pg8 {
constexpr int BM = 256, BK = 64, HALF = 128, HTB = HALF * BK * 2, STAGE_BYTES = 8 * HTB, NXCD = 8, WGM = 8;
__host__ __device__ __forceinline__ int lds_byte(int r, int c) { const int st = (r >> 4) * 2 + (c >> 5), rr = r & 15, cc = c & 31, ob = rr * 64 + cc * 2; return st * 1024 + (ob ^ (((ob >> 9) & 1) << 5)); }
__host__ __device__ __forceinline__ void stage_rc(int b, int& R, int& C) { const int st = b / 1024, sb = b % 1024, swz = sb ^ (((sb >> 9) & 1) << 5); R = (st >> 1) * 16 + swz / 64; C = (st & 1) * 32 + (swz % 64) / 2; }
__host__ __device__ __forceinline__ int perm32(int rho) { const int n = rho >> 4, i = rho & 15; return 8 * (i >> 2) + 4 * n + (i & 3); }

struct Unit { int pm, pn, e, cnt, row0; };

struct DenseOrder {
    int nM, nN, nwg, G, c, base, imax; size_t bstride;
    __device__ void init(int M, int N, int K, int G_, int c_, int base_ = 0, int imax_ = 1 << 20) { nM = M / BM; nN = N / BM; nwg = nM * nN; G = G_; c = c_; base = base_; imax = imax_; bstride = (size_t)BM * K * 2; }
    __device__ __forceinline__ bool next(int i, Unit& u) const {
        if (i >= imax) return false;
        const long L = (long)base + (long)i * G + c; if (L >= nwg) return false;
        int wgid = (int)L; { const int q = nwg / NXCD, r = nwg % NXCD, xcd = wgid % NXCD, off = wgid / NXCD; wgid = (xcd < r ? xcd * (q + 1) : r * (q + 1) + (xcd - r) * q) + off; }
        const int nig = WGM * nN, gid = wgid / nig, fm = gid * WGM, gsz = (nM - fm) < WGM ? (nM - fm) : WGM;
        u.pm = fm + ((wgid % nig) % gsz); u.pn = (wgid % nig) / gsz; u.e = 0; u.cnt = 0; u.row0 = 0; return true;
    }
    __device__ __forceinline__ int arow(const Unit& u, int r) const { return u.pm * BM + r; }
    __device__ __forceinline__ size_t boff(const Unit& u) const { return (size_t)u.pn * bstride; }
};
template <int NPN, bool GATHER> struct GroupOrder {
    const LAS int* pre; const int* cnt; const int* slot_tok; int G, vcu; size_t estride, pstride;
    LAS v4i_t* list;
    static constexpr int MAXU = 32;
    __device__ __forceinline__ void build() const {
        if (threadIdx.x < MAXU) { const int i = threadIdx.x; const int L = i * G + vcu; const int total = pre[NE1] * NPN; v4i_t r = (v4i_t){-1, 0, 0, 0};
            if (L < total) { const int T = L / NPN, pn = L - T * NPN; int lo = 0, hi = NE1;
                while (hi - lo > 1) { const int mid = (lo + hi) >> 1; if (pre[mid] <= T) lo = mid; else hi = mid; }
                r = (v4i_t){lo, (T - pre[lo]) | (pn << 16), cnt[lo * CNT_STRIDE], pre[lo] * BM}; }
            list[i] = r; }
        __syncthreads();
    }
    __device__ __forceinline__ bool next(int i, Unit& u) const {
        if (i >= MAXU) return false;
        const v4i_t r = list[i]; if (r.x < 0) return false;
        u.e = r.x; u.pm = r.y & 0xffff; u.pn = r.y >> 16; u.cnt = r.z; u.row0 = r.w; return true;
    }
    __device__ __forceinline__ int arow(const Unit& u, int r) const {
        const int s = u.pm * BM + r;
        if (GATHER) { return s < u.cnt ? slot_tok[(size_t)u.e * CAP + s] : 0; }
        else return u.row0 + s;
    }
    __device__ __forceinline__ size_t boff(const Unit& u) const { return (size_t)u.e * estride + (size_t)u.pn * pstride; }
};

template <class Epi, class Sched, bool F8 = false, int MIX1 = 0, int MIX2 = 0, int PROBE = 0>
__device__ __forceinline__ void gemm_phase(LAS unsigned char* lds, const bf16_t* Abase, const bf16_t* Bbase, const int K, const Sched& S, const Epi& E, const void* Abase2 = nullptr, const void* Bbase2 = nullptr) {
    const int tid = threadIdx.x, wid = __builtin_amdgcn_readfirstlane(tid >> 6), lane = tid & 63, wr = wid >> 2, wc = wid & 3, fr = lane & 15, fq = lane >> 4;
    const int nt = MIX1 ? (MIX1 + MIX2) : K / BK;
    constexpr int SCW = MIX1 ? 0x79797979 : 0x7f7f7f7f, SCX = MIX1 ? 0x7b7b7b7b : 0x7f7f7f7f;
    int Rr[2], Cc[2]; unsigned voffB[2];
#pragma unroll
    for (int i = 0; i < 2; ++i) { int R, C; stage_rc(tid * 16 + i * 8192, R, C); Rr[i] = R; Cc[i] = C; int Rb = Epi::PERM ? ((R & ~31) + perm32(R & 31)) : R;
        if constexpr (Epi::RELABEL) Rb = 64 * (R >> 5) + (Epi::PERM ? perm32(R & 31) : (R & 31));
        voffB[i] = (unsigned)(Rb * K + C) * 2u; }
    const size_t kstep = (size_t)(BK * 2);
    const size_t hstep = (size_t)(Epi::RELABEL ? 32 : HALF) * K * 2;
    const unsigned ldsw = (unsigned)wid * 1024u;
    const int aoff = lds_byte(wr * 64 + fr, fq * 8), boff = lds_byte(wc * 32 + fr, fq * 8);
#define PG8_SA(b, h) (((b) * 2 + (h)) * HTB)
#define PG8_SB(b, h) ((4 + (b) * 2 + (h)) * HTB)
#define PG8_STAGE(bufoff, gbase, voff) do { _Pragma("unroll") for (int _i = 0; _i < 2; ++_i) \
        __builtin_amdgcn_global_load_lds((const unsigned*)((const char*)(gbase) + (voff)[_i]), (LAS unsigned*)(lds + (bufoff) + ldsw + _i * 8192), 16, 0, 0); } while (0)
#define PG8_LDA(dst, b, h) do { _Pragma("unroll") for (int m = 0; m < 4; ++m) { const v4i_t lo_ = *(const LAS v4i_t*)(lds + PG8_SA(b, h) + aoff + m * 2048), hi_ = *(const LAS v4i_t*)(lds + PG8_SA(b, h) + aoff + m * 2048 + 1024); \
        dst[m] = __builtin_shufflevector(lo_, hi_, 0, 1, 2, 3, 4, 5, 6, 7); } } while (0)
#define PG8_LDB(dst, b, h) do { _Pragma("unroll") for (int n = 0; n < 2; ++n) { const v4i_t lo_ = *(const LAS v4i_t*)(lds + PG8_SB(b, h) + boff + n * 2048), hi_ = *(const LAS v4i_t*)(lds + PG8_SB(b, h) + boff + n * 2048 + 1024); \
        dst[n] = __builtin_shufflevector(lo_, hi_, 0, 1, 2, 3, 4, 5, 6, 7); } } while (0)
#define PG8_LO(x) __builtin_bit_cast(bf16x8, __builtin_shufflevector(x, x, 0, 1, 2, 3))
#define PG8_HI(x) __builtin_bit_cast(bf16x8, __builtin_shufflevector(x, x, 4, 5, 6, 7))
#define PG8_MMA(ai, bj, At, Bt) do { __builtin_amdgcn_s_setprio(1); _Pragma("unroll") for (int m = 0; m < 4; ++m) _Pragma("unroll") for (int n = 0; n < 2; ++n) { \
        if (f8t) { acc[ai][bj][m][n] = __builtin_amdgcn_mfma_scale_f32_16x16x128_f8f6f4(Bt[n], At[m], acc[ai][bj][m][n], 0, 0, 0, SCW, 0, SCX); } \
        else { acc[ai][bj][m][n] = __builtin_amdgcn_mfma_f32_16x16x32_bf16(PG8_LO(Bt[n]), PG8_LO(At[m]), acc[ai][bj][m][n], 0, 0, 0); \
               acc[ai][bj][m][n] = __builtin_amdgcn_mfma_f32_16x16x32_bf16(PG8_HI(Bt[n]), PG8_HI(At[m]), acc[ai][bj][m][n], 0, 0, 0); } } \
        __builtin_amdgcn_s_setprio(0); } while (0)
#define PG8_WAIT_V(n) asm volatile("s_waitcnt vmcnt(" #n ")" ::: "memory")
#define PG8_WAIT_L(n) asm volatile("s_waitcnt lgkmcnt(" #n ")" ::: "memory")
#define PG8_BAR __builtin_amdgcn_s_barrier()
#define PG8_SCHED __builtin_amdgcn_sched_barrier(0)
#define PG8_AOFFS(u, v0, v1) do { _Pragma("unroll") for (int _i = 0; _i < 2; ++_i) { \
        v0[_i] = (unsigned)(((size_t)S.arow(u, Rr[_i]) * K + Cc[_i]) * 2u); v1[_i] = (unsigned)(((size_t)S.arow(u, HALF + Rr[_i]) * K + Cc[_i]) * 2u); } } while (0)
    Unit cur, nxt; int ui = 0;
    if (!S.next(0, cur)) return;
    f32x4 acc[2][2][4][2];
#pragma unroll
    for (int a = 0; a < 2; ++a)
#pragma unroll
        for (int b = 0; b < 2; ++b)
#pragma unroll
            for (int m = 0; m < 4; ++m)
#pragma unroll
                for (int n = 0; n < 2; ++n) acc[a][b][m][n] = (f32x4){0.f, 0.f, 0.f, 0.f};
    v8i_t At[4], B0[2], B1[2];
    unsigned vA0[2], vA1[2], nA0[2], nA1[2];
    PG8_AOFFS(cur, vA0, vA1);
    bool has_next = S.next(1, nxt);
    if (has_next) { PG8_AOFFS(nxt, nA0, nA1); } else { nA0[0] = vA0[0]; nA0[1] = vA0[1]; nA1[0] = vA1[0]; nA1[1] = vA1[1]; }
    asm volatile("" : "+v"(vA0[0]), "+v"(vA0[1]), "+v"(vA1[0]), "+v"(vA1[1]), "+v"(nA0[0]), "+v"(nA0[1]), "+v"(nA1[0]), "+v"(nA1[1]));
    const char* cA = (const char*)Abase; const char* cB = (const char*)Bbase + S.boff(cur);
    const char* cA2 = (const char*)Abase2; const char* cB2 = MIX1 ? (const char*)Bbase2 + S.boff(cur) : nullptr;
#define PG8_A_AT(tau) ((MIX1 && (tau) >= MIX1) ? cA2 + (size_t)((tau) - MIX1) * kstep : cA + (size_t)(tau) * kstep)
#define PG8_B_AT(tau) ((MIX1 && (tau) >= MIX1) ? cB2 + (size_t)((tau) - MIX1) * kstep : cB + (size_t)(tau) * kstep)
    PG8_STAGE(PG8_SB(0, 0), cB, voffB); PG8_STAGE(PG8_SB(0, 1), cB + hstep, voffB); PG8_STAGE(PG8_SA(0, 0), cA, vA0); PG8_STAGE(PG8_SA(0, 1), cA, vA1);
    if (wr == 1) PG8_BAR;
    PG8_WAIT_V(2); PG8_BAR;
    PG8_STAGE(PG8_SB(1, 0), cB + kstep, voffB); PG8_STAGE(PG8_SA(1, 0), cA + kstep, vA0); PG8_STAGE(PG8_SB(1, 1), cB + hstep + kstep, voffB);
    PG8_WAIT_V(6); PG8_BAR;
    for (;;) {
        const char* nB = has_next ? (const char*)Bbase + S.boff(nxt) : cB;
        const char* nB2 = (MIX1 && has_next) ? (const char*)Bbase2 + S.boff(nxt) : cB2;
#define PG8_KBODY(F8T_) do { \
            constexpr bool f8t = (F8T_); const bool last = (t == nt - 2); \
            const char* a1 = PG8_A_AT(t + 1); \
            const char* b2 = last ? nB : PG8_B_AT(t + 2); \
            const char* a2 = last ? cA : PG8_A_AT(t + 2); \
            const char* a3 = last ? cA + kstep : PG8_A_AT(t + 3); const char* b3 = last ? nB + kstep : PG8_B_AT(t + 3); \
              \
            PG8_LDB(B0, 0, 0); PG8_LDB(B1, 0, 1); PG8_SCHED; PG8_LDA(At, 0, 0); PG8_STAGE(PG8_SA(1, 1), a1, vA1); \
            if (last) { vA0[0] = nA0[0]; vA0[1] = nA0[1]; vA1[0] = nA1[0]; vA1[1] = nA1[1]; } \
            PG8_WAIT_V(8); PG8_WAIT_L(0); PG8_BAR; PG8_SCHED; PG8_MMA(0, 0, At, B0); PG8_MMA(0, 1, At, B1); PG8_SCHED; PG8_BAR; PG8_SCHED; \
              \
            PG8_LDA(At, 0, 1); PG8_STAGE(PG8_SB(0, 0), b2, voffB); PG8_STAGE(PG8_SB(0, 1), b2 + hstep, voffB); PG8_STAGE(PG8_SA(0, 0), a2, vA0); \
            PG8_WAIT_V(8); PG8_WAIT_L(0); PG8_BAR; PG8_SCHED; if constexpr (PROBE == 0) { PG8_MMA(1, 0, At, B0); PG8_MMA(1, 1, At, B1); } PG8_SCHED; PG8_BAR; PG8_SCHED; \
              \
            PG8_LDB(B0, 1, 0); PG8_LDB(B1, 1, 1); PG8_SCHED; PG8_LDA(At, 1, 0); PG8_STAGE(PG8_SA(0, 1), a2, vA1); \
            PG8_WAIT_V(8); PG8_WAIT_L(0); PG8_BAR; PG8_SCHED; PG8_MMA(0, 0, At, B0); PG8_MMA(0, 1, At, B1); PG8_SCHED; PG8_BAR; PG8_SCHED; \
              \
            PG8_LDA(At, 1, 1); PG8_STAGE(PG8_SB(1, 0), b3, voffB); PG8_STAGE(PG8_SB(1, 1), b3 + hstep, voffB); PG8_STAGE(PG8_SA(1, 0), a3, vA0); \
            PG8_WAIT_V(8); PG8_WAIT_L(0); PG8_BAR; PG8_SCHED; if constexpr (PROBE == 0) { PG8_MMA(1, 0, At, B0); PG8_MMA(1, 1, At, B1); } PG8_SCHED; PG8_BAR; PG8_SCHED; \
        } while (0)
        if constexpr (MIX1 > 0) {
            int t = 0;
#pragma unroll 1
            for (; t < MIX1; t += 2) PG8_KBODY(false);
#pragma unroll 1
            for (; t < nt; t += 2) PG8_KBODY(true);
        } else {
#pragma unroll 1
            for (int t = 0; t < nt; t += 2) PG8_KBODY(F8);
        }
#undef PG8_KBODY
        if (wr == 0) PG8_BAR;
        E(acc, cur, wr, wc, fr, fq);
        if (!has_next) break;
#pragma unroll
        for (int a = 0; a < 2; ++a)
#pragma unroll
            for (int b = 0; b < 2; ++b)
#pragma unroll
                for (int m = 0; m < 4; ++m)
#pragma unroll
                    for (int n = 0; n < 2; ++n) acc[a][b][m][n] = (f32x4){0.f, 0.f, 0.f, 0.f};
        cur = nxt; cB = nB; cB2 = nB2; ++ui;
        has_next = S.next(ui + 1, nxt);
        if (has_next) { PG8_AOFFS(nxt, nA0, nA1); }
        asm volatile("" : "+v"(nA0[0]), "+v"(nA0[1]), "+v"(nA1[0]), "+v"(nA1[1]));
        if (wr == 1) PG8_BAR;
    }
    PG8_WAIT_V(0);
    PG8_BAR;
#undef PG8_SA
#undef PG8_SB
#undef PG8_STAGE
#undef PG8_LDA
#undef PG8_LDB
#undef PG8_MMA
#undef PG8_WAIT_V
#undef PG8_WAIT_L
#undef PG8_BAR
#undef PG8_SCHED
#undef PG8_AOFFS
#undef PG8_A_AT
#undef PG8_B_AT
}
}

struct EpiProj {
    static constexpr bool RELABEL = true, PERM = true;
    bf16_t* proj; const float* rope; LAS unsigned char* lds; int pn_off; float scale;
    __device__ __forceinline__ void operator()(const f32x4 (&acc)[2][2][4][2], const pg8::Unit& u, int wr, int wc, int fr, int fq) const {
        const int pnl = u.pn + pn_off, type = pnl >> 2;
        const int lane = 16 * fq + fr, wid = wr * 4 + wc;
        LAS unsigned char* scr = lds + LDS_EPI + wid * EPI_WAVEB;
        const int row0 = u.pm * 256 + wr * 64, b = row0 >> 11;
        const bool rot = (type == 2 || type == 3) && (wc & 1) == 0;
        const float sgn = fq < 2 ? -1.f : 1.f;
        const int g = 2 * pnl + (wc >> 1);
        bf16_t* gbase = proj + ((size_t)(b * NGRP + g) * SEQ) * 128 + 64 * (wc & 1) + 8 * (lane & 7);
#pragma unroll
        for (int ai = 0; ai < 2; ++ai)
#pragma unroll
            for (int m = 0; m < 4; ++m) {
                const int sb = (row0 + ai * 128 + m * 16) & 2047, s = sb + fr;
                u32x4 x[2];
#pragma unroll
                for (int bj = 0; bj < 2; ++bj) {
                    f32x4 v0 = acc[ai][bj][m][0] * scale, v1 = acc[ai][bj][m][1] * scale;
                    if (type == 1) {
#pragma unroll
                        for (int j = 0; j < 4; ++j) {
                            { const float xx = v0[j]; const float e = __builtin_amdgcn_exp2f(-2.302208198f * (xx + 0.044715f * xx * xx * xx)); v0[j] = xx * __builtin_amdgcn_rcpf(1.f + e); }
                            { const float xx = v1[j]; const float e = __builtin_amdgcn_exp2f(-2.302208198f * (xx + 0.044715f * xx * xx * xx)); v1[j] = xx * __builtin_amdgcn_rcpf(1.f + e); }
                        }
                    }
                    if (rot && bj == 0) {
                        const float* cp = rope + s * 16 + 8 * (fq & 1);
                        const f32x4 c0 = *(const f32x4*)cp, c1 = *(const f32x4*)(cp + 4), s0 = *(const f32x4*)(cp + 32768), s1 = *(const f32x4*)(cp + 32768 + 4);
                        f32x4 p0, p1;
#pragma unroll
                        for (int j = 0; j < 4; ++j) { p0[j] = __shfl_xor(v0[j], 32); p1[j] = __shfl_xor(v1[j], 32); }
                        v0 = v0 * c0 + sgn * (p0 * s0); v1 = v1 * c1 + sgn * (p1 * s1);
                    }
                    x[bj].x = cvt_pk_bf16(v0[0], v0[1]); x[bj].y = cvt_pk_bf16(v0[2], v0[3]); x[bj].z = cvt_pk_bf16(v1[0], v1[1]); x[bj].w = cvt_pk_bf16(v1[2], v1[3]);
                }
                *(LAS u32x4*)(scr + fr * EPI_ROWB + fq * 16) = x[0]; *(LAS u32x4*)(scr + fr * EPI_ROWB + 64 + fq * 16) = x[1];
                const u32x4 ta = *(const LAS u32x4*)(scr + (lane >> 3) * EPI_ROWB + (lane & 7) * 16), tb = *(const LAS u32x4*)(scr + (8 + (lane >> 3)) * EPI_ROWB + (lane & 7) * 16);
                *(u32x4*)(gbase + (size_t)(sb + (lane >> 3)) * 128) = ta; *(u32x4*)(gbase + (size_t)(sb + 8 + (lane >> 3)) * 128) = tb;
            }
    }
};
struct EpiY {
    static constexpr bool RELABEL = false, PERM = false;
    const bf16_t* xbf; float* y; float* rpart; LAS unsigned char* lds;
    __device__ __forceinline__ void operator()(const f32x4 (&acc)[2][2][4][2], const pg8::Unit& u, int wr, int wc, int fr, int fq) const {
        const int lane = 16 * fq + fr, wid = wr * 4 + wc;
        LAS unsigned char* scr = lds + LDS_EPI + wid * EPI_WAVEB;
        const int rA = lane >> 3, ch = lane & 7;
        const int rowb = u.pm * 256 + wr * 64 + rA, colb = u.pn * 256 + wc * 32 + 4 * ch;
        u32x2 xa[4], xb[4], xc[4];
#define EPIY_LOAD(dst, g) do { const size_t off_ = (size_t)(rowb + ((g) >> 2) * 128 + ((g) & 3) * 16) * DM + colb; \
        _Pragma("unroll") for (int bj = 0; bj < 2; ++bj) { dst[bj * 2] = __builtin_nontemporal_load((const u32x2*)(xbf + off_ + bj * 128)); dst[bj * 2 + 1] = __builtin_nontemporal_load((const u32x2*)(xbf + off_ + 8 * DM + bj * 128)); } } while (0)
        EPIY_LOAD(xa, 0); EPIY_LOAD(xb, 1);
#pragma unroll
        for (int g = 0; g < 8; ++g) {
            const int ai = g >> 2, m = g & 3;
            if (g + 2 < 8) EPIY_LOAD(xc, g + 2);
            const int r0 = rowb + ai * 128 + m * 16;
            float sA1 = 0.f, sA2 = 0.f, sB1 = 0.f, sB2 = 0.f;
#pragma unroll
            for (int bj = 0; bj < 2; ++bj) {
                *(LAS f32x4*)(scr + fr * EPI_ROWB + fq * 16) = acc[ai][bj][m][0]; *(LAS f32x4*)(scr + fr * EPI_ROWB + 64 + fq * 16) = acc[ai][bj][m][1];
                const f32x4 ta = *(const LAS f32x4*)(scr + rA * EPI_ROWB + ch * 16), tb = *(const LAS f32x4*)(scr + (8 + rA) * EPI_ROWB + ch * 16);
                const u32x2 wa = xa[bj * 2], wb = xa[bj * 2 + 1];
                const f32x4 oa = (f32x4){bflo(wa.x), bfhi(wa.x), bflo(wa.y), bfhi(wa.y)} * DN_ALPHA + ta, ob = (f32x4){bflo(wb.x), bfhi(wb.x), bflo(wb.y), bfhi(wb.y)} * DN_ALPHA + tb;
                *(f32x4*)(y + (size_t)r0 * DM + colb + bj * 128) = oa; *(f32x4*)(y + (size_t)(r0 + 8) * DM + colb + bj * 128) = ob;
                sA1 += (oa[0] + oa[1]) + (oa[2] + oa[3]); sA2 += (oa[0] * oa[0] + oa[1] * oa[1]) + (oa[2] * oa[2] + oa[3] * oa[3]);
                sB1 += (ob[0] + ob[1]) + (ob[2] + ob[3]); sB2 += (ob[0] * ob[0] + ob[1] * ob[1]) + (ob[2] * ob[2] + ob[3] * ob[3]);
            }
#pragma unroll
            for (int o = 1; o < 8; o <<= 1) { sA1 += __shfl_xor(sA1, o); sA2 += __shfl_xor(sA2, o); sB1 += __shfl_xor(sB1, o); sB2 += __shfl_xor(sB2, o); }
            if (ch == 0) { *(f32x2*)(rpart + ((size_t)r0 * 32 + u.pn * 4 + wc) * 2) = (f32x2){sA1, sA2}; *(f32x2*)(rpart + ((size_t)(r0 + 8) * 32 + u.pn * 4 + wc) * 2) = (f32x2){sB1, sB2}; }
#pragma unroll
            for (int i = 0; i < 4; ++i) { xa[i] = xb[i]; xb[i] = xc[i]; }
        }
#undef EPIY_LOAD
    }
};
struct EpiH {
    static constexpr bool RELABEL = false, PERM = true;
    unsigned char* h8; const float* slot_gate;
    __device__ __forceinline__ void operator()(const f32x4 (&acc)[2][2][4][2], const pg8::Unit& u, int wr, int wc, int fr, int fq) const {
        const int s0 = u.pm * 256 + wr * 64 + fr, row0 = u.row0 + s0, col0 = u.pn * 128 + wc * 32 + 8 * fq;
#pragma unroll
        for (int ai = 0; ai < 2; ++ai)
#pragma unroll
            for (int m = 0; m < 4; ++m) {
                const float rg = H8_SCALE;
                f32x4 o[2];
#pragma unroll
                for (int n = 0; n < 2; ++n)
#pragma unroll
                    for (int j = 0; j < 4; ++j) { const float g = acc[ai][0][m][n][j] * (1.f / W8_SCALE), up = acc[ai][1][m][n][j] * (1.f / W8_SCALE);
                        const float e = __builtin_amdgcn_exp2f(-1.4426950408889634f * g); o[n][j] = g * __builtin_amdgcn_rcpf(1.f + e) * (up * rg); }
                u32x2 w; int t = __builtin_amdgcn_cvt_pk_fp8_f32(o[0][0], o[0][1], 0, false); t = __builtin_amdgcn_cvt_pk_fp8_f32(o[0][2], o[0][3], t, true); w.x = (unsigned)t;
                t = __builtin_amdgcn_cvt_pk_fp8_f32(o[1][0], o[1][1], 0, false); t = __builtin_amdgcn_cvt_pk_fp8_f32(o[1][2], o[1][3], t, true); w.y = (unsigned)t;
                *(u32x2*)(h8 + (size_t)(row0 + ai * 128 + m * 16) * DEXP + col0) = w;
            }
    }
};
struct EpiPair {
    static constexpr bool RELABEL = false, PERM = true;
    unsigned char* y8; LAS unsigned char* lds; int dry;
    __device__ __forceinline__ void operator()(const f32x4 (&acc)[2][2][4][2], const pg8::Unit& u, int wr, int wc, int fr, int fq) const {
        const int lane = 16 * fq + fr, wid = wr * 4 + wc;
        LAS unsigned char* scr = lds + LDS_EPI + wid * EPI_WAVEB;
        const size_t row0 = (size_t)u.row0 + u.pm * 256 + wr * 64 + (lane >> 2); const int col0 = u.pn * 256 + wc * 64 + 16 * (lane & 3);
#pragma unroll
        for (int ai = 0; ai < 2; ++ai)
#pragma unroll
            for (int m = 0; m < 4; ++m) {
#pragma unroll
                for (int bj = 0; bj < 2; ++bj) { const f32x4 v0 = acc[ai][bj][m][0] * (Y8_SCALE / (H8_SCALE * W8_SCALE)), v1 = acc[ai][bj][m][1] * (Y8_SCALE / (H8_SCALE * W8_SCALE));
                    u32x2 w; int t = __builtin_amdgcn_cvt_pk_fp8_f32(v0[0], v0[1], 0, false); t = __builtin_amdgcn_cvt_pk_fp8_f32(v0[2], v0[3], t, true); w.x = (unsigned)t;
                    t = __builtin_amdgcn_cvt_pk_fp8_f32(v1[0], v1[1], 0, false); t = __builtin_amdgcn_cvt_pk_fp8_f32(v1[2], v1[3], t, true); w.y = (unsigned)t;
                    *(LAS u32x2*)(scr + fr * 80 + bj * 32 + fq * 8) = w; }
                const u32x4 o = *(const LAS u32x4*)(scr + (lane >> 2) * 80 + (lane & 3) * 16);
                if (dry) { asm volatile("" :: "v"(o)); } else __builtin_nontemporal_store(o, (u32x4*)(y8 + (row0 + ai * 128 + m * 16) * DM + col0));
            }
    }
};
namespace att {
constexpr float SCALE = 0.08838834764831845f;
constexpr float THR = 8.f;
constexpr int D = 128, NW = 8, QBLK = 32, KVBLK = 64, QB = NW * QBLK;
constexpr int SHM_V = KVBLK * D * 2, SHM_K = KVBLK * D * 2;
constexpr int LDS_BYTES = 2 * SHM_V + 2 * SHM_K + NW * 64 * 4;
#define KSWZ(row, colB) ((row) * 256 + ((colB) ^ (((row) & 7) << 4)))
#define SBAR() __builtin_amdgcn_sched_barrier(0)
__device__ __forceinline__ int v_st(int k, int c) { const int kk = (k & ~0xC) | ((k & 4) << 1) | ((k & 8) >> 1); return ((kk >> 3) * 4 + (c >> 5)) * 512 + ((kk & 7) * 32 + (c & 31)) * 2; }
__device__ __forceinline__ int v_rd_base(int lane) { return ((lane & 3) << 3) | (((lane >> 2) & 3) << 6) | (((lane >> 4) & 1) << 5) | (((lane >> 5) & 1) << 8); }
constexpr int v_rd_off(int d0, int ks, int half) { return d0 * 512 + ks * 4096 + half * 2048; }
__device__ __forceinline__ int crow(int r, int hi) { return (r & 3) + 8 * (r >> 2) + 4 * hi; }
__device__ __forceinline__ unsigned cvtpk(float lo, float hi) { unsigned r; asm volatile("v_cvt_pk_bf16_f32 %0, %1, %2" : "=v"(r) : "v"(lo), "v"(hi)); return r; }
__device__ __forceinline__ bf16x8 load8(const bf16_t* p) { return *reinterpret_cast<const bf16x8*>(p); }
__device__ __forceinline__ void mask_tile(f32x16& p0, f32x16& p1, int dq, unsigned W, unsigned par) {
    const float NEG = -__builtin_inff();
#pragma unroll
    for (int r = 0; r < 16; ++r) {
        const int c = (r & 3) + 8 * (r >> 2);
        const unsigned x0 = (unsigned)(dq - c), x1 = (unsigned)(dq - c - 32);
        if (x0 >= W || (x0 & par)) p0[r] = NEG;
        if (x1 >= W || (x1 & par)) p1[r] = NEG;
    }
}
__device__ __forceinline__ void partialSM(f32x16& p0, f32x16& p1, float& m_reg, float& mn, float& alpha) {
    float pmax = p0[0]; for (int r = 1; r < 16; ++r) pmax = fmaxf(pmax, p0[r]); for (int r = 0; r < 16; ++r) pmax = fmaxf(pmax, p1[r]);
    { auto rr = __builtin_amdgcn_permlane32_swap(__float_as_uint(pmax), __float_as_uint(pmax), false, false);
      pmax = fmaxf(__uint_as_float(rr[0]), __uint_as_float(rr[1])); }
    constexpr float C2 = 1.4426950408889634f * SCALE;
    if (__builtin_expect(__all((pmax - m_reg) * SCALE <= THR), 1)) { mn = m_reg; alpha = 1.f; }
    else { mn = fmaxf(m_reg, pmax); alpha = __builtin_amdgcn_exp2f((m_reg - mn) * C2); m_reg = mn; }
    const float mnL = -mn * C2;
    for (int r = 0; r < 16; ++r) p0[r] = fmaf(p0[r], C2, mnL); for (int r = 0; r < 16; ++r) p1[r] = fmaf(p1[r], C2, mnL);
    for (int r = 0; r < 16; ++r) p0[r] = __builtin_amdgcn_exp2f(p0[r]);
}
__device__ __forceinline__ void finishSM(f32x16& p0, f32x16& p1, float alpha, float& l_reg, bf16x8& pa0, bf16x8& pa1, bf16x8& pa2, bf16x8& pa3) {
    for (int r = 0; r < 16; ++r) p1[r] = __builtin_amdgcn_exp2f(p1[r]);
    float ps = 0; for (int r = 0; r < 16; ++r) ps += p0[r]; for (int r = 0; r < 16; ++r) ps += p1[r];
    { auto rr = __builtin_amdgcn_permlane32_swap(__float_as_uint(ps), __float_as_uint(ps), false, false);
      ps = __uint_as_float(rr[0]) + __uint_as_float(rr[1]); }
    l_reg = l_reg * alpha + ps;
#define PK4(P, B_, OUT) do { unsigned a0 = cvtpk(P[B_+0], P[B_+1]), a1 = cvtpk(P[B_+2], P[B_+3]);                          \
        unsigned b0 = cvtpk(P[B_+4], P[B_+5]), b1 = cvtpk(P[B_+6], P[B_+7]);                                             \
        auto r0 = __builtin_amdgcn_permlane32_swap(a0, b0, false, false); auto r1 = __builtin_amdgcn_permlane32_swap(a1, b1, false, false); \
        u32x4 w = {r0[0], r1[0], r0[1], r1[1]}; OUT = *reinterpret_cast<bf16x8*>(&w); } while (0)
    PK4(p0, 0, pa0); PK4(p0, 8, pa1); PK4(p1, 0, pa2); PK4(p1, 8, pa3);
#undef PK4
}
template <int KB>
__device__ __forceinline__ void qkt(f32x16& p0, f32x16& p1, const char* K_lds, int r32, int hi, const bf16x8* qr, bool act) {
    if (!act) { const float NEG = -__builtin_inff();
#pragma unroll
        for (int r = 0; r < 16; ++r) { p0[r] = NEG; p1[r] = NEG; } return; }
    p0 = f32x16{}; p1 = f32x16{};
    const char* kb[4];
#pragma unroll
    for (int dd = 0; dd < 4; ++dd) kb[dd] = K_lds + KB * SHM_K + KSWZ(r32, (dd * 16 + hi * 8) * 2);
#pragma unroll
    for (int d0 = 0; d0 < 8; ++d0) { const char* a = kb[d0 & 3] + (d0 >> 2) * 128;
        bf16x8 b0 = *reinterpret_cast<const bf16x8*>(a);
        bf16x8 b1 = *reinterpret_cast<const bf16x8*>(a + 32 * 256);
        p0 = __builtin_amdgcn_mfma_f32_32x32x16_bf16(b0, qr[d0], p0, 0, 0, 0);
        p1 = __builtin_amdgcn_mfma_f32_32x32x16_bf16(b1, qr[d0], p1, 0, 0, 0); }
}
template <int VB>
__device__ __forceinline__ void pv_tile(f32x16* o, int vb0, bf16x8 pa0, bf16x8 pa1, bf16x8 pa2, bf16x8 pa3, bool act) {
    if (!act) return;
#define TRRD(dst, off) asm volatile("ds_read_b64_tr_b16 %0, %1 offset:%2" : "=&v"(dst) : "v"(vb0), "i"(off) : "memory")
#define PV_D0(d0) do { s16x4 l0, l1, l2, l3, h0, h1, h2, h3; constexpr int b_ = VB * SHM_V + v_rd_off(d0, 0, 0); \
        TRRD(l0, b_); TRRD(h0, b_ + 2048); TRRD(l1, b_ + 4096); TRRD(h1, b_ + 6144); TRRD(l2, b_ + 8192); TRRD(h2, b_ + 10240); TRRD(l3, b_ + 12288); TRRD(h3, b_ + 14336); \
        asm volatile("s_waitcnt lgkmcnt(0)" ::: "memory"); SBAR(); \
        o[d0] = __builtin_amdgcn_mfma_f32_32x32x16_bf16(pa0, (bf16x8){l0[0], l0[1], l0[2], l0[3], h0[0], h0[1], h0[2], h0[3]}, o[d0], 0, 0, 0);   \
        o[d0] = __builtin_amdgcn_mfma_f32_32x32x16_bf16(pa1, (bf16x8){l1[0], l1[1], l1[2], l1[3], h1[0], h1[1], h1[2], h1[3]}, o[d0], 0, 0, 0);   \
        o[d0] = __builtin_amdgcn_mfma_f32_32x32x16_bf16(pa2, (bf16x8){l2[0], l2[1], l2[2], l2[3], h2[0], h2[1], h2[2], h2[3]}, o[d0], 0, 0, 0);   \
        o[d0] = __builtin_amdgcn_mfma_f32_32x32x16_bf16(pa3, (bf16x8){l3[0], l3[1], l3[2], l3[3], h3[0], h3[1], h3[2], h3[3]}, o[d0], 0, 0, 0); } while (0)
    PV_D0(0); PV_D0(1); PV_D0(2); PV_D0(3);
#undef PV_D0
#undef TRRD
}
struct BlockRef { const bf16_t* H; bf16_t* O; f32x2* ST; int P0, dil, W; };
constexpr size_t KOFF = (size_t)8 * SEQ * 128, VOFF = (size_t)16 * SEQ * 128;
struct Seam { bf16x8 qr[8]; bf16x8 st_v0, st_v1, st_k0, st_k1; };
__device__ __forceinline__ int swa_jlo(int P0, int W) { const int lowk = P0 - W + 1; return lowk > 0 ? lowk / KVBLK : 0; }
#define ROWP(p, rs_, k0, rr) ((p) + (size_t)((k0) + (rr)) * (rs_) + sc)
#define VMW() asm volatile("s_waitcnt vmcnt(0)" ::: "memory")
#define VMWN(n) asm volatile("s_waitcnt vmcnt(%0)" :: "i"(n) : "memory")
#define SLOAD_H(Kp, Vp, rs_, k0) do { S.st_v0 = load8(ROWP(Vp, rs_, k0, sr)); S.st_v1 = load8(ROWP(Vp, rs_, k0, 32 + sr));              \
                         S.st_k0 = load8(ROWP(Kp, rs_, k0, sr)); S.st_k1 = load8(ROWP(Kp, rs_, k0, 32 + sr)); } while (0)
#define SWRITE_HK(bf) do { *(bf16x8*)(K_lds + (bf) * SHM_K + kws) = S.st_k0; *(bf16x8*)(K_lds + (bf) * SHM_K + kws + 32 * 256) = S.st_k1; } while (0)
#define SWRITE_HV(bf) do { *(bf16x8*)(V_lds + (bf) * SHM_V + vst0) = S.st_v0; *(bf16x8*)(V_lds + (bf) * SHM_V + vst1) = S.st_v1; } while (0)
#define SWRITE_H(bf) do { SWRITE_HV(bf); SWRITE_HK(bf); } while (0)
__device__ __forceinline__ void swa_prime(const BlockRef& cur, char* lds, Seam& S) {
    const int tid = threadIdx.x, wid = __builtin_amdgcn_readfirstlane(tid >> 6), lane = tid & 63, r32 = lane & 31, hi = lane >> 5;
    const int sr = tid >> 4, sc = (tid & 15) * 8, kws = KSWZ(sr, sc * 2); char* K_lds = lds + 2 * SHM_V;
    const int kb0 = swa_jlo(cur.P0, cur.W) * KVBLK; const int rs0 = 128 * cur.dil;
    for (int d0 = 0; d0 < 8; ++d0) S.qr[d0] = load8(cur.H + (size_t)(cur.P0 + wid * QBLK + r32) * rs0 + d0 * 16 + hi * 8);
    SLOAD_H(cur.H + KOFF, cur.H + VOFF, rs0, kb0); VMW(); SWRITE_HK(0);
    __syncthreads();
}
__device__ __forceinline__ void swa_block(const BlockRef& cur, const BlockRef& nxt, char* lds, Seam& S) {
    const int tid = threadIdx.x, wid = __builtin_amdgcn_readfirstlane(tid >> 6), lane = tid & 63, r32 = lane & 31, hi = lane >> 5;
    const int W = cur.W; const unsigned par = (W == 256) ? 1u : 0u; const int rs = 128 * cur.dil, ors = 1024 * cur.dil, sst = 8 * cur.dil, skv = SEQ / cur.dil, nrs = 128 * nxt.dil;
    const int j_lo = swa_jlo(cur.P0, W);
    int j_hi = (cur.P0 + QB - 1) / KVBLK + 1; if (j_hi > skv / KVBLK) j_hi = skv / KVBLK;
    const int NT = j_hi - j_lo;
    const int kbn = swa_jlo(nxt.P0, nxt.W) * KVBLK;
    const int qlo = cur.P0 + wid * QBLK, qm = qlo + r32 - 4 * hi;
    char* V_lds = lds; char* K_lds = lds + 2 * SHM_V;
    float* ws = (float*)(lds + 2 * SHM_V + 2 * SHM_K) + wid * 64; float* li_l = ws, * al_l = ws + 32;
    float m_reg = -1e30f, l_reg = 0; f32x16 o[4] = {};
    const int sr = tid >> 4, sc = (tid & 15) * 8, vst0 = v_st(sr, sc), vst1 = v_st(32 + sr, sc), kws = KSWZ(sr, sc * 2);
    const int vb0 = (int)(uintptr_t)V_lds + v_rd_base(lane);
    const bf16_t* Kh = cur.H + KOFF; const bf16_t* Vh = cur.H + VOFF;
#define RESC(a) do { if (__any((a) < 1.f)) { if (hi == 0) al_l[r32] = (a); asm volatile("s_waitcnt lgkmcnt(0)" ::: "memory");              \
                     for (int d_ = 0; d_ < 4; ++d_) for (int r = 0; r < 16; ++r) o[d_][r] *= al_l[crow(r, hi)]; } } while (0)
#define KBASE(t) ((j_lo + (t)) * KVBLK)
#define ACT(t) (KBASE(t) <= qlo + QBLK - 1 && KBASE(t) + KVBLK - 1 >= qlo - W + 1)
#define MASKT(P0_, P1_, t) do { const int kb_ = KBASE(t); if (ACT(t) && (par != 0u || kb_ + KVBLK - 1 > qlo || kb_ <= qlo + QBLK - 1 - W)) mask_tile(P0_, P1_, qm - kb_, (unsigned)W, par); } while (0)
    constexpr int NQL = 8;
#define SEAM_K0() do { VMWN(NQL); SWRITE_HK(0); SBAR(); } while (0)
    f32x16 pA0, pA1, pB0, pB1; float mnA, mnB, alA, alB; bf16x8 pa0, pa1, pa2, pa3;
    SWRITE_HV(0); SBAR();
    if (NT > 1) { SLOAD_H(Kh, Vh, rs, KBASE(1)); }
    SBAR(); qkt<0>(pA0, pA1, K_lds, r32, hi, S.qr, ACT(0));
    MASKT(pA0, pA1, 0); partialSM(pA0, pA1, m_reg, mnA, alA);
    if (NT > 1) { VMW(); SWRITE_H(1); }
    __syncthreads();
#define HALF_STEP(PX0, PX1, mnX, alX, PY0, PY1, alY, t, KB, VB, SB) do {                                                      \
        SBAR(); if ((t) + 1 < NT) { SLOAD_H(Kh, Vh, rs, KBASE((t) + 1)); SBAR(); }     \
        qkt<KB>(PX0, PX1, K_lds, r32, hi, S.qr, ACT(t));                                                                     \
        finishSM(PY0, PY1, alY, l_reg, pa0, pa1, pa2, pa3); SBAR();                                                           \
        pv_tile<VB>(o, vb0, pa0, pa1, pa2, pa3, ACT((t) - 1)); MASKT(PX0, PX1, (t)); partialSM(PX0, PX1, m_reg, mnX, alX);    \
        __syncthreads();                                                                                                      \
        if ((t) + 1 < NT) { VMW(); SWRITE_H(SB); }                                                                            \
        RESC(alX); __syncthreads(); } while (0)
    for (int t = 1; t + 1 < NT; t += 2) {
        HALF_STEP(pB0, pB1, mnB, alB, pA0, pA1, alA, t, 1, 0, 0);
        HALF_STEP(pA0, pA1, mnA, alA, pB0, pB1, alB, t + 1, 0, 1, 1);
    }
    const bool even = (NT & 1) == 0;
    if (even) { SBAR(); qkt<1>(pB0, pB1, K_lds, r32, hi, S.qr, ACT(NT - 1)); SBAR(); }
    SLOAD_H(nxt.H + KOFF, nxt.H + VOFF, nrs, kbn); SBAR();
#pragma unroll
    for (int d0 = 0; d0 < 8; ++d0) S.qr[d0] = load8(nxt.H + (size_t)(nxt.P0 + wid * QBLK + r32) * nrs + d0 * 16 + hi * 8);
    SBAR();
    finishSM(pA0, pA1, alA, l_reg, pa0, pa1, pa2, pa3); SBAR();
    pv_tile<0>(o, vb0, pa0, pa1, pa2, pa3, ACT(even ? NT - 2 : NT - 1));
    if (even) { MASKT(pB0, pB1, NT - 1); partialSM(pB0, pB1, m_reg, mnB, alB); __syncthreads(); RESC(alB);
        finishSM(pB0, pB1, alB, l_reg, pa0, pa1, pa2, pa3); SBAR(); pv_tile<1>(o, vb0, pa0, pa1, pa2, pa3, ACT(NT - 1)); }
    SBAR(); SEAM_K0();
    if (hi == 0) { li_l[r32] = l_reg; cur.ST[(size_t)(wid * QBLK + r32) * sst] = (f32x2){m_reg, l_reg}; }
    asm volatile("s_waitcnt lgkmcnt(0)" ::: "memory");
    float rli[16];
#pragma unroll
    for (int r = 0; r < 16; ++r) rli[r] = __builtin_amdgcn_rcpf(li_l[crow(r, hi)]);
    bf16_t* Ow = cur.O + (size_t)(wid * QBLK) * ors;
#pragma unroll
    for (int r = 0; r < 16; ++r) { const int orow = crow(r, hi);
#pragma unroll
        for (int d0 = 0; d0 < 4; ++d0) { const float v = o[d0][r] * rli[r];
            const float vn = __shfl_xor(v, 1);
            if ((r32 & 1) == 0) *(unsigned*)(Ow + (size_t)orow * ors + d0 * 32 + r32) = cvtpk(v, vn); } }
    __syncthreads();
#undef RESC
#undef KBASE
#undef ACT
#undef MASKT
#undef SEAM_K0
#undef HALF_STEP
}
#undef ROWP
#undef VMW
#undef VMWN
#undef SLOAD_H
#undef SWRITE_HK
#undef SWRITE_HV
#undef SWRITE_H
}


namespace att {
constexpr int RING = 4, R_V = 0, R_K = RING * SHM_V, R_WS = R_K + RING * SHM_K, STREAM_LDS = R_WS + NW * 64 * 4;
struct DmaMap { int krow[2], kcol[2], vrow[2], vcol[2]; };
__device__ __forceinline__ DmaMap dma_map(int wid, int lane) {
    DmaMap m;
#pragma unroll
    for (int j = 0; j < 2; ++j) { const int p = (2 * wid + j) * 64 + lane;
        const int row = p >> 4, cpos = p & 15; m.krow[j] = row; m.kcol[j] = (cpos ^ (row & 7)) * 8;
        const int sub = p >> 5, kk = (sub >> 2) * 8 + ((p & 31) >> 2); m.vrow[j] = (kk & ~0xC) | ((kk & 4) << 1) | ((kk & 8) >> 1); m.vcol[j] = (sub & 3) * 32 + (p & 3) * 8; }
    return m;
}
__device__ __forceinline__ void dma_tile(const bf16_t* H, int rs, int kb0, LAS unsigned char* ldsl, int slot, int wid, const DmaMap& m) {
#pragma unroll
    for (int j = 0; j < 2; ++j) {
        __builtin_amdgcn_global_load_lds((const unsigned*)(H + KOFF + (size_t)(kb0 + m.krow[j]) * rs + m.kcol[j]), (LAS unsigned*)(ldsl + R_K + slot * SHM_K + (2 * wid + j) * 1024), 16, 0, 0);
        __builtin_amdgcn_global_load_lds((const unsigned*)(H + VOFF + (size_t)(kb0 + m.vrow[j]) * rs + m.vcol[j]), (LAS unsigned*)(ldsl + R_V + slot * SHM_V + (2 * wid + j) * 1024), 16, 0, 0); }
}
__device__ __forceinline__ void qkt_s(f32x16& p0, f32x16& p1, const char* Kslot, int r32, int hi, const bf16x8* qr, bool act) {
    if (!act) { const float NEG = -__builtin_inff();
#pragma unroll
        for (int r = 0; r < 16; ++r) { p0[r] = NEG; p1[r] = NEG; } return; }
    p0 = f32x16{}; p1 = f32x16{};
    asm volatile("" : "+v"(r32), "+v"(hi));
    const char* kb[4];
#pragma unroll
    for (int dd = 0; dd < 4; ++dd) kb[dd] = Kslot + KSWZ(r32, (dd * 16 + hi * 8) * 2);
#pragma unroll
    for (int d0 = 0; d0 < 8; ++d0) { const char* a = kb[d0 & 3] + (d0 >> 2) * 128;
        bf16x8 b0 = *reinterpret_cast<const bf16x8*>(a);
        bf16x8 b1 = *reinterpret_cast<const bf16x8*>(a + 32 * 256);
        p0 = __builtin_amdgcn_mfma_f32_32x32x16_bf16(b0, qr[d0], p0, 0, 0, 0);
        p1 = __builtin_amdgcn_mfma_f32_32x32x16_bf16(b1, qr[d0], p1, 0, 0, 0); }
}
__device__ __forceinline__ void pv_s(f32x16* o, int vb, bf16x8 pa0, bf16x8 pa1, bf16x8 pa2, bf16x8 pa3, bool act) {
    if (!act) return;
#define TRRD(dst, off) asm volatile("ds_read_b64_tr_b16 %0, %1 offset:%2" : "=&v"(dst) : "v"(vb), "i"(off) : "memory")
#define PV_D0(d0) do { s16x4 l0, l1, l2, l3, h0, h1, h2, h3; constexpr int b_ = v_rd_off(d0, 0, 0); \
        TRRD(l0, b_); TRRD(h0, b_ + 2048); TRRD(l1, b_ + 4096); TRRD(h1, b_ + 6144); TRRD(l2, b_ + 8192); TRRD(h2, b_ + 10240); TRRD(l3, b_ + 12288); TRRD(h3, b_ + 14336); \
        asm volatile("s_waitcnt lgkmcnt(0)" ::: "memory"); SBAR(); \
        o[d0] = __builtin_amdgcn_mfma_f32_32x32x16_bf16(pa0, (bf16x8){l0[0], l0[1], l0[2], l0[3], h0[0], h0[1], h0[2], h0[3]}, o[d0], 0, 0, 0);   \
        o[d0] = __builtin_amdgcn_mfma_f32_32x32x16_bf16(pa1, (bf16x8){l1[0], l1[1], l1[2], l1[3], h1[0], h1[1], h1[2], h1[3]}, o[d0], 0, 0, 0);   \
        o[d0] = __builtin_amdgcn_mfma_f32_32x32x16_bf16(pa2, (bf16x8){l2[0], l2[1], l2[2], l2[3], h2[0], h2[1], h2[2], h2[3]}, o[d0], 0, 0, 0);   \
        o[d0] = __builtin_amdgcn_mfma_f32_32x32x16_bf16(pa3, (bf16x8){l3[0], l3[1], l3[2], l3[3], h3[0], h3[1], h3[2], h3[3]}, o[d0], 0, 0, 0); } while (0)
    PV_D0(0); PV_D0(1); PV_D0(2); PV_D0(3);
#undef PV_D0
#undef TRRD
}
}

struct Args {
    const float* x; const float* w_in; const float* conv_w; const float* conv_b; const float* w_rg_a; const float* b_rg_a; const float* w_rg_x; const float* b_rg_x;
    const float* lru_lambda; const float* w_out; const float* ln1_g; const float* ln1_b; const float* w_router; const float* router_bias;
    const float* w_gate; const float* w_up; const float* w_down; const float* ws_gate; const float* ws_up; const float* ws_down; const float* ln2_g; const float* ln2_b;
    float* out; unsigned char* ws; int ph_lo, ph_hi, coop, pad;
};

__device__ __forceinline__ unsigned xb_ld(unsigned* p)              { return __hip_atomic_load(p, __ATOMIC_RELAXED, __HIP_MEMORY_SCOPE_AGENT); }
__device__ __forceinline__ unsigned xb_add(unsigned* p, unsigned v) { return __hip_atomic_fetch_add(p, v, __ATOMIC_RELAXED, __HIP_MEMORY_SCOPE_AGENT); }
struct TrItem { const float* src; bf16_t* dst; int ld, ldd, k0, n0, dst_row0; };
__device__ __forceinline__ void tr_load8(const TrItem& it, int lane, f32x4 (&v)[16]) {
    const float* p = it.src + (size_t)(it.k0 + 4 * (lane >> 3)) * it.ld + it.n0 + (lane & 7) * 4;
#pragma unroll
    for (int t = 0; t < 4; ++t)
#pragma unroll
        for (int j = 0; j < 4; ++j) v[4 * t + j] = __builtin_nontemporal_load((const f32x4*)(p + (size_t)(32 * t + j) * it.ld));
}
__device__ __forceinline__ void tr_store8(const TrItem& it, int lane, const f32x4 (&v)[16], LAS float* scr) {
    LAS unsigned char* T = (LAS unsigned char*)scr;
    const int kg = lane >> 3, n4 = (lane & 7) * 4;
#pragma unroll
    for (int t = 0; t < 4; ++t)
#pragma unroll
        for (int nn = 0; nn < 4; ++nn) {
            int w = __builtin_amdgcn_cvt_pk_fp8_f32(v[4 * t + 0][nn] * W8_SCALE, v[4 * t + 1][nn] * W8_SCALE, 0, false);
            w = __builtin_amdgcn_cvt_pk_fp8_f32(v[4 * t + 2][nn] * W8_SCALE, v[4 * t + 3][nn] * W8_SCALE, w, true);
            *(LAS int*)(T + (n4 + nn) * 136 + 32 * t + 4 * kg) = w; }
    LDS_WAIT(); asm volatile("" ::: "memory");
    const int kc = lane & 7;
#pragma unroll
    for (int p = 0; p < 4; ++p) {
        const int n = (lane >> 3) + 8 * p;
        const u32x2 lo = *(const LAS u32x2*)(T + n * 136 + 16 * kc), hi = *(const LAS u32x2*)(T + n * 136 + 16 * kc + 8);
        __builtin_nontemporal_store((u32x4){lo.x, lo.y, hi.x, hi.y}, (u32x4*)((unsigned char*)it.dst + (size_t)(it.dst_row0 + n) * it.ldd + it.k0 + 16 * kc));
    }
    LDS_WAIT(); asm volatile("" ::: "memory");
}
__device__ __forceinline__ void tr_load(const TrItem& it, int lane, f32x4 (&v)[16]) {
    const float* p = it.src + (size_t)(it.k0 + (lane >> 4)) * it.ld + it.n0 + (lane & 15) * 4;
#pragma unroll
    for (int i = 0; i < 16; ++i) v[i] = __builtin_nontemporal_load((const f32x4*)(p + (size_t)(4 * i) * it.ld));
}
__device__ __forceinline__ void tr_store(const TrItem& it, int lane, const f32x4 (&v)[16], LAS float* scr, int mode, size_t lo_off) {
    const int r = lane >> 4, c4 = (lane & 15) * 4;
#pragma unroll
    for (int i = 0; i < 16; ++i)
#pragma unroll
        for (int j = 0; j < 4; ++j) scr[(c4 + j) * 65 + 4 * i + r] = v[i][j];
    LDS_WAIT(); asm volatile("" ::: "memory");
    const int kc = lane & 7;
#pragma unroll
    for (int p = 0; p < 8; ++p) {
        const int n = (lane >> 3) + 8 * p; const LAS float* s = scr + n * 65 + 8 * kc;
        float f[8];
#pragma unroll
        for (int j = 0; j < 8; ++j) f[j] = s[j];
        u32x4 o; o.x = cvt_pk_bf16(f[0], f[1]); o.y = cvt_pk_bf16(f[2], f[3]); o.z = cvt_pk_bf16(f[4], f[5]); o.w = cvt_pk_bf16(f[6], f[7]);
        bf16_t* d = it.dst + (size_t)(it.dst_row0 + n) * it.ldd + it.k0 + 8 * kc;
        *(u32x4*)d = o;
        if (mode == 1) {
            u32x4 l; l.x = cvt_pk_bf16(f[0] - bflo(o.x), f[1] - bfhi(o.x)); l.y = cvt_pk_bf16(f[2] - bflo(o.y), f[3] - bfhi(o.y));
            l.z = cvt_pk_bf16(f[4] - bflo(o.z), f[5] - bfhi(o.z)); l.w = cvt_pk_bf16(f[6] - bflo(o.w), f[7] - bfhi(o.w));
            *(u32x4*)(d + lo_off) = l;
        }
    }
    LDS_WAIT(); asm volatile("" ::: "memory");
}
constexpr int IT_WIN = 32 * 80, IT_WOUT = 32 * 32, IT_GU1 = 32 * 8, IT_GU = NE1 * 2 * IT_GU1, IT_D1 = 8 * 32, IT_D = NE1 * IT_D1, IT_RG = 8 * 2 * 4, IT_RT = 32;
constexpr int IT_TOTAL = IT_WIN + IT_WOUT + IT_GU + IT_D + IT_RG + IT_RT;
__device__ __forceinline__ int tr_decode(const Args& a, int it, TrItem& t) {
    unsigned char* ws = a.ws;
    if (it < IT_WIN) { t.src = a.w_in; t.ld = NPROJ;
        if (it < 1024) { t.k0 = (it / 32) * 64; t.n0 = (it % 32) * 64; t.dst = (bf16_t*)(ws + WS_WIN); t.ldd = DM; t.dst_row0 = t.n0; return 0; }
        const int i2 = it - 1024; t.k0 = (i2 / 96) * 128; t.n0 = 2048 + (i2 % 96) * 32; t.dst = (bf16_t*)(ws + WS_WIN8); t.ldd = DM; t.dst_row0 = t.n0 - 2048; return 2; }
    it -= IT_WIN;
    if (it < IT_WOUT) { t.src = a.w_out; t.ld = DM;
        if (it < 512) { t.k0 = (it / 32) * 64; t.n0 = (it % 32) * 64; t.dst = (bf16_t*)(ws + WS_WOUT); t.ldd = 1024; t.dst_row0 = t.n0; return 0; }
        const int i2 = it - 512; t.k0 = 1024 + (i2 / 64) * 128; t.n0 = (i2 % 64) * 32; t.dst = (bf16_t*)(ws + WS_WOUT + 4 * MiB - 1024); t.ldd = DM; t.dst_row0 = t.n0; return 2; }
    it -= IT_WOUT;
    if (it < IT_GU) { const int e = it / (2 * IT_GU1), r = it % (2 * IT_GU1), up = r / IT_GU1, q = r % IT_GU1;
        const float* src = e < NEXP ? (up ? a.w_up : a.w_gate) + (size_t)e * DM * DEXP : (up ? a.ws_up : a.ws_gate);
        t.src = src; t.ld = DEXP; t.k0 = (q / 16) * 128; t.n0 = (q % 16) * 32; t.dst = (bf16_t*)(ws + WS_WGU + (size_t)e * 1024 * DM); t.ldd = DM;
        t.dst_row0 = (t.n0 >> 7) * 256 + up * 128 + (t.n0 & 127); return 2; }
    it -= IT_GU;
    if (it < IT_D) { const int e = it / IT_D1, q = it % IT_D1;
        t.src = e < NEXP ? a.w_down + (size_t)e * DEXP * DM : a.ws_down; t.ld = DM; t.k0 = (q / 64) * 128; t.n0 = (q % 64) * 32;
        t.dst = (bf16_t*)(ws + WS_WD + (size_t)e * DM * DEXP); t.ldd = DEXP; t.dst_row0 = t.n0; return 2; }
    it -= IT_D;
    if (it < IT_RG) { const int n = it / 8, r = it % 8, mat = r / 4, q = r % 4;
        t.src = (mat ? a.w_rg_x : a.w_rg_a) + (size_t)n * 128 * 128; t.ld = 128; t.k0 = (q / 2) * 64; t.n0 = (q % 2) * 64;
        t.dst = (bf16_t*)(ws + WS_WRG) + (size_t)n * 256 * 128; t.ldd = 128; t.dst_row0 = mat * 128 + t.n0; return 0; }
    it -= IT_RG;
    t.src = a.w_router; t.ld = NEXP; t.k0 = it * 64; t.n0 = 0; t.dst = (bf16_t*)(ws + WS_WR); t.ldd = DM; t.dst_row0 = 0; return 1;
}
#ifndef BG_NC
#define BG_NC 72
#endif
constexpr int CW_DONE = 2304, CW_PROG = 2560, BG_GC = 256 - BG_NC, BG_NS = BG_NC * NWAVES;
constexpr int BG_Q = (1792 + BG_GC - 1) / BG_GC, BG_X = 512 - 2 * BG_GC, BG_F3 = BG_Q - 6;
static_assert(BG_NC % 8 == 0 && CW_PROG + BG_NS <= CW_BAR && BG_X >= 0 && BG_X <= BG_GC && BG_X % 8 == 0 && BG_F3 >= 0 && BG_X * BG_F3 <= 768 && BG_X * BG_F3 + (BG_GC - BG_X) * (BG_Q - 4) >= 768, "background streams / projection split");
template <int MAP, bool STOP> __device__ __forceinline__ int p0_items(const Args& a, LAS unsigned char* lds, int first, int stride, unsigned* done = nullptr, int limit = 1 << 30) {
    const int COUNT = min(limit, MAP == 0 ? IT_WIN + IT_WOUT + IT_RG + IT_RT : IT_GU + IT_D);
    const int lane = threadIdx.x & 63, wave = __builtin_amdgcn_readfirstlane(threadIdx.x >> 6);
    LAS float* scr = (LAS float*)(lds + wave * 16640);
#define P0_MAP(i) (MAP == 0 ? ((i) < IT_WIN + IT_WOUT ? (i) : (i) + IT_GU + IT_D) : (i) + IT_WIN + IT_WOUT)
    int it = first, n = 0; if (it >= COUNT) return 0;
    TrItem cur; int mode = tr_decode(a, P0_MAP(it), cur); f32x4 v[16]; if (MAP == 1 || mode == 2) tr_load8(cur, lane, v); else tr_load(cur, lane, v);
    for (;;) {
        unsigned d = 0u; if (STOP) d = xb_ld(done);
        const int itn = it + stride; const bool more = itn < COUNT;
        TrItem nxt = cur; int moden = mode; f32x4 vn[16];
        if (more) { moden = tr_decode(a, P0_MAP(itn), nxt); if (MAP == 1 || moden == 2) tr_load8(nxt, lane, vn); else tr_load(nxt, lane, vn); }
        if (MAP == 1 || mode == 2) tr_store8(cur, lane, v, scr); else tr_store(cur, lane, v, scr, mode, (size_t)NEXP * DM);
        ++n;
        if (!more) break;
        cur = nxt; mode = moden; it = itn;
#pragma unroll
        for (int i = 0; i < 16; ++i) v[i] = vn[i];
        if (STOP && __builtin_amdgcn_readfirstlane((int)d) != 0) { tr_store8(cur, lane, v, scr); ++n; break; }
    }
#undef P0_MAP
    return n;
}
__device__ __forceinline__ void p0_phase(const Args& a, LAS unsigned char* lds, int vcu, int G, int parts = 7) {
    const int tid = threadIdx.x, lane = tid & 63, wave = __builtin_amdgcn_readfirstlane(tid >> 6);
    unsigned char* ws = a.ws;
    const int gt = vcu * NTHR + tid, NGT = G * NTHR;
    if (parts & 1) { unsigned* ctl = (unsigned*)(ws + WS_CTL);
      for (int i = gt; i < CW_BAR; i += NGT) ctl[i] = (i == CW_CNT + NEXP * CNT_STRIDE) ? (unsigned)NTOK : 0u;
      int* st = (int*)(ws + WS_SLOT) + (size_t)NEXP * CAP;
      for (int i = gt; i < NTOK; i += NGT) { st[i] = i; }
      float* tab = (float*)(ws + WS_TAB);
      for (int i = gt; i < 2048 * 16; i += NGT) { const int pos = i >> 4, j = i & 15;
          const double inv = pow(500000.0, -(double)j / 16.0), ang = (double)pos * inv; tab[i] = (float)cos(ang); tab[32768 + i] = (float)sin(ang); }
      for (int i = gt; i < 1024; i += NGT) { const float lam = a.lru_lambda[i]; tab[65536 + i] = 8.0f * log1pf(expf(-lam)); }
    }
    if (parts & 2) { const f32x4* xs = (const f32x4*)a.x; u32x4* xd = (u32x4*)(ws + WS_XB); u32x2* x8d = (u32x2*)(ws + WS_XIN8);
      constexpr int NCH = NTOK * DM / 8;
      for (int i = gt; i < NCH; i += NGT) { const f32x4 v0 = __builtin_nontemporal_load(xs + 2 * i), v1 = __builtin_nontemporal_load(xs + 2 * i + 1);
          u32x4 o; o.x = cvt_pk_bf16(v0[0], v0[1]); o.y = cvt_pk_bf16(v0[2], v0[3]); o.z = cvt_pk_bf16(v1[0], v1[1]); o.w = cvt_pk_bf16(v1[2], v1[3]); xd[i] = o;
          u32x2 o8; int t8 = __builtin_amdgcn_cvt_pk_fp8_f32(v0[0], v0[1], 0, false); t8 = __builtin_amdgcn_cvt_pk_fp8_f32(v0[2], v0[3], t8, true); o8.x = (unsigned)t8;
          t8 = __builtin_amdgcn_cvt_pk_fp8_f32(v1[0], v1[1], 0, false); t8 = __builtin_amdgcn_cvt_pk_fp8_f32(v1[2], v1[3], t8, true); o8.y = (unsigned)t8; x8d[i] = o8; }
    }
    const int gw = vcu * NWAVES + wave, NGW = G * NWAVES;
    if (parts & 4) {
        p0_items<0, false>(a, lds, gw, NGW);
        if (!(parts & 8)) p0_items<1, false>(a, lds, gw, NGW);
    }
}

constexpr int LRU_XC = 0, LRU_XCP = 272, LRU_AA = 69632, LRU_UU = LRU_AA + 32768, LRU_SA = LRU_UU + 32768, LRU_SH = LRU_SA + 2048, LRU_CARRY = LRU_SH + 2048, LRU_WB = LRU_CARRY + 256;
static_assert(LRU_WB + 64 * LRU_XCP <= LDS_BYTES - 256, "LRU LDS map");
__device__ __forceinline__ void lru_item(const Args& a, char* lds, int item) {
    const int tid = threadIdx.x, lane = tid & 63, wave = __builtin_amdgcn_readfirstlane(tid >> 6), r32 = lane & 31, hi = lane >> 5;
    const int b = item >> 5, n = (item >> 2) & 7, cq = item & 3;
    unsigned char* ws = a.ws;
    const bf16_t* proj = (const bf16_t*)(ws + WS_PROJ);
    const bf16_t* xl = proj + (size_t)(b * NGRP + n) * SEQ * 128;
    const bf16_t* gl = proj + (size_t)(b * NGRP + 8 + n) * SEQ * 128;
    bf16_t* mix = (bf16_t*)(ws + WS_MIX) + (size_t)b * SEQ * 1024 + n * 128 + cq * 32;
    const float* tab = (const float*)(ws + WS_TAB);
    char* XC = lds + LRU_XC; float* AA = (float*)(lds + LRU_AA); float* UU = (float*)(lds + LRU_UU); float* SA = (float*)(lds + LRU_SA); float* SH = (float*)(lds + LRU_SH); float* CARRY = (float*)(lds + LRU_CARRY);
    char* WB = lds + LRU_WB;
    { const bf16_t* wt = (const bf16_t*)(ws + WS_WRG) + (size_t)n * 256 * 128;
#pragma unroll
      for (int i = 0; i < 2; ++i) { const int q = tid + 512 * i, row = q >> 4, c16 = q & 15; const int srow = (row < 32 ? cq * 32 + row : 128 + cq * 32 + (row - 32));
          *(u32x4*)(WB + row * LRU_XCP + c16 * 16) = *(const u32x4*)(wt + (size_t)srow * 128 + c16 * 8); } }
    const int chd = n * 128 + cq * 32 + r32;
    const float ba = a.b_rg_a[chd], bx = a.b_rg_x[chd], sp8 = tab[65536 + chd];
    const int cg8 = tid & 15, tg = tid >> 4;
    float cw[4][8], cb[8];
#pragma unroll
    for (int j = 0; j < 4; ++j)
#pragma unroll
        for (int c = 0; c < 8; ++c) cw[j][c] = a.conv_w[j * 1024 + n * 128 + cg8 * 8 + c];
#pragma unroll
    for (int c = 0; c < 8; ++c) cb[c] = a.conv_b[n * 128 + cg8 * 8 + c];
    if (tid < 32) CARRY[tid] = 0.f;
    const int sd = tid & 31, seg = tid >> 5;
    u32x4 xr[11];
#define LRU_XLOAD(s0_) do { const bf16_t* pb_ = xl + ((s0_) + tg * 8 - 3) * 128 + cg8 * 8; const int sneg_ = 3 - ((s0_) + tg * 8); \
        _Pragma("unroll") for (int i = 0; i < 11; ++i) { xr[i] = *(const u32x4*)(pb_ + i * 128); if (i < 3 && i < sneg_) xr[i] = (u32x4){0u, 0u, 0u, 0u}; } } while (0)
    LRU_XLOAD(0);
    for (int ch = 0; ch < 8; ++ch) {
        const int s0 = ch * 256;
#pragma unroll
        for (int i = 0; i < 8; ++i) { float o[8];
#pragma unroll
            for (int c = 0; c < 8; ++c) o[c] = cb[c];
#pragma unroll
            for (int j = 0; j < 4; ++j) { const u32x4 w = xr[i + j];
                o[0] += cw[j][0] * bflo(w.x); o[1] += cw[j][1] * bfhi(w.x); o[2] += cw[j][2] * bflo(w.y); o[3] += cw[j][3] * bfhi(w.y);
                o[4] += cw[j][4] * bflo(w.z); o[5] += cw[j][5] * bfhi(w.z); o[6] += cw[j][6] * bflo(w.w); o[7] += cw[j][7] * bfhi(w.w); }
            u32x4 w; w.x = cvt_pk_bf16(o[0], o[1]); w.y = cvt_pk_bf16(o[2], o[3]); w.z = cvt_pk_bf16(o[4], o[5]); w.w = cvt_pk_bf16(o[6], o[7]);
            *(u32x4*)(XC + (tg * 8 + i) * LRU_XCP + cg8 * 16) = w; }
        if (ch + 1 < 8) LRU_XLOAD(s0 + 256);
        __syncthreads();
        { f32x16 ga = {}, gx = {};
#pragma unroll
          for (int ks = 0; ks < 8; ++ks) { const bf16x8 af = *(const bf16x8*)(XC + (wave * 32 + r32) * LRU_XCP + (ks * 16 + hi * 8) * 2);
              const bf16x8 Bak = *(const bf16x8*)(WB + r32 * LRU_XCP + (ks * 16 + hi * 8) * 2), Bxk = *(const bf16x8*)(WB + (32 + r32) * LRU_XCP + (ks * 16 + hi * 8) * 2);
              ga = __builtin_amdgcn_mfma_f32_32x32x16_bf16(af, Bak, ga, 0, 0, 0); gx = __builtin_amdgcn_mfma_f32_32x32x16_bf16(af, Bxk, gx, 0, 0, 0); }
#pragma unroll
          for (int r = 0; r < 16; ++r) { const int tok = wave * 32 + att::crow(r, hi);
              const float ra = __builtin_amdgcn_rcpf(1.f + __expf(-(ga[r] + ba))), ix = __builtin_amdgcn_rcpf(1.f + __expf(-(gx[r] + bx)));
              const float la = -ra * sp8, av = __expf(la), x2 = 2.f * la;
              float pz = fmaf(x2, 1.f / 7.f, 1.f); pz = fmaf(x2 * (1.f / 6.f), pz, 1.f); pz = fmaf(x2 * (1.f / 5.f), pz, 1.f); pz = fmaf(x2 * 0.25f, pz, 1.f); pz = fmaf(x2 * (1.f / 3.f), pz, 1.f); pz = fmaf(x2 * 0.5f, pz, 1.f);
              const float mult = sqrtf(-x2 * pz);
              const float xcv = bf2f(*(const unsigned short*)(XC + tok * LRU_XCP + (cq * 32 + r32) * 2));
              AA[tok * 32 + r32] = av; UU[tok * 32 + r32] = mult * ix * xcv; } }
        __syncthreads();
        { float av[16], uv[16]; float Ap = 1.f, Hp = 0.f;
          unsigned short glv[16];
#pragma unroll
          for (int i = 0; i < 16; ++i) glv[i] = gl[(size_t)(s0 + seg * 16 + i) * 128 + cq * 32 + sd];
#pragma unroll
          for (int i = 0; i < 16; ++i) { av[i] = AA[(seg * 16 + i) * 32 + sd]; uv[i] = UU[(seg * 16 + i) * 32 + sd]; Hp = av[i] * Hp + uv[i]; Ap *= av[i]; }
          SA[seg * 32 + sd] = Ap; SH[seg * 32 + sd] = Hp;
          __syncthreads();
          float carry = CARRY[(ch & 1) * 32 + sd];
          for (int s2 = 0; s2 < seg; ++s2) carry = SA[s2 * 32 + sd] * carry + SH[s2 * 32 + sd];
#pragma unroll
          for (int i = 0; i < 16; ++i) { carry = av[i] * carry + uv[i];
              mix[(size_t)(s0 + seg * 16 + i) * 1024 + sd] = (bf16_t)(cvt_pk_bf16(carry * bf2f(glv[i]), 0.f) & 0xffffu); }
          if (seg == 15) CARRY[((ch + 1) & 1) * 32 + sd] = carry; }
    }
    __syncthreads();
}

__device__ __forceinline__ att::BlockRef att_ref(const Args& a, int L) {
    unsigned char* ws = a.ws;
    const int p = L >> 9, q = L & 511, bh = q >> 3, sub = q & 7, b = bh >> 3, h = bh & 7;
    int dil, cls, qb;
    if (p == 0) { dil = 1; cls = 0; qb = sub; } else if (p == 1) { dil = 4; cls = sub >> 1; qb = sub & 1; } else { dil = 8; cls = sub; qb = 0; }
    const bf16_t* proj = (const bf16_t*)(ws + WS_PROJ);
    att::BlockRef r;
    r.H = proj + (size_t)(b * NGRP + 16 + h) * SEQ * 128 + cls * 128;
    r.dil = dil; r.W = (p == 2) ? 256 : 129; r.P0 = qb * 256;
    const size_t tok0 = (size_t)b * SEQ + cls + (size_t)qb * 256 * dil;
    r.O = (bf16_t*)((unsigned char*)a.out + (size_t)p * NTOK * 1024 + tok0 * 1024 + h * 128);
    r.ST = (f32x2*)(ws + WS_ASTAT) + (size_t)p * NTOK * 8 + tok0 * 8 + h;
    return r;
}
__device__ __forceinline__ void att_phase_v1(const Args& a, char* lds, int c, int G) {
    constexpr int TOTAL = 3 * 512;
    int L = c; if (L >= TOTAL) return;
    att::BlockRef cur = att_ref(a, L);
    att::Seam S;
    att::swa_prime(cur, lds, S);
    for (;;) {
        const bool more = L + G < TOTAL;
        const att::BlockRef nxt = more ? att_ref(a, L + G) : cur;
        att::swa_block(cur, nxt, lds, S);
        if (!more) break;
        cur = nxt; L += G;
    }
}
__device__ __forceinline__ void att_phase(const Args& a, char* lds, LAS unsigned char* ldsl, int c, int G) {
    using namespace att;
    constexpr int TOTAL = 3 * 512;
    int L = c; if (L >= TOTAL) return;
    const int tid = threadIdx.x, wid = __builtin_amdgcn_readfirstlane(tid >> 6), lane = tid & 63, r32 = lane & 31, hi = lane >> 5;
    char* V_lds = lds + R_V; char* K_lds = lds + R_K;
    float* wsf = (float*)(lds + R_WS) + wid * 64; float* li_l = wsf, * al_l = wsf + 32;
    const int vb0 = (int)(uintptr_t)V_lds + v_rd_base(lane);
    bf16x8 qr[8];
#define QLOAD(ref) do { _Pragma("unroll") for (int d0 = 0; d0 < 8; ++d0) qr[d0] = load8((ref).H + (size_t)((ref).P0 + wid * QBLK + r32) * (128 * (ref).dil) + d0 * 16 + hi * 8); } while (0)
    const bf16_t* iH; int irs, ikb, irem, iss_L = L, pos_iss = 0; bool iss_ok = true;
#define ISS_SET(ref) do { const int jl_ = swa_jlo((ref).P0, (ref).W); int jh_ = ((ref).P0 + QB - 1) / KVBLK + 1; const int skv_ = SEQ / (ref).dil; if (jh_ > skv_ / KVBLK) jh_ = skv_ / KVBLK; \
        iH = (ref).H; irs = 128 * (ref).dil; ikb = jl_ * KVBLK; irem = jh_ - jl_; } while (0)
#define ISSUE_NEXT() do { if (iss_ok) { { int lo_ = lane; asm volatile("" : "+v"(lo_)); dma_tile(iH, irs, ikb, ldsl, pos_iss & 3, wid, dma_map(wid, lo_)); } ++pos_iss;     ikb += KVBLK; \
        if (--irem == 0) { iss_L += G; if (iss_L < TOTAL) { const BlockRef nr_ = att_ref(a, iss_L); ISS_SET(nr_); } else iss_ok = false; } } } while (0)
    { const BlockRef c0 = att_ref(a, L); ISS_SET(c0); QLOAD(c0); }
    ISSUE_NEXT(); ISSUE_NEXT();
    asm volatile("s_waitcnt vmcnt(4)" ::: "memory");
    __syncthreads();
    int pos = 0;
    for (;;) {
        int W, NT, j_lo, P0c;
        { const BlockRef cr = att_ref(a, L); W = cr.W; P0c = cr.P0; const int skv = SEQ / cr.dil; j_lo = swa_jlo(cr.P0, W);
          int j_hi = (cr.P0 + QB - 1) / KVBLK + 1; if (j_hi > skv / KVBLK) j_hi = skv / KVBLK; NT = j_hi - j_lo; }
        const unsigned par = (W == 256) ? 1u : 0u;
        const int qlo = P0c + wid * QBLK, qm = qlo + r32 - 4 * hi;
        const bool more = L + G < TOTAL;
        float m_reg = -1e30f, l_reg = 0; f32x16 o[4] = {};
        f32x16 pA0, pA1, pB0, pB1; float mnA, mnB, alA, alB; bf16x8 pa0, pa1, pa2, pa3;
#define RESC(a_) do { if (__any((a_) < 1.f)) { if (hi == 0) al_l[r32] = (a_); asm volatile("s_waitcnt lgkmcnt(0)" ::: "memory");              \
                     for (int d_ = 0; d_ < 4; ++d_) for (int r = 0; r < 16; ++r) o[d_][r] *= al_l[crow(r, hi)]; } } while (0)
#define KBASE(t) ((j_lo + (t)) * KVBLK)
#define ACT(t) (KBASE(t) <= qlo + QBLK - 1 && KBASE(t) + KVBLK - 1 >= qlo - W + 1)
#define MASKT(P0_, P1_, t) do { const int kb_ = KBASE(t); if (ACT(t) && (par != 0u || kb_ + KVBLK - 1 > qlo || kb_ <= qlo + QBLK - 1 - W)) mask_tile(P0_, P1_, qm - kb_, (unsigned)W, par); } while (0)
#define STEP(PX0, PX1, mnX, alX, PY0, PY1, alY, t, HAVEPREV, LASTQ) do {                                                                 \
            const bool issued_ = iss_ok; ISSUE_NEXT(); SBAR();                                                                              \
            qkt_s(PX0, PX1, K_lds + (pos & 3) * SHM_K, r32, hi, qr, ACT(t)); SBAR();                                                       \
            const bool qn_ = (LASTQ) && more; if (qn_) { const BlockRef nq_ = att_ref(a, L + G); QLOAD(nq_); SBAR(); }        \
            if (HAVEPREV) { finishSM(PY0, PY1, alY, l_reg, pa0, pa1, pa2, pa3); SBAR();                                                    \
                            pv_s(o, vb0 + ((pos - 1) & 3) * SHM_V, pa0, pa1, pa2, pa3, ACT((t) - 1)); }                                    \
            MASKT(PX0, PX1, (t)); partialSM(PX0, PX1, m_reg, mnX, alX);                                                                    \
            if (issued_) { if (qn_) asm volatile("s_waitcnt vmcnt(12)" ::: "memory"); else asm volatile("s_waitcnt vmcnt(4)" ::: "memory"); } \
            else { if (qn_) asm volatile("s_waitcnt vmcnt(8)" ::: "memory"); else asm volatile("s_waitcnt vmcnt(0)" ::: "memory"); }        \
            __syncthreads();                                                                                                                \
            RESC(alX); ++pos; } while (0)
        for (int t = 0; t < NT; t += 2) {
            STEP(pA0, pA1, mnA, alA, pB0, pB1, alB, t, (t > 0), false);
            STEP(pB0, pB1, mnB, alB, pA0, pA1, alA, t + 1, true, (t + 2 >= NT));
        }
        finishSM(pB0, pB1, alB, l_reg, pa0, pa1, pa2, pa3); SBAR();
        pv_s(o, vb0 + ((pos - 1) & 3) * SHM_V, pa0, pa1, pa2, pa3, ACT(NT - 1));
        int Le = L; asm volatile("" : "+s"(Le));
        const BlockRef ce = att_ref(a, Le); const int ors = 1024 * ce.dil, sst = 8 * ce.dil;
        if (hi == 0) { li_l[r32] = l_reg; ce.ST[(size_t)(wid * QBLK + r32) * sst] = (f32x2){m_reg, l_reg}; }
        asm volatile("s_waitcnt lgkmcnt(0)" ::: "memory");
        float rli[16];
#pragma unroll
        for (int r = 0; r < 16; ++r) rli[r] = __builtin_amdgcn_rcpf(li_l[crow(r, hi)]);
        unsigned char* Ow = (unsigned char*)ce.O + (size_t)(wid * QBLK) * ors;
        char* osc = lds + STREAM_LDS + wid * 1536;
#pragma unroll
        for (int d0 = 0; d0 < 4; ++d0) {
#pragma unroll
            for (int r = 0; r < 16; ++r) *(unsigned char*)(osc + crow(r, hi) * 48 + r32) = (unsigned char)__builtin_amdgcn_cvt_pk_fp8_f32(o[d0][r] * (rli[r] * A8_SCALE), 0.f, 0, false);
            asm volatile("s_waitcnt lgkmcnt(0)" ::: "memory");
            const u32x4 tv = *(const u32x4*)(osc + (lane >> 1) * 48 + (lane & 1) * 16);
            *(u32x4*)(Ow + (size_t)(lane >> 1) * ors + d0 * 32 + (lane & 1) * 16) = tv;
        }
#undef STEP
#undef MASKT
#undef ACT
#undef KBASE
#undef RESC
        if (!more) break;
        L += G;
    }
#undef QLOAD
#undef ISS_SET
#undef ISSUE_NEXT
    asm volatile("s_waitcnt vmcnt(0)" ::: "memory");
    __syncthreads();
}
__device__ __forceinline__ void merge_phase(const Args& a, int vcu, int G) {
    unsigned char* ws = a.ws;
    const int gt = vcu * NTHR + threadIdx.x, NGT = G * NTHR;
    const f32x2* st = (const f32x2*)(ws + WS_ASTAT); const unsigned char* op8 = (const unsigned char*)a.out; unsigned char* att8 = ws + WS_MIX + 32 * MiB;
    constexpr float C2 = 1.4426950408889634f * att::SCALE;
    for (int i = gt; i < NTOK * 8 * 16; i += NGT) {
        const int c = i & 15, th = i >> 4, t = th >> 3, h = th & 7;
        const f32x2 s0 = st[th], s1 = st[(size_t)NTOK * 8 + th], s2 = st[(size_t)2 * NTOK * 8 + th];
        const float mx = fmaxf(s0.x, fmaxf(s1.x, s2.x));
        const float w0 = s0.y * __builtin_amdgcn_exp2f((s0.x - mx) * C2), w1 = s1.y * __builtin_amdgcn_exp2f((s1.x - mx) * C2), w2 = s2.y * __builtin_amdgcn_exp2f((s2.x - mx) * C2);
        const float inv = 1.f / (w0 + w1 + w2);
        const size_t off = (size_t)t * 1024 + h * 128 + c * 8;
        const u32x2 a0 = *(const u32x2*)(op8 + off), a1 = *(const u32x2*)(op8 + (size_t)NTOK * 1024 + off), a2 = *(const u32x2*)(op8 + (size_t)2 * NTOK * 1024 + off);
        u32x2 o;
#define MRG2(f, sel) ({ const f32x2 q0 = __builtin_amdgcn_cvt_pk_f32_fp8((int)a0.f, sel), q1 = __builtin_amdgcn_cvt_pk_f32_fp8((int)a1.f, sel), q2 = __builtin_amdgcn_cvt_pk_f32_fp8((int)a2.f, sel); (f32x2){(w0 * q0.x + w1 * q1.x + w2 * q2.x) * inv, (w0 * q0.y + w1 * q1.y + w2 * q2.y) * inv}; })
        { const f32x2 lo = MRG2(x, false), hi2 = MRG2(x, true); int t0 = __builtin_amdgcn_cvt_pk_fp8_f32(lo.x, lo.y, 0, false); t0 = __builtin_amdgcn_cvt_pk_fp8_f32(hi2.x, hi2.y, t0, true); o.x = (unsigned)t0; }
        { const f32x2 lo = MRG2(y, false), hi2 = MRG2(y, true); int t1 = __builtin_amdgcn_cvt_pk_fp8_f32(lo.x, lo.y, 0, false); t1 = __builtin_amdgcn_cvt_pk_fp8_f32(hi2.x, hi2.y, t1, true); o.y = (unsigned)t1; }
#undef MRG2
        *(u32x2*)(att8 + (size_t)t * DM + h * 128 + c * 8) = o;
    }
}

constexpr int P4_ROWB = 272, P4_AH = 0, P4_AL = 64 * P4_ROWB, P4_WH = 2 * 64 * P4_ROWB, P4_WL = 3 * 64 * P4_ROWB, P4_RED = 4 * 64 * P4_ROWB, P4_STAT = P4_RED + 2 * 64 * 65 * 4, P4_LCNT = P4_STAT + 512, P4_BASE = P4_LCNT + 256, P4_REC = P4_BASE + 256;
__device__ __forceinline__ float grp8_max(float v) { v = fmaxf(v, __shfl_xor(v, 1)); v = fmaxf(v, __shfl_xor(v, 2)); v = fmaxf(v, __shfl_xor(v, 4)); return v; }
__device__ __forceinline__ float wave_max(float v) {
#pragma unroll
    for (int o = 1; o < 64; o <<= 1) v = fmaxf(v, __shfl_xor(v, o));
    return v;
}
__device__ __forceinline__ void p4_phase(const Args& a, char* lds, int vcu, int G) {
    const int tid = threadIdx.x, lane = tid & 63, wave = __builtin_amdgcn_readfirstlane(tid >> 6), r32 = lane & 31, hi = lane >> 5;
    unsigned char* ws = a.ws;
    const float* Y = a.out; bf16_t* X1 = (bf16_t*)(ws + WS_X1); unsigned char* X8 = ws + WS_X8; const float* rpart = (const float*)(ws + WS_RPART);
    const bf16_t* WRh = (const bf16_t*)(ws + WS_WR); const bf16_t* WRl = WRh + (size_t)NEXP * DM;
    float* RED = (float*)(lds + P4_RED); f32x2* STAT = (f32x2*)(lds + P4_STAT);
    unsigned* cnt = (unsigned*)(ws + WS_CTL) + CW_CNT;
    int* slot_tok = (int*)(ws + WS_SLOT); float* slot_gate = (float*)(ws + WS_SLOT + SLOT_ARR); int* TS = (int*)(ws + WS_SLOT + 2 * SLOT_ARR);
    const int mt = wave & 1, nt = (wave >> 1) & 1, kh = wave >> 2;
    const int yc = 4 * (lane & 31), yr0 = 2 * wave + (lane >> 5);
    const int we = tid >> 4, wk8 = (tid & 15) * 8;
    const float bias = a.router_bias[lane];
    for (int tile = vcu; tile < NTOK / 64; tile += G) {
        const int t0 = tile * 64;
        __syncthreads();
        unsigned* LCNT = (unsigned*)(lds + P4_LCNT); unsigned* BASE = (unsigned*)(lds + P4_BASE); u32x4* REC = (u32x4*)(lds + P4_REC);
        if (tid < 64) { LCNT[tid] = 0u; const f32x4* rp = (const f32x4*)(rpart + (size_t)(t0 + tid) * 64); float s1 = 0.f, s2 = 0.f;
#pragma unroll
            for (int i = 0; i < 16; ++i) { const f32x4 v = rp[i]; s1 += v[0] + v[2]; s2 += v[1] + v[3]; }
            const float mean = s1 * (1.f / DM), var = s2 * (1.f / DM) - mean * mean; STAT[tid] = (f32x2){mean, 1.f / sqrtf(var + LN_EPS)}; }
        f32x4 yv[4], gv, bv; u32x4 wh[2], wl[2];
#define P4_LOAD(k0) do { _Pragma("unroll") for (int i = 0; i < 4; ++i) yv[i] = __builtin_nontemporal_load((const f32x4*)(Y + (size_t)(t0 + yr0 + 16 * i) * DM + (k0) + yc)); \
        gv = *(const f32x4*)(a.ln1_g + (k0) + yc); bv = *(const f32x4*)(a.ln1_b + (k0) + yc); \
        _Pragma("unroll") for (int j = 0; j < 2; ++j) { wh[j] = *(const u32x4*)(WRh + (size_t)(we + 32 * j) * DM + (k0) + wk8); wl[j] = *(const u32x4*)(WRl + (size_t)(we + 32 * j) * DM + (k0) + wk8); } } while (0)
        P4_LOAD(0);
        f32x16 acc = {};
        for (int ch = 0; ch < 16; ++ch) {
            const int k0 = ch * 128;
            __syncthreads();
#pragma unroll
            for (int i = 0; i < 4; ++i) { const int row = yr0 + 16 * i; const f32x2 st = STAT[row];
                const f32x4 x = (yv[i] - st.x) * st.y * gv + bv;
                u32x2 hw, lw; hw.x = cvt_pk_bf16(x[0], x[1]); hw.y = cvt_pk_bf16(x[2], x[3]);
                lw.x = cvt_pk_bf16(x[0] - bflo(hw.x), x[1] - bfhi(hw.x)); lw.y = cvt_pk_bf16(x[2] - bflo(hw.y), x[3] - bfhi(hw.y));
                *(u32x2*)(lds + P4_AH + row * P4_ROWB + yc * 2) = hw; *(u32x2*)(lds + P4_AL + row * P4_ROWB + yc * 2) = lw;
                __builtin_nontemporal_store(hw, (u32x2*)(X1 + (size_t)(t0 + row) * DM + k0 + yc));
                { int t8 = __builtin_amdgcn_cvt_pk_fp8_f32(x[0], x[1], 0, false); t8 = __builtin_amdgcn_cvt_pk_fp8_f32(x[2], x[3], t8, true); *(int*)(X8 + (size_t)(t0 + row) * DM + k0 + yc) = t8; } }
#pragma unroll
            for (int j = 0; j < 2; ++j) { *(u32x4*)(lds + P4_WH + (we + 32 * j) * P4_ROWB + wk8 * 2) = wh[j]; *(u32x4*)(lds + P4_WL + (we + 32 * j) * P4_ROWB + wk8 * 2) = wl[j]; }
            __syncthreads();
            if (ch + 1 < 16) P4_LOAD(k0 + 128);
#pragma unroll
            for (int kk = 0; kk < 4; ++kk) { const int ko = ((kh * 4 + kk) * 16 + 8 * hi) * 2;
                const bf16x8 Ah = *(const bf16x8*)(lds + P4_AH + (32 * mt + r32) * P4_ROWB + ko), Al = *(const bf16x8*)(lds + P4_AL + (32 * mt + r32) * P4_ROWB + ko);
                const bf16x8 Bh = *(const bf16x8*)(lds + P4_WH + (32 * nt + r32) * P4_ROWB + ko), Bl = *(const bf16x8*)(lds + P4_WL + (32 * nt + r32) * P4_ROWB + ko);
                acc = __builtin_amdgcn_mfma_f32_32x32x16_bf16(Ah, Bh, acc, 0, 0, 0); acc = __builtin_amdgcn_mfma_f32_32x32x16_bf16(Ah, Bl, acc, 0, 0, 0); acc = __builtin_amdgcn_mfma_f32_32x32x16_bf16(Al, Bh, acc, 0, 0, 0); }
        }
#undef P4_LOAD
#pragma unroll
        for (int r = 0; r < 16; ++r) RED[(kh * 64 + 32 * mt + att::crow(r, hi)) * 65 + 32 * nt + r32] = acc[r];
        __syncthreads();
        const float NEG = -__builtin_inff(); const int grp = lane >> 3;
        for (int rr = 0; rr < 8; ++rr) {
            const int row = 8 * wave + rr;
            const float lg = RED[row * 65 + lane] + RED[(64 + row) * 65 + lane];
            const float sc = __builtin_amdgcn_rcpf(1.f + __expf(-lg)), sel = sc + bias;
            const float m1 = grp8_max(sel);
            const unsigned long long eq = __ballot(sel == m1);
            const int first = __builtin_ctz((unsigned)((eq >> (8 * grp)) & 0xffull));
            const float m2 = grp8_max((lane & 7) == first ? NEG : sel);
            const float gs = m1 + m2;
            int rank = 0;
#pragma unroll
            for (int g = 0; g < 8; ++g) { const float o = __shfl(gs, 8 * g); rank += (o > gs || (o == gs && g < grp)) ? 1 : 0; }
            float msel = rank < 4 ? sel : NEG;
            int myk = -1;
#pragma unroll
            for (int k = 0; k < 8; ++k) { const float mx = wave_max(msel); const unsigned long long b = __ballot(msel == mx); const int win = __builtin_ctzll(b);
                if (lane == win) { myk = k; msel = NEG; } }
            const float gsum = wave_sum(myk >= 0 ? sc : 0.f);
            if (myk >= 0) { const unsigned lpos = atomicAdd(LCNT + lane, 1u);
                REC[row * 8 + myk] = (u32x4){(unsigned)lane, lpos, __float_as_uint(sc * (2.5f / gsum)), 0u}; }
        }
        __syncthreads();
        if (tid < 64) BASE[tid] = atomicAdd(cnt + tid * CNT_STRIDE, LCNT[tid]);
        __syncthreads();
        { const u32x4 rc = REC[tid]; const int e = (int)rc.x; const unsigned pos = BASE[e] + rc.y; const int t = t0 + (tid >> 3);
          slot_tok[(size_t)e * CAP + pos] = t; slot_gate[t * 8 + (tid & 7)] = __uint_as_float(rc.z); TS[t * 8 + (tid & 7)] = e * CAP + (int)pos; }
    }
    __syncthreads();
}

__device__ __forceinline__ void p8_phase(const Args& a, const LAS int* pre, int vcu, int G) {
    const int tid = threadIdx.x, lane = tid & 63, wave = __builtin_amdgcn_readfirstlane(tid >> 6);
    unsigned char* ws = a.ws;
    const unsigned char* Y8 = (const unsigned char*)(ws + WS_BIG); const bf16_t* X1 = (const bf16_t*)(ws + WS_X1); const int* TS = (const int*)(ws + WS_SLOT + 2 * SLOT_ARR); const float* TG = (const float*)(ws + WS_SLOT + SLOT_ARR);
    const int gw = vcu * NWAVES + wave, NGW = G * NWAVES;
    const int ncol = 128 * ((lane >> 3) & 1) + 32 * (lane >> 4) + 4 * (lane & 7);
    const int shared0 = pre[NEXP] * 256;
    for (int row = gw; row < NTOK; row += NGW) {
        u32x2 xr[8]; unsigned yr[NPAIR][8]; float gk[NPAIR];
#pragma unroll
        for (int p = 0; p < NPAIR; ++p) gk[p] = p < 8 ? __uint_as_float(__builtin_amdgcn_readfirstlane(__float_as_uint(TG[row * 8 + p]))) * (1.f / Y8_SCALE) : (1.f / Y8_SCALE);
        { const bf16_t* xp = X1 + (size_t)row * DM + ncol;
#pragma unroll
          for (int k = 0; k < 8; ++k) xr[k] = *(const u32x2*)(xp + 256 * k); }
#pragma unroll
        for (int p = 0; p < NPAIR; ++p) {
            int srow;
            if (p < 8) { const int ts = __builtin_amdgcn_readfirstlane(TS[row * 8 + p]); srow = pre[ts >> 14] * 256 + (ts & (CAP - 1)); } else srow = shared0 + row;
            const unsigned char* yp = Y8 + (size_t)srow * DM + 4 * lane;
#pragma unroll
            for (int k = 0; k < 8; ++k) yr[p][k] = __builtin_nontemporal_load((const unsigned*)(yp + 256 * k)); }
        f32x4 v[8];
#pragma unroll
        for (int k = 0; k < 8; ++k) { f32x4 sacc = (f32x4){0.f, 0.f, 0.f, 0.f};
#pragma unroll
            for (int p = 0; p < NPAIR; ++p) { const f32x2 lo = __builtin_amdgcn_cvt_pk_f32_fp8((int)yr[p][k], false), hi = __builtin_amdgcn_cvt_pk_f32_fp8((int)yr[p][k], true); sacc += (f32x4){lo.x, lo.y, hi.x, hi.y} * gk[p]; }
            v[k] = (f32x4){bflo(xr[k].x), bfhi(xr[k].x), bflo(xr[k].y), bfhi(xr[k].y)} * DN_ALPHA + sacc; }
        float s = 0.f;
#pragma unroll
        for (int k = 0; k < 8; ++k) s += (v[k][0] + v[k][1]) + (v[k][2] + v[k][3]);
        const float mean = wave_sum(s) * (1.f / DM); float q = 0.f;
#pragma unroll
        for (int k = 0; k < 8; ++k) { v[k] = v[k] - mean; q += (v[k][0] * v[k][0] + v[k][1] * v[k][1]) + (v[k][2] * v[k][2] + v[k][3] * v[k][3]); }
        const float rstd = 1.f / sqrtf(wave_sum(q) * (1.f / DM) + LN_EPS);
        float* orow = a.out + (size_t)row * DM + ncol;
        asm volatile("" ::: "memory");
#pragma unroll
        for (int k = 0; k < 8; ++k) { const f32x4 g2 = *(const f32x4*)(a.ln2_g + 256 * k + ncol), b2 = *(const f32x4*)(a.ln2_b + 256 * k + ncol); __builtin_nontemporal_store(v[k] * rstd * g2 + b2, (f32x4*)(orow + 256 * k)); }
    }
}

#define XB_TMO      128
#define XB_XCNT(j)  (256  + 64 * (j))
#define XB_XSUB(j)  (1280 + 64 * (j))
#define XB_XGEN(j)  (2304 + 64 * (j))
#define XB_TOP      3328
#define XB_TOPGEN   3392
#define XCD_BAR_WORDS 3456
#define XB_SPIN_CAP (1u << 22)
__device__ __forceinline__ unsigned xb_xcc_id() { return (unsigned)__builtin_amdgcn_s_getreg((3 << 11) | 20) & 0xFu; }
#define XB_SPIN(cond, bar) do { unsigned _sp = 0; while (cond) { __builtin_amdgcn_s_sleep(1); \
    if ((++_sp & 255u) == 0u) { if (xb_ld(&(bar)[XB_TMO])) break; if (_sp > XB_SPIN_CAP) { atomicAdd(&(bar)[XB_TMO], 1u); break; } } } } while (0)
struct XcdBarrier { unsigned* bar; unsigned x; volatile LAS unsigned* st; };
__device__ __forceinline__ XcdBarrier xcd_barrier_post(unsigned* bar, volatile LAS unsigned* st) {
    XcdBarrier b; b.bar = bar; b.x = xb_xcc_id(); b.st = st;
    if (threadIdx.x == 0) (void)xb_add(&bar[XB_XCNT(b.x)], 1u);
    return b;
}
__device__ __forceinline__ void xcd_barrier_complete(unsigned* bar, unsigned x, unsigned& nloc, unsigned& nx) {
    const unsigned G = gridDim.x;
    unsigned sum, cnt, mine, sp = 0u;
    for (;;) {
        sum = 0u; cnt = 0u; mine = 0u;
#pragma unroll
        for (unsigned j = 0; j < 16; ++j) { const unsigned c = xb_ld(&bar[XB_XCNT(j)]); sum += c; cnt += (c > 0u) ? 1u : 0u; mine = (j == x) ? c : mine; }
        if (sum == G) break;
        __builtin_amdgcn_s_sleep(1);
        if ((++sp & 255u) == 0u) { if (xb_ld(&bar[XB_TMO])) break; if (sp > XB_SPIN_CAP) { atomicAdd(&bar[XB_TMO], 1u); break; } }
    }
    nloc = mine > 0u ? mine : 1u; nx = cnt > 0u ? cnt : 1u;
}
__device__ __forceinline__ void xcd_barrier(const XcdBarrier& b) {
    asm volatile("s_waitcnt vmcnt(0)" ::: "memory");
    __syncthreads();
    if (threadIdx.x == 0) {
        unsigned* bar = b.bar;
        __builtin_amdgcn_s_waitcnt(0);
        unsigned nloc = b.st[0], nx = b.st[1];
        if (nloc == 0u) { xcd_barrier_complete(bar, b.x, nloc, nx); b.st[0] = nloc; b.st[1] = nx; }
        const unsigned old = xb_add(&bar[XB_XSUB(b.x)], 1u);
        const unsigned gen = old / nloc;
        if (old + 1u == (gen + 1u) * nloc) {
            __builtin_amdgcn_fence(__ATOMIC_RELEASE, "agent");
            asm volatile("s_waitcnt vmcnt(0)" ::: "memory");
            const unsigned og = xb_add(&bar[XB_TOP], 1u);
            const unsigned tg = og / nx;
            if (og + 1u == (tg + 1u) * nx) xb_add(&bar[XB_TOPGEN], 1u);
            else XB_SPIN(xb_ld(&bar[XB_TOPGEN]) == tg, bar);
            __builtin_amdgcn_fence(__ATOMIC_ACQUIRE, "agent");
            xb_add(&bar[XB_XGEN(b.x)], 1u);
            asm volatile("s_waitcnt vmcnt(0)" ::: "memory");
        } else {
            XB_SPIN(xb_ld(&bar[XB_XGEN(b.x)]) == gen, bar);
            __builtin_amdgcn_fence(__ATOMIC_ACQUIRE, "agent");
            asm volatile("s_waitcnt vmcnt(0)" ::: "memory");
        }
    }
    __syncthreads();
}

constexpr int N_PHASES = 9;
constexpr int LDS_PRE = 131072;
constexpr int LDS_MISC = LDS_BYTES - 256;
__global__ void __launch_bounds__(NTHR, 2) hymba_fwd(Args args) {
    extern __shared__ __attribute__((aligned(16))) unsigned char lds_raw[];
    LAS unsigned char* lds = (LAS unsigned char*)lds_raw;
    const int G = gridDim.x, bx = blockIdx.x, tid = threadIdx.x;
    const int vcu = (G % 8 == 0) ? (bx % 8) * (G / 8) + bx / 8 : bx;
    unsigned char* ws = args.ws;
    const int lo = args.ph_lo, hi = args.ph_hi;
    const bool part = args.coop && G == 256;
    const bool is_conv = part && bx >= BG_GC;
    const int cidx = bx;
#ifndef PHASE_MASK
#define PHASE_MASK 0x1ff
#endif
#define IN(k) ((((PHASE_MASK) >> (k)) & 1) && lo <= (k) && (k) < hi)
#ifndef REP_MASK
#define REP_MASK 0
#endif
#define REPS(k) for (int rep_ = 0; rep_ < 1 + (((REP_MASK) >> (k)) & 1); ++rep_)
#define REPBAR(k) do { if ((((REP_MASK) >> (k)) & 1) && rep_ == 0 && args.coop) xcd_barrier(bar); } while (0)
#define SEAM(k) do { if (IN(k) && IN((k) + 1)) { xcd_barrier(bar); } } while (0)
    XcdBarrier bar; bar.bar = (unsigned*)(ws + WS_CTL) + CW_BAR; bar.x = 0; bar.st = (volatile LAS unsigned*)(lds + LDS_MISC);
    if (args.coop) {
        if (tid < 2) ((LAS unsigned*)(lds + LDS_MISC))[tid] = 0u;
        __syncthreads();
        bar = xcd_barrier_post((unsigned*)(ws + WS_CTL) + CW_BAR, (volatile LAS unsigned*)(lds + LDS_MISC));
    }
    if (IN(0)) { p0_phase(args, lds, vcu, G, part ? 15 : 7);
#ifdef DUP_P0
        if (args.coop) xcd_barrier(bar);
        p0_phase(args, lds, vcu, G, DUP_P0);
#endif
    }
    SEAM(0);
    if (IN(1)) {
        unsigned* ctl = (unsigned*)(ws + WS_CTL);
        if (is_conv) {
            const int cw = (bx - BG_GC) * NWAVES + __builtin_amdgcn_readfirstlane(tid >> 6);
            const int n = p0_items<1, true>(args, lds, cw, BG_NS, ctl + CW_DONE);
            if ((tid & 63) == 0) ctl[CW_PROG + cw] = (unsigned)n;
        } else {
            int g1 = G, c1 = bx, g2 = G, c2 = bx, b2 = 0, im2 = 1 << 20;
            if (part) { g1 = BG_GC; c1 = cidx; if (cidx < BG_X) { g2 = BG_X; c2 = cidx; b2 = 0; im2 = BG_F3; } else { g2 = BG_GC - BG_X; c2 = cidx - BG_X; b2 = BG_X * BG_F3; } }
            { pg8::DenseOrder S; S.init(NTOK, 2048, DM, g1, c1);
              EpiProj E{(bf16_t*)(ws + WS_PROJ), (const float*)(ws + WS_TAB), lds, 0, 1.f};
              pg8::gemm_phase<EpiProj, pg8::DenseOrder>(lds, (const bf16_t*)(ws + WS_XB), (const bf16_t*)(ws + WS_WIN), DM, S, E); }
            { pg8::DenseOrder S; S.init(NTOK, 3072, DM / 2, g2, c2, b2, im2);
              EpiProj E{(bf16_t*)(ws + WS_PROJ), (const float*)(ws + WS_TAB), lds, 8, 1.f / W8_SCALE};
              pg8::gemm_phase<EpiProj, pg8::DenseOrder, true>(lds, (const bf16_t*)(ws + WS_XIN8), (const bf16_t*)(ws + WS_WIN8), DM / 2, S, E); }
            if (part && cidx < BG_X && tid == 0) (void)xb_add(ctl + CW_DONE, 1u);
        }
    }
    SEAM(1);
    if (IN(2)) {
#ifndef NO_LRU
        for (int item = vcu; item < 256; item += G) lru_item(args, (char*)lds_raw, item);
#endif
#ifdef DUP_LRU
        if (args.coop) xcd_barrier(bar);
        for (int item = vcu; item < 256; item += G) lru_item(args, (char*)lds_raw, item);
#endif
        att_phase(args, (char*)lds_raw, lds, bx, G);
#ifdef DUP_ATT
        if (args.coop) xcd_barrier(bar);
        att_phase(args, (char*)lds_raw, lds, bx, G);
#endif
    }
    SEAM(2);
    if (IN(3)) REPS(3) { merge_phase(args, vcu, G); REPBAR(3); }
    SEAM(3);
    if (IN(4)) {
        pg8::DenseOrder S; S.init(NTOK, DM, 1024, G, bx);
        EpiY E{(const bf16_t*)(ws + WS_XB), args.out, (float*)(ws + WS_RPART), lds};
        pg8::gemm_phase<EpiY, pg8::DenseOrder, false, 16, 8>(lds, (const bf16_t*)(ws + WS_MIX), (const bf16_t*)(ws + WS_WOUT), 1024, S, E, ws + WS_MIX + 32 * MiB, ws + WS_WOUT + 4 * MiB);
    }
    SEAM(4);
    if (IN(5)) { p4_phase(args, (char*)lds_raw, vcu, G);
        if (part) {
            __syncthreads();
            const int gw = vcu * NWAVES + __builtin_amdgcn_readfirstlane(tid >> 6), cw = gw % BG_NS, hs = gw / BG_NS, nh = (256 * NWAVES - cw + BG_NS - 1) / BG_NS;
            const int k0 = (int)((const unsigned*)(ws + WS_CTL))[CW_PROG + cw] + hs;
            (void)p0_items<1, false>(args, lds, k0 * BG_NS + cw, nh * BG_NS, nullptr, IT_GU);
        }
#ifdef DUP_P4
        if (args.coop) { xcd_barrier(bar); if (bx == 0 && tid < NEXP) ((unsigned*)(ws + WS_CTL))[CW_CNT + tid * CNT_STRIDE] = 0u; xcd_barrier(bar); }
        p4_phase(args, (char*)lds_raw, vcu, G);
#endif
    }
    SEAM(5);
    if (IN(6) || IN(7) || IN(8)) {
        LAS int* pre = (LAS int*)(lds + LDS_PRE);
        if (tid == 0) { const unsigned* cnt = (const unsigned*)(ws + WS_CTL) + CW_CNT; int s = 0;
            for (int e = 0; e < NE1; ++e) { pre[e] = s; s += (int)((cnt[e * CNT_STRIDE] + 255u) >> 8); } pre[NE1] = s; }
        __syncthreads();
    }
    if (IN(6)) {
        pg8::GroupOrder<4, true> S{(const LAS int*)(lds + LDS_PRE), (const int*)(ws + WS_CTL) + CW_CNT, (const int*)(ws + WS_SLOT), G, vcu, (size_t)1024 * DM, (size_t)256 * DM, (LAS v4i_t*)(lds + LDS_PRE + 512)}; S.build();
        EpiH E{(unsigned char*)(ws + WS_H), nullptr};
        pg8::gemm_phase<EpiH, pg8::GroupOrder<4, true>, true>(lds, (const bf16_t*)(ws + WS_X8), (const bf16_t*)(ws + WS_WGU), DM / 2, S, E);
        if (part) {
            const int gw = vcu * NWAVES + __builtin_amdgcn_readfirstlane(tid >> 6), cw = gw % BG_NS, hs = gw / BG_NS, nh = (256 * NWAVES - cw + BG_NS - 1) / BG_NS;
            int k0 = (int)((const unsigned*)(ws + WS_CTL))[CW_PROG + cw] + hs;
            const int kd = (IT_GU - cw + BG_NS - 1) / BG_NS;
            if (k0 < kd) k0 += (kd - k0 + nh - 1) / nh * nh;
            (void)p0_items<1, false>(args, lds, k0 * BG_NS + cw, nh * BG_NS);
        }
    }
    SEAM(6);
    if (IN(7)) {
#ifdef STAG7
        { const unsigned long long t0 = __builtin_amdgcn_s_memrealtime(), dl = (unsigned long long)((vcu & 15) * STAG7);
          while (__builtin_amdgcn_s_memrealtime() - t0 < dl) __builtin_amdgcn_s_sleep(8); }
#endif
        pg8::GroupOrder<8, false> S{(const LAS int*)(lds + LDS_PRE), (const int*)(ws + WS_CTL) + CW_CNT, (const int*)(ws + WS_SLOT), G, vcu, (size_t)DM * DEXP, (size_t)256 * DEXP, (LAS v4i_t*)(lds + LDS_PRE + 512)}; S.build();
        EpiPair E{(unsigned char*)(ws + WS_BIG), lds, 0};
#ifdef PRE_P7
        { EpiPair E2{(unsigned char*)(ws + WS_BIG), lds, 1}; pg8::gemm_phase<EpiPair, pg8::GroupOrder<8, false>, true, 0, 0, PRE_P7 - 1>(lds, (const bf16_t*)(ws + WS_H), (const bf16_t*)(ws + WS_WD), DEXP / 2, S, E2); }
        if (args.coop) xcd_barrier(bar);
#endif
        pg8::gemm_phase<EpiPair, pg8::GroupOrder<8, false>, true>(lds, (const bf16_t*)(ws + WS_H), (const bf16_t*)(ws + WS_WD), DEXP / 2, S, E);
#ifdef DUP_P7
        if (args.coop) xcd_barrier(bar);
        pg8::gemm_phase<EpiPair, pg8::GroupOrder<8, false>, true>(lds, (const bf16_t*)(ws + WS_H), (const bf16_t*)(ws + WS_WD), DEXP / 2, S, E);
#endif
    }
    SEAM(7);
    if (IN(8)) { p8_phase(args, (const LAS int*)(lds + LDS_PRE), vcu, G);
#ifdef DUP_P8
        if (args.coop) xcd_barrier(bar);
        p8_phase(args, (const LAS int*)(lds + LDS_PRE), vcu, G);
#endif
    }
#undef IN
#undef SEAM
}

extern "C" void kernel_launch(void* const* d_in, const int* in_sizes, int n_in, void* d_out, int out_size, void* d_ws, size_t ws_size, hipStream_t stream) {
    static int grid = 0;
    if (grid == 0) {
        if (n_in != 22 || out_size != NTOK * DM || ws_size < WS_END) { fprintf(stderr, "kernel_launch: unexpected problem: n_in %d out %d ws %zu (need %zu)\n", n_in, out_size, ws_size, (size_t)WS_END); grid = -1; return; }
        int dev = 0, cus = 0, per_cu = 0;
        (void)hipGetDevice(&dev); (void)hipDeviceGetAttribute(&cus, hipDeviceAttributeMultiprocessorCount, dev);
        if (hipFuncSetAttribute((const void*)hymba_fwd, hipFuncAttributeMaxDynamicSharedMemorySize, LDS_BYTES) != hipSuccess) { fprintf(stderr, "kernel_launch: hipFuncSetAttribute failed\n"); grid = -1; return; }
        if (hipOccupancyMaxActiveBlocksPerMultiprocessor(&per_cu, (const void*)hymba_fwd, NTHR, LDS_BYTES) != hipSuccess || per_cu < 1 || cus < 1) {
            fprintf(stderr, "kernel_launch: the occupancy query admits %d workgroups per CU on %d CUs for %d threads + %d B LDS: the grid barrier needs every workgroup resident; nothing launched\n", per_cu, cus, NTHR, LDS_BYTES); (void)hipGetLastError(); grid = -1; return; }
        (void)hipGetLastError();
        grid = cus;
    }
    if (grid < 0) return;
    Args a{};
    const float** f = (const float**)&a;
    for (int i = 0; i < 22; ++i) f[i] = (const float*)d_in[i];
    a.out = (float*)d_out; a.ws = (unsigned char*)d_ws; a.coop = 0; a.pad = 0;
#ifndef ONE_LAUNCH
    for (int p = 0; p < N_PHASES; ++p) { a.ph_lo = p; a.ph_hi = p + 1; hipLaunchKernelGGL(hymba_fwd, dim3(grid), dim3(NTHR), LDS_BYTES, stream, a); }
#else
    a.ph_lo = 0; a.ph_hi = N_PHASES; a.coop = 1;
    (void)hipMemsetAsync((char*)d_ws + WS_CTL + (size_t)CW_BAR * 4, 0, (size_t)XCD_BAR_WORDS * 4, stream);
    hipLaunchKernelGGL(hymba_fwd, dim3(grid), dim3(NTHR), LDS_BYTES, stream, a);
#endif
}
```
